# Optimizing an MI355X kernel written in HIP

```python
import math
import jax, jax.numpy as jnp
from jax import lax
import numpy as np

D_MODEL = 2048
BATCH = 4
SEQ = 8192
DEPTH = 4
DEC_BATCH = 32
DEC_SEQ = 16
PAST_LEN = 2048

CHUNK = 64
N_MIXERS = 2
N_SSD_LAYERS = (DEPTH + 1) // 2
N_MLSTM_LAYERS = DEPTH // 2
CONV_W = 4
SSD_INNER = 2 * D_MODEL
SSD_HEADDIM = 64
SSD_HEADS = SSD_INNER // SSD_HEADDIM
SSD_GROUPS = 8
SSD_HPG = SSD_HEADS // SSD_GROUPS
SSD_DSTATE = 128
SSD_CONV_DIM = SSD_INNER + 2 * SSD_GROUPS * SSD_DSTATE
SSD_PROJ = SSD_INNER + SSD_CONV_DIM + SSD_HEADS
ML_INNER = 2 * D_MODEL
ML_HEADS = 8
ML_HEADDIM = ML_INNER // ML_HEADS
ML_PROJ = 3 * ML_INNER + 2 * ML_HEADS
DEEPNORM_ALPHA = (2 * DEPTH) ** 0.25
DEEPNORM_BETA = (8 * DEPTH) ** -0.25
LN_EPS = 1e-5
RMS_EPS = 1e-6

kernel_name = "hybrid_ssd_mlstm_streaming_step"


def layer_norm(x, g, b):
    xf = x.astype(jnp.float32)
    mu = jnp.mean(xf, axis=-1, keepdims=True)
    var = jnp.mean(jnp.square(xf - mu), axis=-1, keepdims=True)
    return ((xf - mu) * lax.rsqrt(var + LN_EPS) * g + b).astype(x.dtype)


def causal_conv(u, conv_state, w, b):
    T = u.shape[1]
    up = jnp.concatenate([conv_state.astype(u.dtype), u], axis=1)
    y = b + up[:, 0:T] * w[0]
    for k in range(1, CONV_W):
        y = y + up[:, k:k + T] * w[k]
    return y, up[:, -(CONV_W - 1):]


def to_chunks(a, L):
    B, T = a.shape[0], a.shape[1]
    return jnp.moveaxis(a.reshape((B, T // L, L) + a.shape[2:]), 1, 0)


def from_chunks(a):
    a = jnp.moveaxis(a, 0, 1)
    return a.reshape((a.shape[0], a.shape[1] * a.shape[2]) + a.shape[3:])


def ssd_scan(x, dt, A, Bm, Cm, h0):
    T = x.shape[1]
    L = min(CHUNK, T)
    causal = jnp.tril(jnp.ones((L, L), dtype=bool))

    def step(h, inp):
        xc, dtc, Bc, Cc = inp
        cum = jnp.cumsum(dtc * A, axis=1)
        seg = cum[:, :, None] - cum[:, None, :]
        decay = jnp.exp(jnp.where(causal[None, :, :, None, None], seg, -jnp.inf))
        cb = jnp.einsum('btgn,bsgn->btsg', Cc, Bc)
        w = cb[..., None] * decay * dtc[:, None]
        y = jnp.einsum('btsgh,bsghp->btghp', w, xc)
        y = y + jnp.einsum('btgn,bghpn->btghp', Cc, h) * jnp.exp(cum)[..., None]
        tail = jnp.exp(cum[:, -1:] - cum) * dtc
        h = h * jnp.exp(cum[:, -1])[..., None, None] + jnp.einsum(
            'bsghp,bsgn->bghpn', xc * tail[..., None], Bc)
        return h, y

    hT, ys = lax.scan(step, h0, (to_chunks(x, L), to_chunks(dt, L), to_chunks(Bm, L), to_chunks(Cm, L)))
    return from_chunks(ys), hT


def mlstm_scan(q, k, v, li, lf, C0, n0, m0):
    T = q.shape[1]
    L = min(CHUNK, T)
    causal = jnp.tril(jnp.ones((L, L), dtype=bool))

    def step(carry, inp):
        C, n, m = carry
        qc, kc, vc, lic, lfc = inp
        b = jnp.cumsum(lfc, axis=1)
        dmat = b[:, :, None] - b[:, None, :] + lic[:, None]
        dmat = jnp.where(causal[None, :, :, None], dmat, -jnp.inf)
        inter = b + m[:, None]
        m_t = jnp.maximum(inter, jnp.max(dmat, axis=2))
        s = jnp.einsum('bthd,bshd->btsh', qc, kc) * jnp.exp(dmat - m_t[:, :, None])
        g = jnp.exp(inter - m_t)
        num = jnp.einsum('btsh,bshd->bthd', s, vc) + g[..., None] * jnp.einsum('bthk,bhkv->bthv', qc, C)
        den = jnp.sum(s, axis=2) + g * jnp.einsum('bthk,bhk->bth', qc, n)
        h = num / jnp.maximum(jnp.abs(den), jnp.exp(-m_t))[..., None]
        m_new = m_t[:, -1]
        tail = jnp.exp(b[:, -1:] - b + lic - m_new[:, None])
        dec = jnp.exp(b[:, -1] + m - m_new)
        kt = kc * tail[..., None]
        C = dec[..., None, None] * C + jnp.einsum('bshk,bshv->bhkv', kt, vc)
        n = dec[..., None] * n + jnp.sum(kt, axis=1)
        return (C, n, m_new), h

    (CT, nT, mT), hs = lax.scan(step, (C0, n0, m0),
                                (to_chunks(q, L), to_chunks(k, L), to_chunks(v, L),
                                 to_chunks(li, L), to_chunks(lf, L)))
    return from_chunks(hs), CT, nT, mT


def ssd_mixer(x, conv_state, h0, w_in, conv_w, conv_b, dt_bias, A_log, D, norm_w, w_out):
    Bsz, T = x.shape[0], x.shape[1]
    proj = x @ w_in
    z = proj[..., :SSD_INNER]
    xBC = proj[..., SSD_INNER:SSD_INNER + SSD_CONV_DIM]
    dt_raw = proj[..., SSD_INNER + SSD_CONV_DIM:]
    xBC, new_conv = causal_conv(xBC, conv_state, conv_w, conv_b)
    xBC = jax.nn.silu(xBC).astype(jnp.float32)
    xs = xBC[..., :SSD_INNER].reshape(Bsz, T, SSD_GROUPS, SSD_HPG, SSD_HEADDIM)
    Bm = xBC[..., SSD_INNER:SSD_INNER + SSD_GROUPS * SSD_DSTATE].reshape(Bsz, T, SSD_GROUPS, SSD_DSTATE)
    Cm = xBC[..., SSD_INNER + SSD_GROUPS * SSD_DSTATE:].reshape(Bsz, T, SSD_GROUPS, SSD_DSTATE)
    dt = jax.nn.softplus(dt_raw.astype(jnp.float32) + dt_bias).reshape(Bsz, T, SSD_GROUPS, SSD_HPG)
    A = -jnp.exp(A_log.astype(jnp.float32)).reshape(SSD_GROUPS, SSD_HPG)
    h0 = h0.astype(jnp.float32).reshape(Bsz, SSD_GROUPS, SSD_HPG, SSD_HEADDIM, SSD_DSTATE)
    y, hT = ssd_scan(xs, dt, A, Bm, Cm, h0)
    y = y + D.astype(jnp.float32).reshape(SSD_GROUPS, SSD_HPG)[:, :, None] * xs
    y = y.reshape(Bsz, T, SSD_GROUPS, -1) * jax.nn.silu(z.astype(jnp.float32)).reshape(Bsz, T, SSD_GROUPS, -1)
    y = y * lax.rsqrt(jnp.mean(jnp.square(y), axis=-1, keepdims=True) + RMS_EPS)
    y = y.reshape(Bsz, T, SSD_INNER) * norm_w
    out = y.astype(x.dtype) @ w_out
    return out, new_conv, hT.reshape(Bsz, SSD_HEADS, SSD_HEADDIM, SSD_DSTATE)


def mlstm_mixer(x, conv_state, C0, n0, m0, w_in, conv_w, conv_b, w_q, w_k, w_v, b_i, b_f, norm_w, skip, w_out):
    Bsz, T = x.shape[0], x.shape[1]
    proj = x @ w_in
    xm = proj[..., :ML_INNER]
    z = proj[..., ML_INNER:2 * ML_INNER]
    o_pre = proj[..., 2 * ML_INNER:3 * ML_INNER]
    gi = proj[..., 3 * ML_INNER:3 * ML_INNER + ML_HEADS]
    gf = proj[..., 3 * ML_INNER + ML_HEADS:]
    xc, new_conv = causal_conv(xm, conv_state, conv_w, conv_b)
    xc = jax.nn.silu(xc).astype(jnp.float32).reshape(Bsz, T, ML_HEADS, ML_HEADDIM)
    xmh = xm.astype(jnp.float32).reshape(Bsz, T, ML_HEADS, ML_HEADDIM)
    q = jnp.einsum('bthd,hde->bthe', xc, w_q) * (ML_HEADDIM ** -0.5)
    k = jnp.einsum('bthd,hde->bthe', xc, w_k)
    v = jnp.einsum('bthd,hde->bthe', xmh, w_v)
    li = gi.astype(jnp.float32) + b_i
    lf = jax.nn.log_sigmoid(gf.astype(jnp.float32) + b_f)
    h, CT, nT, mT = mlstm_scan(q, k, v, li, lf, C0.astype(jnp.float32),
                               n0.astype(jnp.float32), m0.astype(jnp.float32))
    mu = jnp.mean(h, axis=-1, keepdims=True)
    var = jnp.mean(jnp.square(h - mu), axis=-1, keepdims=True)
    hn = (h - mu) * lax.rsqrt(var + LN_EPS) * norm_w
    o = jax.nn.sigmoid(o_pre.astype(jnp.float32)).reshape(Bsz, T, ML_HEADS, ML_HEADDIM)
    hcell = (o * hn).reshape(Bsz, T, ML_INNER) + skip * xc.reshape(Bsz, T, ML_INNER)
    y = hcell * jax.nn.silu(z.astype(jnp.float32))
    out = y.astype(x.dtype) @ w_out
    return out, new_conv, CT, nT, mT


def trunk(x, states, weights):
    ssd_conv, ssd_h, ml_conv, ml_C, ml_n, ml_m = states
    (ssd_w_in, ssd_conv_w, ssd_conv_b, ssd_dt_bias, ssd_A_log, ssd_D, ssd_norm_w, ssd_w_out,
     ml_w_in, ml_conv_w, ml_conv_b, ml_w_q, ml_w_k, ml_w_v, ml_b_i, ml_b_f, ml_norm_w, ml_skip, ml_w_out,
     ln_g, ln_b) = weights
    o_sc, o_sh, o_mc, o_mC, o_mn, o_mm = [], [], [], [], [], []
    for i in range(DEPTH):
        j = i // N_MIXERS
        if i % N_MIXERS == 0:
            y, c, h = ssd_mixer(x, ssd_conv[j], ssd_h[j], ssd_w_in[j], ssd_conv_w[j], ssd_conv_b[j],
                                ssd_dt_bias[j], ssd_A_log[j], ssd_D[j], ssd_norm_w[j], ssd_w_out[j])
            o_sc.append(c)
            o_sh.append(h)
        else:
            y, c, C, n, m = mlstm_mixer(x, ml_conv[j], ml_C[j], ml_n[j], ml_m[j], ml_w_in[j], ml_conv_w[j],
                                        ml_conv_b[j], ml_w_q[j], ml_w_k[j], ml_w_v[j], ml_b_i[j], ml_b_f[j],
                                        ml_norm_w[j], ml_skip[j], ml_w_out[j])
            o_mc.append(c)
            o_mC.append(C)
            o_mn.append(n)
            o_mm.append(m)
        x = layer_norm(DEEPNORM_ALPHA * x + y, ln_g[i], ln_b[i])
    return (x, jnp.stack(o_sc), jnp.stack(o_sh), jnp.stack(o_mc), jnp.stack(o_mC),
            jnp.stack(o_mn), jnp.stack(o_mm))


def setup_inputs(seed: int = 0) -> dict:
    key = jax.random.key(seed)
    ks = iter(jax.random.split(key, 48))
    f32 = jnp.float32

    def nrm(shape, s):
        return jax.random.normal(next(ks), shape, f32) * s

    NA, NB = N_SSD_LAYERS, N_MLSTM_LAYERS
    dt0 = jnp.exp(jax.random.uniform(next(ks), (NA, SSD_HEADS), f32, math.log(1e-3), math.log(1e-1)))
    b_f = jnp.broadcast_to(jnp.linspace(3.0, 6.0, ML_HEADS, dtype=f32), (NB, ML_HEADS)) + nrm((NB, ML_HEADS), 0.1)
    return {
        "x_prompt": nrm((BATCH, SEQ, D_MODEL), 1.0),
        "x_sample": nrm((DEC_BATCH, DEC_SEQ, D_MODEL), 1.0),
        "state_ssd_conv": nrm((NA, DEC_BATCH, CONV_W - 1, SSD_CONV_DIM), 1.0),
        "state_ssd_h": nrm((NA, DEC_BATCH, SSD_HEADS, SSD_HEADDIM, SSD_DSTATE), 0.1),
        "state_mlstm_conv": nrm((NB, DEC_BATCH, CONV_W - 1, ML_INNER), 1.0),
        "state_mlstm_C": nrm((NB, DEC_BATCH, ML_HEADS, ML_HEADDIM, ML_HEADDIM), 0.1),
        "state_mlstm_n": nrm((NB, DEC_BATCH, ML_HEADS, ML_HEADDIM), 0.1),
        "state_mlstm_m": nrm((NB, DEC_BATCH, ML_HEADS), 1.0),
        "ssd_w_in": nrm((NA, D_MODEL, SSD_PROJ), D_MODEL ** -0.5),
        "ssd_conv_w": nrm((NA, CONV_W, SSD_CONV_DIM), CONV_W ** -0.5),
        "ssd_conv_b": nrm((NA, SSD_CONV_DIM), 0.01),
        "ssd_dt_bias": dt0 + jnp.log(-jnp.expm1(-dt0)),
        "ssd_A_log": jnp.log(jax.random.uniform(next(ks), (NA, SSD_HEADS), f32, 1.0, 16.0)),
        "ssd_D": 1.0 + nrm((NA, SSD_HEADS), 0.1),
        "ssd_norm_w": 1.0 + nrm((NA, SSD_INNER), 0.02),
        "ssd_w_out": nrm((NA, SSD_INNER, D_MODEL), SSD_INNER ** -0.5 * DEEPNORM_BETA),
        "ml_w_in": nrm((NB, D_MODEL, ML_PROJ), D_MODEL ** -0.5),
        "ml_conv_w": nrm((NB, CONV_W, ML_INNER), CONV_W ** -0.5),
        "ml_conv_b": nrm((NB, ML_INNER), 0.01),
        "ml_w_q": nrm((NB, ML_HEADS, ML_HEADDIM, ML_HEADDIM), ML_HEADDIM ** -0.5),
        "ml_w_k": nrm((NB, ML_HEADS, ML_HEADDIM, ML_HEADDIM), ML_HEADDIM ** -0.5),
        "ml_w_v": nrm((NB, ML_HEADS, ML_HEADDIM, ML_HEADDIM), ML_HEADDIM ** -0.5),
        "ml_b_i": nrm((NB, ML_HEADS), 0.1),
        "ml_b_f": b_f,
        "ml_norm_w": 1.0 + nrm((NB, ML_HEADS, ML_HEADDIM), 0.02),
        "ml_skip": 1.0 + nrm((NB, ML_INNER), 0.1),
        "ml_w_out": nrm((NB, ML_INNER, D_MODEL), ML_INNER ** -0.5 * DEEPNORM_BETA),
        "ln_g": 1.0 + nrm((DEPTH, D_MODEL), 0.01),
        "ln_b": nrm((DEPTH, D_MODEL), 0.01),
    }


def reference(x_prompt, x_sample, state_ssd_conv, state_ssd_h, state_mlstm_conv, state_mlstm_C,
              state_mlstm_n, state_mlstm_m,
              ssd_w_in, ssd_conv_w, ssd_conv_b, ssd_dt_bias, ssd_A_log, ssd_D, ssd_norm_w, ssd_w_out,
              ml_w_in, ml_conv_w, ml_conv_b, ml_w_q, ml_w_k, ml_w_v, ml_b_i, ml_b_f, ml_norm_w, ml_skip,
              ml_w_out, ln_g, ln_b):
    weights = (ssd_w_in, ssd_conv_w, ssd_conv_b, ssd_dt_bias, ssd_A_log, ssd_D, ssd_norm_w, ssd_w_out,
               ml_w_in, ml_conv_w, ml_conv_b, ml_w_q, ml_w_k, ml_w_v, ml_b_i, ml_b_f, ml_norm_w, ml_skip,
               ml_w_out, ln_g, ln_b)
    f32 = jnp.float32
    NA, NB = N_SSD_LAYERS, N_MLSTM_LAYERS
    zero_states = (jnp.zeros((NA, BATCH, CONV_W - 1, SSD_CONV_DIM), x_prompt.dtype),
                   jnp.zeros((NA, BATCH, SSD_HEADS, SSD_HEADDIM, SSD_DSTATE), f32),
                   jnp.zeros((NB, BATCH, CONV_W - 1, ML_INNER), x_prompt.dtype),
                   jnp.zeros((NB, BATCH, ML_HEADS, ML_HEADDIM, ML_HEADDIM), f32),
                   jnp.zeros((NB, BATCH, ML_HEADS, ML_HEADDIM), f32),
                   jnp.zeros((NB, BATCH, ML_HEADS), f32))
    y_prompt, p_sc, p_sh, p_mc, p_mC, p_mn, p_mm = trunk(x_prompt, zero_states, weights)
    cache_states = (state_ssd_conv, state_ssd_h, state_mlstm_conv, state_mlstm_C, state_mlstm_n, state_mlstm_m)
    y_sample, s_sc, s_sh, s_mc, s_mC, s_mn, s_mm = trunk(x_sample, cache_states, weights)
    return (y_prompt, y_sample, p_sc, p_sh, p_mc, p_mC, p_mn, p_mm, s_sc, s_sh, s_mc, s_mC, s_mn, s_mm)
```

```cpp
#include <hip/hip_runtime.h>
#include <cstdio>
#include <cstdint>

#ifndef MK_ONE_LAUNCH
#define MK_ONE_LAUNCH 1
#endif

namespace pg8 {
#define PG8_LAS __attribute__((address_space(3)))
typedef unsigned short bf16_t;
typedef short bf16x8 __attribute__((ext_vector_type(8)));
typedef float f32x4 __attribute__((ext_vector_type(4)));
typedef unsigned u32x4 __attribute__((ext_vector_type(4)));
typedef unsigned u32x2 __attribute__((ext_vector_type(2)));
constexpr int BM = 256, BK = 64, HALF = 128, HTB = HALF * BK * 2  , STAGE_BYTES = 8 * HTB, NXCD = 8, WGM = 8;

__host__ __device__ __forceinline__ int lds_byte(int r, int c) { const int st = (r >> 4) * 2 + (c >> 5), rr = r & 15, cc = c & 31, ob = rr * 64 + cc * 2; return st * 1024 + (ob ^ (((ob >> 9) & 1) << 5)); }
__host__ __device__ __forceinline__ void stage_rc(int b, int& R, int& C) { const int st = b / 1024, sb = b % 1024, swz = sb ^ (((sb >> 9) & 1) << 5); R = (st >> 1) * 16 + swz / 64; C = (st & 1) * 32 + (swz % 64) / 2; }
__host__ __device__ __forceinline__ int perm32(int rho) { const int n = rho >> 4, i = rho & 15; return 8 * (i >> 2) + 4 * n + (i & 3); }

struct Unit { int pm, pn, kq; };
struct Gemm { const bf16_t* A; const bf16_t* Bt; int lda; int K; int hshift; };

struct StaticOrder {
    int nM, nN, nwg, G, c, wgm;
    __host__ __device__ void init(int nM_, int nN_, int G_, int c_, int wgm_ = 4) { nM = nM_; nN = nN_; nwg = nM * nN; G = G_; c = c_; wgm = wgm_; }
    __host__ __device__ bool next(int i, Unit& u) const {
        const long L = (long)i * G + c; if (L >= nwg) return false;
        int wgid = (int)L; { const int q = nwg / NXCD, r = nwg % NXCD, xcd = wgid % NXCD, off = wgid / NXCD; wgid = (xcd < r ? xcd * (q + 1) : r * (q + 1) + (xcd - r) * q) + off; }
        const int nig = wgm * nN, gid = wgid / nig, fm = gid * wgm, gsz = (nM - fm) < wgm ? (nM - fm) : wgm;
        u.pm = fm + ((wgid % nig) % gsz); u.pn = (wgid % nig) / gsz; u.kq = -1; return true;
    }
    __device__ __forceinline__ void a_ready(const Unit&) const {}
    __device__ __forceinline__ void done(const Unit&) const {}
};

struct SplitTailOrder {
    StaticOrder base; int nMf, nN, ntail, G, c;
    __host__ __device__ void init(int nMf_, int nN_, int ntail_, int G_, int c_, int wgm_ = 4) { nMf = nMf_; nN = nN_; ntail = ntail_; G = G_; c = c_; base.init(nMf_, nN_, G_, c_, wgm_); }
    __host__ __device__ bool next(int i, Unit& u) const {
        const long L = (long)i * G + c; const int nfull = nMf * nN;
        if (L < nfull) return base.next(i, u);
        const int x = (int)(L - nfull); if (x >= ntail * nN * 4) return false;
        u.pm = nMf + x / (nN * 4); u.pn = (x >> 2) % nN; u.kq = x & 3; return true;
    }
    __device__ __forceinline__ void a_ready(const Unit&) const {}
    __device__ __forceinline__ void done(const Unit&) const {}
};
__device__ __forceinline__ u32x4 xw_a(const u32x4 w0, const u32x4 w1) { u32x4 r;
    r.x = (unsigned)__builtin_amdgcn_update_dpp((int)w0.x, (int)w1.x, 0x128, 0xf, 0xc, false); r.y = (unsigned)__builtin_amdgcn_update_dpp((int)w0.y, (int)w1.y, 0x128, 0xf, 0xc, false);
    r.z = (unsigned)__builtin_amdgcn_update_dpp((int)w0.z, (int)w1.z, 0x128, 0xf, 0xc, false); r.w = (unsigned)__builtin_amdgcn_update_dpp((int)w0.w, (int)w1.w, 0x128, 0xf, 0xc, false); return r; }
__device__ __forceinline__ u32x4 xw_b(const u32x4 w0, const u32x4 w1) { u32x4 r;
    r.x = (unsigned)__builtin_amdgcn_update_dpp((int)w1.x, (int)w0.x, 0x128, 0xf, 0x3, false); r.y = (unsigned)__builtin_amdgcn_update_dpp((int)w1.y, (int)w0.y, 0x128, 0xf, 0x3, false);
    r.z = (unsigned)__builtin_amdgcn_update_dpp((int)w1.z, (int)w0.z, 0x128, 0xf, 0x3, false); r.w = (unsigned)__builtin_amdgcn_update_dpp((int)w1.w, (int)w0.w, 0x128, 0xf, 0x3, false); return r; }
__device__ __forceinline__ unsigned cvt_pk_bf16(float lo, float hi) { unsigned r; asm volatile("v_cvt_pk_bf16_f32 %0, %1, %2" : "=v"(r) : "v"(lo), "v"(hi)); return r; }

template <class Epi, class Sched, bool ALIGN_EPI = false, bool SP2 = false, bool SPLITK = false>
__device__ __forceinline__ void gemm_phase(PG8_LAS unsigned char* lds, const Gemm g, const Sched& S, const Epi& E, const int tid_in) {
    int tid_ = tid_in; asm volatile("" : "+v"(tid_));
    const int tid = tid_, wid = __builtin_amdgcn_readfirstlane(tid >> 6), lane = tid & 63, wr = wid >> 2, wc = wid & 3, fr = lane & 15, fq = lane >> 4;
    const int K = g.K, nt = K / BK, lda = g.lda;
    unsigned voffA[2], voffB[2];
#pragma unroll
    for (int i = 0; i < 2; ++i) { int R, C; stage_rc(tid * 16 + i * 8192, R, C); const int Rb = Epi::PERM ? (64 * (R >> 5) + perm32(R & 31)) : R;
        voffA[i] = (unsigned)(R * lda + C) * 2u; voffB[i] = (unsigned)(Rb * K + C) * 2u; }
    const size_t kstep = (size_t)(BK * 2);
    const size_t hstepA = (size_t)HALF * lda * 2, hstepB = (size_t)(Epi::PERM ? 32 : HALF) * K * 2;
    const unsigned ldsw = (unsigned)wid * 1024u;
    const int aoff = lds_byte(wr * 64 + fr, fq * 8), boff = lds_byte(wc * 32 + fr, fq * 8);
#define PG8_KOFF(u) ((SPLITK && (u).kq > 0) ? (size_t)(u).kq * (size_t)(K / 4) * 2 : (size_t)0)
#define PG8_ABASE(u) ((const char*)g.A + ((size_t)(u).pm * 256 * lda + (g.hshift >= 0 ? (size_t)((u).pn >> g.hshift) * 512 : (size_t)0)) * 2 + PG8_KOFF(u))
#define PG8_BBASE(u) ((const char*)g.Bt + (size_t)(u).pn * 256 * K * 2 + PG8_KOFF(u))
#define PG8_SA(b, h) (((b) * 2 + (h)) * HTB)
#define PG8_SB(b, h) ((4 + (b) * 2 + (h)) * HTB)
#define PG8_STAGE(bufoff, gbase, voff) do { _Pragma("unroll") for (int _i = 0; _i < 2; ++_i) \
        __builtin_amdgcn_global_load_lds((const unsigned*)((const char*)(gbase) + (voff)[_i]), (PG8_LAS unsigned*)(lds + (bufoff) + ldsw + _i * 8192), 16, 0, 0); } while (0)
#define PG8_LDA(dst, b, h) do { _Pragma("unroll") for (int m = 0; m < 4; ++m) _Pragma("unroll") for (int k = 0; k < 2; ++k) dst[m][k] = *(const PG8_LAS bf16x8*)(lds + PG8_SA(b, h) + aoff + m * 2048 + k * 1024); } while (0)
#define PG8_LDB(dst, b, h) do { _Pragma("unroll") for (int n = 0; n < 2; ++n) _Pragma("unroll") for (int k = 0; k < 2; ++k) dst[n][k] = *(const PG8_LAS bf16x8*)(lds + PG8_SB(b, h) + boff + n * 2048 + k * 1024); } while (0)
#define PG8_MMA(ai, bj, At, Bt) do { __builtin_amdgcn_s_setprio(1); _Pragma("unroll") for (int m = 0; m < 4; ++m) _Pragma("unroll") for (int n = 0; n < 2; ++n) _Pragma("unroll") for (int k = 0; k < 2; ++k) \
        acc[ai][bj][m][n] = __builtin_amdgcn_mfma_f32_16x16x32_bf16(Bt[n][k], At[m][k], acc[ai][bj][m][n], 0, 0, 0); __builtin_amdgcn_s_setprio(0); } while (0)
#define PG8_WAIT_V(n) asm volatile("s_waitcnt vmcnt(" #n ")" ::: "memory")
#define PG8_WAIT_L(n) asm volatile("s_waitcnt lgkmcnt(" #n ")" ::: "memory")
#define PG8_BAR __builtin_amdgcn_s_barrier()
#define PG8_SCHED __builtin_amdgcn_sched_barrier(0)
    Unit cur, nxt; int ui = 0;
    if (!S.next(0, cur)) return;
    int ntc = (SPLITK && cur.kq >= 0) ? nt / 4 : nt;
    f32x4 acc[2][2][4][2];
#pragma unroll
    for (int a = 0; a < 2; ++a)
#pragma unroll
        for (int b = 0; b < 2; ++b)
#pragma unroll
            for (int m = 0; m < 4; ++m)
#pragma unroll
                for (int n = 0; n < 2; ++n) acc[a][b][m][n] = (f32x4){0.f, 0.f, 0.f, 0.f};
    bf16x8 At[4][2], B0[2][2], B1[2][2];
    const char* cA = PG8_ABASE(cur); const char* cB = PG8_BBASE(cur);
    S.a_ready(cur);
    if constexpr (SP2) {
        PG8_STAGE(PG8_SB(0, 0), cB, voffB); PG8_STAGE(PG8_SB(0, 1), cB + hstepB, voffB); PG8_STAGE(PG8_SA(0, 0), cA, voffA); PG8_STAGE(PG8_SA(0, 1), cA + hstepA, voffA);
        if (wr == 1) PG8_BAR;
        PG8_WAIT_V(2); PG8_BAR;
        PG8_STAGE(PG8_SB(1, 0), cB + kstep, voffB); PG8_STAGE(PG8_SA(1, 0), cA + kstep, voffA); PG8_STAGE(PG8_SB(1, 1), cB + hstepB + kstep, voffB);
        PG8_WAIT_V(6); PG8_BAR;
    } else {
        PG8_STAGE(PG8_SB(0, 0), cB, voffB); PG8_STAGE(PG8_SA(0, 0), cA, voffA); PG8_STAGE(PG8_SB(0, 1), cB + hstepB, voffB); PG8_STAGE(PG8_SA(0, 1), cA + hstepA, voffA);
        if (wr == 1) PG8_BAR;
        PG8_WAIT_V(4); PG8_BAR;
        PG8_STAGE(PG8_SB(1, 0), cB + kstep, voffB); PG8_STAGE(PG8_SA(1, 0), cA + kstep, voffA); PG8_STAGE(PG8_SB(1, 1), cB + hstepB + kstep, voffB);
        PG8_WAIT_V(6); PG8_BAR;
    }
    for (;;) {
        const bool has_next = S.next(ui + 1, nxt);
        const char* nA = has_next ? PG8_ABASE(nxt) : cA; const char* nB = has_next ? PG8_BBASE(nxt) : cB;
        for (int t = 0; t < ntc; t += 2) {
            const bool last = (t == ntc - 2);
            const char* a1 = cA + (size_t)(t + 1) * kstep;
            const char* a2 = last ? nA : cA + (size_t)(t + 2) * kstep; const char* b2 = last ? nB : cB + (size_t)(t + 2) * kstep;
            const char* a3 = a2 + kstep; const char* b3 = b2 + kstep;
            if (last && has_next) S.a_ready(nxt);
            if constexpr (SP2) {
            PG8_LDB(B0, 0, 0); PG8_LDB(B1, 0, 1); PG8_SCHED; PG8_LDA(At, 0, 0); PG8_STAGE(PG8_SA(1, 1), a1 + hstepA, voffA);
            PG8_WAIT_V(8); PG8_WAIT_L(0); PG8_BAR; PG8_MMA(0, 0, At, B0); PG8_MMA(0, 1, At, B1); PG8_BAR; PG8_SCHED;
            PG8_LDA(At, 0, 1); PG8_STAGE(PG8_SB(0, 0), b2, voffB); PG8_STAGE(PG8_SB(0, 1), b2 + hstepB, voffB); PG8_STAGE(PG8_SA(0, 0), a2, voffA);
            PG8_WAIT_V(8); PG8_WAIT_L(0); PG8_BAR; PG8_MMA(1, 0, At, B0); PG8_MMA(1, 1, At, B1); PG8_BAR; PG8_SCHED;
            PG8_LDB(B0, 1, 0); PG8_LDB(B1, 1, 1); PG8_SCHED; PG8_LDA(At, 1, 0); PG8_STAGE(PG8_SA(0, 1), a2 + hstepA, voffA);
            PG8_WAIT_V(8); PG8_WAIT_L(0); PG8_BAR; PG8_MMA(0, 0, At, B0); PG8_MMA(0, 1, At, B1); PG8_BAR; PG8_SCHED;
            PG8_LDA(At, 1, 1); PG8_STAGE(PG8_SB(1, 0), b3, voffB); PG8_STAGE(PG8_SB(1, 1), b3 + hstepB, voffB); PG8_STAGE(PG8_SA(1, 0), a3, voffA);
            PG8_WAIT_V(8); PG8_WAIT_L(0); PG8_BAR; PG8_MMA(1, 0, At, B0); PG8_MMA(1, 1, At, B1); PG8_BAR; PG8_SCHED;
            } else {
            PG8_LDB(B0, 0, 0); PG8_SCHED; PG8_LDA(At, 0, 0); PG8_STAGE(PG8_SA(1, 1), a1 + hstepA, voffA);
            PG8_WAIT_L(8); PG8_BAR; PG8_WAIT_L(0); PG8_MMA(0, 0, At, B0); PG8_BAR; PG8_SCHED;
            PG8_LDB(B1, 0, 1); PG8_STAGE(PG8_SB(0, 0), b2, voffB);
            PG8_BAR; PG8_WAIT_L(0); PG8_MMA(0, 1, At, B1); PG8_BAR;
            PG8_LDA(At, 0, 1); PG8_STAGE(PG8_SA(0, 0), a2, voffA);
            PG8_BAR; PG8_WAIT_L(0); PG8_MMA(1, 0, At, B0); PG8_BAR; PG8_SCHED;
            PG8_STAGE(PG8_SB(0, 1), b2 + hstepB, voffB);
            PG8_WAIT_V(6); PG8_BAR; PG8_MMA(1, 1, At, B1); PG8_BAR;
            PG8_LDB(B0, 1, 0); PG8_SCHED; PG8_LDA(At, 1, 0); PG8_STAGE(PG8_SA(0, 1), a2 + hstepA, voffA);
            PG8_WAIT_L(8); PG8_BAR; PG8_WAIT_L(0); PG8_MMA(0, 0, At, B0); PG8_BAR; PG8_SCHED;
            PG8_LDB(B1, 1, 1); PG8_STAGE(PG8_SB(1, 0), b3, voffB);
            PG8_BAR; PG8_WAIT_L(0); PG8_MMA(0, 1, At, B1); PG8_BAR;
            PG8_LDA(At, 1, 1); PG8_STAGE(PG8_SA(1, 0), a3, voffA);
            PG8_BAR; PG8_WAIT_L(0); PG8_MMA(1, 0, At, B0); PG8_BAR; PG8_SCHED;
            PG8_STAGE(PG8_SB(1, 1), b3 + hstepB, voffB);
            PG8_WAIT_V(6); PG8_BAR; PG8_MMA(1, 1, At, B1); PG8_BAR;
            }
        }
        if constexpr (ALIGN_EPI) { if (wr == 0) PG8_BAR; }
        E(acc, cur, wr, wc, fr, fq); S.done(cur);
        if (!has_next) break;
#pragma unroll
        for (int a = 0; a < 2; ++a)
#pragma unroll
            for (int b = 0; b < 2; ++b)
#pragma unroll
                for (int m = 0; m < 4; ++m)
#pragma unroll
                    for (int n = 0; n < 2; ++n) acc[a][b][m][n] = (f32x4){0.f, 0.f, 0.f, 0.f};
        cur = nxt; cA = nA; cB = nB; ++ui; ntc = (SPLITK && cur.kq >= 0) ? nt / 4 : nt;
        if constexpr (ALIGN_EPI) { if (wr == 1) PG8_BAR; }
    }
    PG8_WAIT_V(0);
    if constexpr (!ALIGN_EPI) { if (wr == 0) PG8_BAR; }
    PG8_BAR;
#undef PG8_KOFF
#undef PG8_ABASE
#undef PG8_BBASE
#undef PG8_SA
#undef PG8_SB
#undef PG8_STAGE
#undef PG8_LDA
#undef PG8_LDB
#undef PG8_MMA
#undef PG8_WAIT_V
#undef PG8_WAIT_L
#undef PG8_BAR
#undef PG8_SCHED
}
}

#ifndef WGM_OUT
#define WGM_OUT 2
#endif
#ifndef WGM_HEAD
#define WGM_HEAD 4
#endif
#define PG8_SP2 true
#define PG8_ALIGN true

constexpr int DM = 2048;
constexpr int NB_P = 4, T_P = 8192, NB_S = 32, T_S = 16;
constexpr int M_P = NB_P * T_P, M_S = NB_S * T_S, M = M_P + M_S;
constexpr int NSTREAM = NB_P + NB_S;
constexpr int NPANEL = M / 256;
constexpr int SSD_INNER = 4096, SSD_HD = 64, SSD_NH = 64, SSD_NG = 8, SSD_DS = 128, SSD_CONVD = 6144, SSD_PROJ = 10304, SSD_NPAD = 10496;
constexpr int ML_INNER = 4096, ML_NH = 8, ML_HD = 512, ML_PROJ = 12304, ML_NPAD = 12544;
constexpr float DN_ALPHA = 1.6817928305074290f;
constexpr float LN_EPS = 1e-5f, RMS_EPS = 1e-6f;
constexpr float ML_QSCALE = 0.04419417382415922f;

constexpr size_t O_YP = 0;
constexpr size_t O_YS = O_YP + (size_t)M_P * DM;
constexpr size_t O_P_SCONV = O_YS + (size_t)M_S * DM;
constexpr size_t O_P_SH = O_P_SCONV + (size_t)2 * NB_P * 3 * SSD_CONVD;
constexpr size_t O_P_MCONV = O_P_SH + (size_t)2 * NB_P * SSD_NH * SSD_HD * SSD_DS;
constexpr size_t O_P_MC = O_P_MCONV + (size_t)2 * NB_P * 3 * ML_INNER;
constexpr size_t O_P_MN = O_P_MC + (size_t)2 * NB_P * ML_NH * ML_HD * ML_HD;
constexpr size_t O_P_MM = O_P_MN + (size_t)2 * NB_P * ML_NH * ML_HD;
constexpr size_t O_S_SCONV = O_P_MM + (size_t)2 * NB_P * ML_NH;
constexpr size_t O_S_SH = O_S_SCONV + (size_t)2 * NB_S * 3 * SSD_CONVD;
constexpr size_t O_S_MCONV = O_S_SH + (size_t)2 * NB_S * SSD_NH * SSD_HD * SSD_DS;
constexpr size_t O_S_MC = O_S_MCONV + (size_t)2 * NB_S * 3 * ML_INNER;
constexpr size_t O_S_MN = O_S_MC + (size_t)2 * NB_S * ML_NH * ML_HD * ML_HD;
constexpr size_t O_S_MM = O_S_MN + (size_t)2 * NB_S * ML_NH * ML_HD;
constexpr size_t O_END = O_S_MM + (size_t)2 * NB_S * ML_NH;

constexpr size_t MiB = 1u << 20;
constexpr size_t WS_CTL = 0, CTL_ZERO_BYTES = 1 * MiB;
constexpr size_t WS_WSSD_IN = 1 * MiB;
constexpr size_t WS_WSSD_OUT = 83 * MiB;
constexpr size_t WS_WML_IN = 115 * MiB;
constexpr size_t WS_WML_QK = 213 * MiB;
constexpr size_t WS_WML_V = 229 * MiB;
constexpr size_t WS_WML_OUT = 237 * MiB;
constexpr size_t WS_XB = 269 * MiB;
constexpr size_t WS_ACT = 399 * MiB;
constexpr size_t ACT_U = (size_t)M * 4096 * 2;
static_assert(ACT_U == 260 * MiB, "unit");
constexpr size_t WS_S_XBCC = WS_ACT + 920 * MiB;
constexpr size_t WS_S_Z = WS_ACT, WS_S_XBC = WS_ACT + 260 * MiB, WS_S_Y = WS_ACT + 650 * MiB, WS_S_DT = WS_ACT + 910 * MiB, WS_S_VPRE = WS_S_XBC;
constexpr size_t WS_M_XM = WS_ACT, WS_M_Q = WS_ACT, WS_M_YG = WS_ACT, WS_M_Z = WS_ACT + 260 * MiB, WS_M_O = WS_ACT + 520 * MiB, WS_M_XC = WS_ACT + 780 * MiB,
                 WS_M_K = WS_ACT + 1040 * MiB, WS_M_VPRE = WS_M_K, WS_M_V = WS_ACT + 1300 * MiB, WS_M_H = WS_M_V, WS_M_GATES = WS_ACT + 1560 * MiB;
constexpr size_t WS_M_S = WS_ACT + 1564 * MiB, WS_M_TOK = WS_ACT + 1600 * MiB, WS_M_CHK = WS_ACT + 1605 * MiB, WS_M_CHP = WS_M_CHK + 512 * 1024;
constexpr size_t WS_END = WS_ACT + 1606 * MiB;
constexpr int ML_NCHUNK = 512 + NB_S;
constexpr int CW_BAR = 4096;

constexpr int NWAVES = 8;
constexpr int ST64 = 144, ST128 = 272;
constexpr int SX_OFF = 0, SXS_OFF = 9216, SB_OFF = 18432, SC_OFF = 35840, SH_OFF = 53248, SW_OFF = 70656, SS_OFF = 79872;
constexpr int RING_BYTES = 131072;
constexpr int LDS_BYTES = 163840;
constexpr int MISC_OFF = LDS_BYTES - 256;
constexpr int STK = 288, STV = 160, MQ_K = 17408, MQ_BUF = 35840, MV_IMG = 10240;
constexpr int MS_OFF = 71680, MV_OFF = 80896, MVT_OFF = 91136, MP_OFF = 111616, MSC_OFF = 128000, MN_OFF = 130048, MNP_OFF = 132096, MQN_OFF = 133120, MNB_OFF = 133376, MTB_OFF = 134400, MDEC_OFF = 135168, MI_OFF = 135424;

#define GAS __attribute__((address_space(1)))
#define LAS __attribute__((address_space(3)))
typedef unsigned short bf16;
typedef unsigned v4u __attribute__((ext_vector_type(4)));
typedef unsigned v2u __attribute__((ext_vector_type(2)));
typedef float f32x4 __attribute__((ext_vector_type(4)));
#define LDS_WAIT() asm volatile("s_waitcnt lgkmcnt(0)" ::: "memory")
#define VM_WAIT() asm volatile("s_waitcnt vmcnt(0)" ::: "memory")
typedef __bf16 bf16x2n __attribute__((ext_vector_type(2)));
__device__ __forceinline__ unsigned f2bf(float f) { return (unsigned)__builtin_bit_cast(unsigned short, (__bf16)f); }
__device__ __forceinline__ unsigned pk2(float lo, float hi) { bf16x2n v; v[0] = (__bf16)lo; v[1] = (__bf16)hi; return __builtin_bit_cast(unsigned, v); }
__device__ __forceinline__ float bf2f(unsigned b) { return __builtin_bit_cast(float, b << 16); }
__device__ __forceinline__ float bflo(unsigned w) { return __builtin_bit_cast(float, w << 16); }
__device__ __forceinline__ float bfhi(unsigned w) { return __builtin_bit_cast(float, w & 0xffff0000u); }
__device__ __forceinline__ float silu_f(float x) { return x * __builtin_amdgcn_rcpf(1.f + __expf(-x)); }
__device__ __forceinline__ float sigmoid_f(float x) { return __builtin_amdgcn_rcpf(1.f + __expf(-x)); }
__device__ __forceinline__ float softplus_f(float x) { return fmaxf(x, 0.f) + __logf(1.f + __expf(-fabsf(x))); }
__device__ __forceinline__ float logsigmoid_f(float x) { return fminf(x, 0.f) - __logf(1.f + __expf(-fabsf(x))); }
#define RDLANE(v, l) __builtin_bit_cast(float, __builtin_amdgcn_readlane(__builtin_bit_cast(int, (float)(v)), (l)))
#define BPERM(v, srclane) __builtin_bit_cast(float, __builtin_amdgcn_ds_bpermute((srclane) << 2, __builtin_bit_cast(int, (float)(v))))
#define DPPF(oldv, srcv, ctrl, rmask) __builtin_bit_cast(float, __builtin_amdgcn_update_dpp(__builtin_bit_cast(int, (float)(oldv)), __builtin_bit_cast(int, (float)(srcv)), (ctrl), (rmask), 0xf, false))
__device__ __forceinline__ float wave_scan_add(float v) {
    v += DPPF(0.f, v, 0x111, 0xf); v += DPPF(0.f, v, 0x112, 0xf); v += DPPF(0.f, v, 0x114, 0xf); v += DPPF(0.f, v, 0x118, 0xf);
    v += DPPF(0.f, v, 0x142, 0xa); v += DPPF(0.f, v, 0x143, 0xc);
    return v;
}
__device__ __forceinline__ float wave_scan_max(float v) {
    const float ni = -3.0e38f;
    v = fmaxf(v, DPPF(ni, v, 0x111, 0xf)); v = fmaxf(v, DPPF(ni, v, 0x112, 0xf)); v = fmaxf(v, DPPF(ni, v, 0x114, 0xf)); v = fmaxf(v, DPPF(ni, v, 0x118, 0xf));
    v = fmaxf(v, DPPF(ni, v, 0x142, 0xa)); v = fmaxf(v, DPPF(ni, v, 0x143, 0xc));
    return v;
}
__device__ __forceinline__ float wave_sum(float v) { return __builtin_bit_cast(float, __builtin_amdgcn_readlane(__builtin_bit_cast(int, wave_scan_add(v)), 63)); }

#define XB_TMO      128
#define XB_XCNT(j)  (256  + 64 * (j))
#define XB_XSUB(j)  (1280 + 64 * (j))
#define XB_XGEN(j)  (2304 + 64 * (j))
#define XB_TOP      3328
#define XB_TOPGEN   3392
#define XCD_BAR_WORDS 3456
#define XB_SPIN_CAP (1u << 21)

__device__ __forceinline__ unsigned xb_ld(unsigned* p)              { return __hip_atomic_load(p, __ATOMIC_RELAXED, __HIP_MEMORY_SCOPE_AGENT); }
__device__ __forceinline__ unsigned xb_add(unsigned* p, unsigned v) { return __hip_atomic_fetch_add(p, v, __ATOMIC_RELAXED, __HIP_MEMORY_SCOPE_AGENT); }
__device__ __forceinline__ unsigned xb_xcc_id() { return (unsigned)__builtin_amdgcn_s_getreg((3 << 11) | 20) & 0xFu; }
#define XB_SPIN(cond, bar) do { unsigned _sp = 0; while (cond) { __builtin_amdgcn_s_sleep(1); \
    if ((++_sp & 255u) == 0u) { if (xb_ld(&(bar)[XB_TMO])) break; if (_sp > XB_SPIN_CAP) { atomicAdd(&(bar)[XB_TMO], 1u); break; } } } } while (0)

struct XcdBarrier {
    unsigned* bar; unsigned x;
    volatile LAS unsigned* st;
};
__device__ __forceinline__ XcdBarrier xcd_barrier_post(unsigned* bar, volatile LAS unsigned* st) {
    XcdBarrier b; b.bar = bar; b.x = xb_xcc_id(); b.st = st;
    if (threadIdx.x == 0) (void)xb_add(&bar[XB_XCNT(b.x)], 1u);
    return b;
}
__device__ __forceinline__ void xcd_barrier_complete(unsigned* bar, unsigned x, unsigned& nloc, unsigned& nx) {
    const unsigned G = gridDim.x * gridDim.y * gridDim.z;
    unsigned sum, cnt, mine, sp = 0u;
    for (;;) {
        sum = 0u; cnt = 0u; mine = 0u;
#pragma unroll
        for (unsigned j = 0; j < 16; ++j) { const unsigned c = xb_ld(&bar[XB_XCNT(j)]); sum += c; cnt += (c > 0u) ? 1u : 0u; mine = (j == x) ? c : mine; }
        if (sum == G) break;
        __builtin_amdgcn_s_sleep(1);
        if ((++sp & 255u) == 0u) { if (xb_ld(&bar[XB_TMO])) break; if (sp > XB_SPIN_CAP) { atomicAdd(&bar[XB_TMO], 1u); break; } }
    }
    nloc = mine > 0u ? mine : 1u; nx = cnt > 0u ? cnt : 1u;
}
__device__ __forceinline__ void xcd_barrier(const XcdBarrier& b, const bool leader) {
    asm volatile("s_waitcnt vmcnt(0)" ::: "memory");
    __syncthreads();
    if (leader) {
        size_t bo_ = 0; asm volatile("" : "+s"(bo_)); unsigned* bar = b.bar + bo_;
        __builtin_amdgcn_s_waitcnt(0);
        unsigned nloc = b.st[0], nx = b.st[1];
        if (nloc == 0u) { xcd_barrier_complete(bar, b.x, nloc, nx); b.st[0] = nloc; b.st[1] = nx; }
        const unsigned old = xb_add(&bar[XB_XSUB(b.x)], 1u);
        const unsigned gen = old / nloc;
        if (old + 1u == (gen + 1u) * nloc) {
            __builtin_amdgcn_fence(__ATOMIC_RELEASE, "agent");
            asm volatile("s_waitcnt vmcnt(0)" ::: "memory");
            const unsigned og = xb_add(&bar[XB_TOP], 1u);
            const unsigned tg = og / nx;
            if (og + 1u == (tg + 1u) * nx) xb_add(&bar[XB_TOPGEN], 1u);
            else XB_SPIN(xb_ld(&bar[XB_TOPGEN]) == tg, bar);
            __builtin_amdgcn_fence(__ATOMIC_ACQUIRE, "agent");
            xb_add(&bar[XB_XGEN(b.x)], 1u);
            asm volatile("s_waitcnt vmcnt(0)" ::: "memory");
        } else {
            XB_SPIN(xb_ld(&bar[XB_XGEN(b.x)]) == gen, bar);
            __builtin_amdgcn_fence(__ATOMIC_ACQUIRE, "agent");
            asm volatile("s_waitcnt vmcnt(0)" ::: "memory");
        }
    }
    __syncthreads();
}

using pg8::Unit; using pg8::u32x4; using pg8::cvt_pk_bf16; using pg8::xw_a; using pg8::xw_b;
struct EpiSsdIn {
    static constexpr bool PERM = true, AFTER_DRAIN = false;
    bf16* Z; bf16* XBC; float* DT;
    __device__ __forceinline__ void operator()(const f32x4 (&acc)[2][2][4][2], const Unit& u, int wr, int wc, int fr, int fq) const {
        if (u.pn < 40) {
            bf16* base; int ldc, colt;
            if (u.pn < 16) { base = Z; ldc = 4096; colt = u.pn * 256; } else { base = XBC; ldc = 6144; colt = (u.pn - 16) * 256; }
            const int rowx = u.pm * 256 + wr * 64 + (fr & 7), colx = colt + wc * 64 + 8 * fq + 32 * (fr >> 3);
#pragma unroll
            for (int ai = 0; ai < 2; ++ai)
#pragma unroll
                for (int m = 0; m < 4; ++m) { bf16* rowp = base + (size_t)(rowx + ai * 128 + m * 16) * ldc + colx; u32x4 w[2];
#pragma unroll
                    for (int bj = 0; bj < 2; ++bj) { const f32x4 v0 = acc[ai][bj][m][0], v1 = acc[ai][bj][m][1];
                        w[bj].x = cvt_pk_bf16(v0[0], v0[1]); w[bj].y = cvt_pk_bf16(v0[2], v0[3]); w[bj].z = cvt_pk_bf16(v1[0], v1[1]); w[bj].w = cvt_pk_bf16(v1[2], v1[3]); }
                    *(u32x4*)(rowp) = xw_a(w[0], w[1]); *(u32x4*)(rowp + (size_t)8 * ldc) = xw_b(w[0], w[1]); }
        } else if (wc == 0) {
            const int row0 = u.pm * 256 + wr * 64 + fr;
#pragma unroll
            for (int ai = 0; ai < 2; ++ai)
#pragma unroll
                for (int m = 0; m < 4; ++m) { float* rowp = DT + (size_t)(row0 + ai * 128 + m * 16) * 64 + 8 * fq;
#pragma unroll
                    for (int bj = 0; bj < 2; ++bj) { *(f32x4*)(rowp + 32 * bj) = acc[ai][bj][m][0]; *(f32x4*)(rowp + 32 * bj + 4) = acc[ai][bj][m][1]; } }
        }
    }
};
struct EpiMlIn {
    static constexpr bool PERM = true, AFTER_DRAIN = false;
    bf16* XM; size_t tstride; float* GATES;
    __device__ __forceinline__ void operator()(const f32x4 (&acc)[2][2][4][2], const Unit& u, int wr, int wc, int fr, int fq) const {
        const int row0 = u.pm * 256 + wr * 64 + fr;
        if (u.pn < 48) {
            bf16* base = XM + (size_t)(u.pn >> 4) * tstride;
            const int rowx = u.pm * 256 + wr * 64 + (fr & 7), colx = (u.pn & 15) * 256 + wc * 64 + 8 * fq + 32 * (fr >> 3);
#pragma unroll
            for (int ai = 0; ai < 2; ++ai)
#pragma unroll
                for (int m = 0; m < 4; ++m) { bf16* rowp = base + (size_t)(rowx + ai * 128 + m * 16) * 4096 + colx; u32x4 w[2];
#pragma unroll
                    for (int bj = 0; bj < 2; ++bj) { const f32x4 v0 = acc[ai][bj][m][0], v1 = acc[ai][bj][m][1];
                        w[bj].x = cvt_pk_bf16(v0[0], v0[1]); w[bj].y = cvt_pk_bf16(v0[2], v0[3]); w[bj].z = cvt_pk_bf16(v1[0], v1[1]); w[bj].w = cvt_pk_bf16(v1[2], v1[3]); }
                    *(u32x4*)(rowp) = xw_a(w[0], w[1]); *(u32x4*)(rowp + 8 * 4096) = xw_b(w[0], w[1]); }
        } else if (wc == 0 && fq < 2) {
#pragma unroll
            for (int ai = 0; ai < 2; ++ai)
#pragma unroll
                for (int m = 0; m < 4; ++m) { float* rowp = GATES + (size_t)(row0 + ai * 128 + m * 16) * 16 + 8 * fq;
                    *(f32x4*)(rowp) = acc[ai][0][m][0]; *(f32x4*)(rowp + 4) = acc[ai][0][m][1]; }
        }
    }
};
template <int MODE> struct EpiHead {
    static constexpr bool PERM = true, AFTER_DRAIN = false;
    bf16* O0; bf16* O1; float scale0;
    __device__ __forceinline__ void operator()(const f32x4 (&acc)[2][2][4][2], const Unit& u, int wr, int wc, int fr, int fq) const {
        bf16* base; int colt; float sc = 1.f;
        if (MODE == 0) { base = O0; colt = u.pn * 256; }
        else { const int head = u.pn >> 2, sub = u.pn & 3; if (sub < 2) { base = O0; colt = head * 512 + sub * 256; sc = scale0; } else { base = O1; colt = head * 512 + (sub - 2) * 256; } }
        const int rowx = u.pm * 256 + wr * 64 + (fr & 7), colx = colt + wc * 64 + 8 * fq + 32 * (fr >> 3);
#pragma unroll
        for (int ai = 0; ai < 2; ++ai)
#pragma unroll
            for (int m = 0; m < 4; ++m) { bf16* rowp = base + (size_t)(rowx + ai * 128 + m * 16) * 4096 + colx; u32x4 w[2];
#pragma unroll
                for (int bj = 0; bj < 2; ++bj) { const f32x4 v0 = acc[ai][bj][m][0] * sc, v1 = acc[ai][bj][m][1] * sc;
                    w[bj].x = cvt_pk_bf16(v0[0], v0[1]); w[bj].y = cvt_pk_bf16(v0[2], v0[3]); w[bj].z = cvt_pk_bf16(v1[0], v1[1]); w[bj].w = cvt_pk_bf16(v1[2], v1[3]); }
                *(u32x4*)(rowp) = xw_a(w[0], w[1]); *(u32x4*)(rowp + 8 * 4096) = xw_b(w[0], w[1]); }
    }
};
struct EpiResid {
    static constexpr bool PERM = true, AFTER_DRAIN = false;
    const bf16* XB; bf16* V; float alpha; float* SLAB;
    __device__ __forceinline__ void operator()(const f32x4 (&acc)[2][2][4][2], const Unit& u, int wr, int wc, int fr, int fq) const {
        const int row0 = u.pm * 256 + wr * 64 + fr, col0 = u.pn * 256 + wc * 64 + 8 * fq;
        if (u.kq >= 0) {
#pragma unroll
            for (int ai = 0; ai < 2; ++ai)
#pragma unroll
                for (int m = 0; m < 4; ++m) { float* sp = SLAB + ((size_t)u.kq * M_S + (row0 + ai * 128 + m * 16 - M_P)) * DM + col0;
#pragma unroll
                    for (int bj = 0; bj < 2; ++bj) { *(f32x4*)(sp + bj * 32) = acc[ai][bj][m][0]; *(f32x4*)(sp + bj * 32 + 4) = acc[ai][bj][m][1]; } }
            return;
        }
#pragma unroll
        for (int ai = 0; ai < 2; ++ai)
#pragma unroll
            for (int m = 0; m < 4; ++m) { const size_t off = (size_t)(row0 + ai * 128 + m * 16) * DM + col0; u32x4 w[2];
#pragma unroll
                for (int bj = 0; bj < 2; ++bj) { const v4u xw = *(const v4u*)(XB + off + bj * 32); const f32x4 v0 = acc[ai][bj][m][0], v1 = acc[ai][bj][m][1];
                    w[bj].x = cvt_pk_bf16(alpha * bflo(xw.x) + v0[0], alpha * bfhi(xw.x) + v0[1]); w[bj].y = cvt_pk_bf16(alpha * bflo(xw.y) + v0[2], alpha * bfhi(xw.y) + v0[3]);
                    w[bj].z = cvt_pk_bf16(alpha * bflo(xw.z) + v1[0], alpha * bfhi(xw.z) + v1[1]); w[bj].w = cvt_pk_bf16(alpha * bflo(xw.w) + v1[2], alpha * bfhi(xw.w) + v1[3]); }
                bf16* vp = V + (size_t)(u.pm * 256 + wr * 64 + (fr & 7) + ai * 128 + m * 16) * DM + col0 + 32 * (fr >> 3);
                *(u32x4*)(vp) = xw_a(w[0], w[1]); *(u32x4*)(vp + 8 * DM) = xw_b(w[0], w[1]); }
    }
};

__device__ __forceinline__ void transpose_item(const float* W, int ldw, int nvalid, int K, bf16* WT, int kb, int nb, LAS float* scr, int lane) {
    const int k0 = 64 * kb, n0 = 32 * nb;
    const int n4 = (lane & 7) * 4, nn = n0 + n4;
    f32x4 wv[8];
#pragma unroll
    for (int i = 0; i < 8; ++i) { const int kk = (lane >> 3) + 8 * i; wv[i] = nn < nvalid ? *(const f32x4*)(W + (size_t)(k0 + kk) * ldw + nn) : (f32x4){0.f, 0.f, 0.f, 0.f}; }
#pragma unroll
    for (int i = 0; i < 8; ++i) { const int kk = (lane >> 3) + 8 * i; LAS float* d = scr + kk * 33 + n4; d[0] = wv[i][0]; d[1] = wv[i][1]; d[2] = wv[i][2]; d[3] = wv[i][3]; }
    LDS_WAIT(); asm volatile("" ::: "memory");
    const int c = lane & 7;
#pragma unroll
    for (int j = 0; j < 4; ++j) { const int n = (lane >> 3) + 8 * j; const LAS float* s = scr + (8 * c) * 33 + n;
        v4u o; o.x = pk2(s[0 * 33], s[1 * 33]); o.y = pk2(s[2 * 33], s[3 * 33]); o.z = pk2(s[4 * 33], s[5 * 33]); o.w = pk2(s[6 * 33], s[7 * 33]);
        *(v4u*)(WT + (size_t)(n0 + n) * K + k0 + 8 * c) = o; }
    LDS_WAIT(); asm volatile("" ::: "memory");
}

typedef short bf16x8 __attribute__((ext_vector_type(8)));
typedef short v4s __attribute__((ext_vector_type(4)));
__device__ __forceinline__ bf16x8 lds_tr_frag(LAS unsigned char* img, int stride, int krow0, int q, int colbyte) {
    const v4s lo = __builtin_amdgcn_ds_read_tr16_b64_v4i16((LAS v4s*)(img + (krow0 + q) * stride + colbyte));
    const v4s hi = __builtin_amdgcn_ds_read_tr16_b64_v4i16((LAS v4s*)(img + (krow0 + 4 + q) * stride + colbyte));
    return (bf16x8){lo[0], lo[1], lo[2], lo[3], hi[0], hi[1], hi[2], hi[3]};
}
__device__ __forceinline__ void ml_gate_scalars(const float* GATES, int r0, int Lv, int hd, float bi, float bfv, int lane, float& b, float& a, float& pm) {
    float lf = 0.f, li = -1e30f;
    if (lane < Lv) { const float* gp = GATES + (size_t)(r0 + lane) * 16; li = gp[hd] + bi; lf = logsigmoid_f(gp[8 + hd] + bfv); }
    b = wave_scan_add(lf);
    a = li - b; pm = wave_scan_max(a);
}
template <int C> __device__ __forceinline__ void conv_pass(const bf16* raw, bf16* outp, const float* cw, const float* cb, const float* st_in, float* so_p, float* so_s, size_t gtid, size_t NGT) {
    constexpr int NCH = C / 8, NBLK = M / 16;
    for (size_t it = gtid; it < (size_t)NBLK * NCH; it += NGT) {
        const int rb = (int)(it / NCH), c0 = (int)(it % NCH) * 8;
        int s, t0; if (rb < M_P / 16) { s = rb >> 9; t0 = (rb & 511) * 16; } else { s = NB_P + (rb - M_P / 16); t0 = 0; }
        const int row0 = rb * 16;
        const bool lastblk = (s >= NB_P) || ((rb & 511) == 511);
        v4u rw[16];
#pragma unroll
        for (int r = 0; r < 16; ++r) rw[r] = *(const v4u*)(raw + (size_t)(row0 + r) * C + c0);
        float h0[8], h1[8], h2[8];
        if (t0 > 0) { const v4u a = *(const v4u*)(raw + (size_t)(row0 - 3) * C + c0), b = *(const v4u*)(raw + (size_t)(row0 - 2) * C + c0), c = *(const v4u*)(raw + (size_t)(row0 - 1) * C + c0);
            h0[0] = bflo(a.x); h0[1] = bfhi(a.x); h0[2] = bflo(a.y); h0[3] = bfhi(a.y); h0[4] = bflo(a.z); h0[5] = bfhi(a.z); h0[6] = bflo(a.w); h0[7] = bfhi(a.w);
            h1[0] = bflo(b.x); h1[1] = bfhi(b.x); h1[2] = bflo(b.y); h1[3] = bfhi(b.y); h1[4] = bflo(b.z); h1[5] = bfhi(b.z); h1[6] = bflo(b.w); h1[7] = bfhi(b.w);
            h2[0] = bflo(c.x); h2[1] = bfhi(c.x); h2[2] = bflo(c.y); h2[3] = bfhi(c.y); h2[4] = bflo(c.z); h2[5] = bfhi(c.z); h2[6] = bflo(c.w); h2[7] = bfhi(c.w);
        } else if (s >= NB_P) { const float* sp = st_in + (size_t)(s - NB_P) * 3 * C + c0;
#pragma unroll
            for (int e = 0; e < 8; ++e) { h0[e] = sp[e]; h1[e] = sp[C + e]; h2[e] = sp[2 * C + e]; }
        } else {
#pragma unroll
            for (int e = 0; e < 8; ++e) { h0[e] = 0.f; h1[e] = 0.f; h2[e] = 0.f; } }
        float w0[8], w1[8], w2[8], w3[8], bb[8];
#pragma unroll
        for (int e = 0; e < 8; ++e) { w0[e] = cw[c0 + e]; w1[e] = cw[C + c0 + e]; w2[e] = cw[2 * C + c0 + e]; w3[e] = cw[3 * C + c0 + e]; bb[e] = cb[c0 + e]; }
#pragma unroll
        for (int r = 0; r < 16; ++r) {
            const v4u w = rw[r]; const float x[8] = {bflo(w.x), bfhi(w.x), bflo(w.y), bfhi(w.y), bflo(w.z), bfhi(w.z), bflo(w.w), bfhi(w.w)};
            float y[8];
#pragma unroll
            for (int e = 0; e < 8; ++e) { y[e] = silu_f(bb[e] + w0[e] * h0[e] + w1[e] * h1[e] + w2[e] * h2[e] + w3[e] * x[e]); h0[e] = h1[e]; h1[e] = h2[e]; h2[e] = x[e]; }
            v4u o; o.x = pk2(y[0], y[1]); o.y = pk2(y[2], y[3]); o.z = pk2(y[4], y[5]); o.w = pk2(y[6], y[7]);
            *(v4u*)(outp + (size_t)(row0 + r) * C + c0) = o;
        }
        if (lastblk) { float* so = (s < NB_P ? so_p + (size_t)s * 3 * C : so_s + (size_t)(s - NB_P) * 3 * C) + c0;
#pragma unroll
            for (int e = 0; e < 8; ++e) { so[e] = h0[e]; so[C + e] = h1[e]; so[2 * C + e] = h2[e]; } }
    }
}
struct Args { const float* in[29]; float* out; unsigned char* ws; int ph_lo, ph_hi; };

__device__ __forceinline__ int stream_T(int s) { return s < NB_P ? T_P : T_S; }
__device__ __forceinline__ int stream_row0(int s) { return s < NB_P ? s * T_P : M_P + (s - NB_P) * T_S; }

__global__ void __launch_bounds__(NWAVES * 64, 2) mk_fwd(Args args) {
    extern __shared__ __attribute__((aligned(16))) unsigned char lds_raw[];
    LAS unsigned char* lds = (LAS unsigned char*)lds_raw;
    volatile LAS unsigned* MISC = (volatile LAS unsigned*)(lds + MISC_OFF);
    const int G = gridDim.x, bx = blockIdx.x;
    const int wave0 = __builtin_amdgcn_readfirstlane((int)threadIdx.x >> 6);
    const int NGW = G * NWAVES; const size_t NGT = (size_t)G * (NWAVES * 64);
#define SITE_VARS() int lane__; asm volatile("v_mbcnt_lo_u32_b32 %0, -1, 0\n\tv_mbcnt_hi_u32_b32 %0, -1, %0" : "=v"(lane__)); int tid_ = wave0 * 64 + lane__; asm volatile("" : "+v"(tid_)); const int tid = tid_, lane = tid & 63, wave = __builtin_amdgcn_readfirstlane(tid >> 6); \
    const int gw = bx * NWAVES + wave; const size_t gtid = (size_t)bx * (NWAVES * 64) + tid; (void)lane; (void)gw; (void)gtid
    unsigned char* ws0 = args.ws; unsigned char* ws = ws0;
    unsigned* ctl = (unsigned*)(ws + WS_CTL);
    float* out0 = args.out; float* out = out0; (void)out;

    for (int u = threadIdx.x; u < (LDS_BYTES - RING_BYTES) / 4; u += NWAVES * 64) ((LAS unsigned*)(lds + RING_BYTES))[u] = 0u;
    __syncthreads();
#if MK_ONE_LAUNCH
    XcdBarrier bar = xcd_barrier_post(ctl + CW_BAR, MISC + 8);
#define GRID_BAR() do { int lane__; asm volatile("v_mbcnt_lo_u32_b32 %0, -1, 0\n\tv_mbcnt_hi_u32_b32 %0, -1, %0" : "=v"(lane__)); xcd_barrier(bar, wave0 == 0 && lane__ == 0); } while (0)
#else
#define GRID_BAR() do { } while (0)
#endif
    const int lo = args.ph_lo, hi = args.ph_hi;
#define IN(k) (lo <= (k) && (k) < hi)
#define SEAM(a, b) do { if (IN(a) && IN(b)) GRID_BAR(); } while (0)

    const float* x_prompt = args.in[0]; const float* x_sample = args.in[1];
    const float* st_sconv = args.in[2]; const float* st_sh = args.in[3]; const float* st_mconv = args.in[4];
    const float* st_mC = args.in[5]; const float* st_mn = args.in[6]; const float* st_mm = args.in[7];
    bf16* XB = (bf16*)(ws + WS_XB);

    if (IN(0)) {
        SITE_VARS();
        LAS float* scr = (LAS float*)(lds + wave * 16384);
        constexpr int I_SIN = 32 * (SSD_NPAD / 32), I_SOUT = 64 * 64, I_MIN = 32 * (ML_NPAD / 32), I_H = 8 * 16, I_MOUT = 64 * 64;
        constexpr int PER_L = I_SIN + I_SOUT + I_MIN + 3 * 8 * I_H + I_MOUT;
        for (int it = gw; it < 2 * PER_L; it += NGW) {
            const int j = it / PER_L; int r = it % PER_L;
            if (r < I_SIN) { const int nbn = SSD_NPAD / 32; transpose_item(args.in[8] + (size_t)j * DM * SSD_PROJ, SSD_PROJ, SSD_PROJ, DM, (bf16*)(ws + WS_WSSD_IN) + (size_t)j * SSD_NPAD * DM, r / nbn, r % nbn, scr, lane); continue; } r -= I_SIN;
            if (r < I_SOUT) { transpose_item(args.in[15] + (size_t)j * SSD_INNER * DM, DM, DM, SSD_INNER, (bf16*)(ws + WS_WSSD_OUT) + (size_t)j * DM * SSD_INNER, r / 64, r % 64, scr, lane); continue; } r -= I_SOUT;
            if (r < I_MIN) { const int nbn = ML_NPAD / 32; transpose_item(args.in[16] + (size_t)j * DM * ML_PROJ, ML_PROJ, ML_PROJ, DM, (bf16*)(ws + WS_WML_IN) + (size_t)j * ML_NPAD * DM, r / nbn, r % nbn, scr, lane); continue; } r -= I_MIN;
            if (r < 3 * 8 * I_H) { const int which = r / (8 * I_H), rr = r % (8 * I_H), head = rr / I_H, it2 = rr % I_H;
                const float* W = args.in[19 + which] + ((size_t)(j * 8 + head) * 512) * 512;
                bf16* WT = which == 2 ? (bf16*)(ws + WS_WML_V) + ((size_t)j * 4096 + head * 512) * 512
                                      : (bf16*)(ws + WS_WML_QK) + ((size_t)j * 8192 + head * 1024 + which * 512) * 512;
                transpose_item(W, 512, 512, 512, WT, it2 / 16, it2 % 16, scr, lane); continue; } r -= 3 * 8 * I_H;
            transpose_item(args.in[26] + (size_t)j * ML_INNER * DM, DM, DM, ML_INNER, (bf16*)(ws + WS_WML_OUT) + (size_t)j * DM * ML_INNER, r / 64, r % 64, scr, lane);
        }
        for (size_t i = gtid; i < (size_t)M * DM / 8; i += NGT) {
            const size_t e = i * 8;
            const float* src = e < (size_t)M_P * DM ? x_prompt + e : x_sample + (e - (size_t)M_P * DM);
            const f32x4 a = *(const f32x4*)src, b = *(const f32x4*)(src + 4);
            v4u o; o.x = pk2(a[0], a[1]); o.y = pk2(a[2], a[3]); o.z = pk2(b[0], b[1]); o.w = pk2(b[2], b[3]);
            *(v4u*)(XB + e) = o;
        }
    }
    SEAM(0, 1);

    for (int jp = 0; jp < 2; ++jp) {
        {
            const int li = 2 * jp, pb = 1 + 8 * li, j = jp;
            size_t lo_ = 0; asm volatile("" : "+s"(lo_)); unsigned char* ws = ws0 + lo_; float* out = out0 + lo_;
            bf16* Z = (bf16*)(ws + WS_S_Z); bf16* XBC = (bf16*)(ws + WS_S_XBC); bf16* Y = (bf16*)(ws + WS_S_Y); bf16* XBCC = (bf16*)(ws + WS_S_XBCC); float* DT = (float*)(ws + WS_S_DT); bf16* VPRE = (bf16*)(ws + WS_S_VPRE); float* SLAB = (float*)(ws + WS_S_VPRE + 136 * MiB);
            const float* conv_w = args.in[9] + (size_t)j * 4 * SSD_CONVD; const float* conv_b = args.in[10] + (size_t)j * SSD_CONVD;
            if (IN(pb + 0)) {
                SITE_VARS();
                pg8::Gemm g{XB, (const bf16*)(ws + WS_WSSD_IN) + (size_t)j * SSD_NPAD * DM, DM, DM, -1};
                pg8::StaticOrder S; S.init(NPANEL, SSD_NPAD / 256, G, bx);
                EpiSsdIn E{Z, XBC, DT};
                pg8::gemm_phase<EpiSsdIn, pg8::StaticOrder, PG8_ALIGN, PG8_SP2>(lds, g, S, E, tid);
            }
            SEAM(pb + 0, pb + 1);
            if (IN(pb + 1)) {
                SITE_VARS();
                conv_pass<SSD_CONVD>(XBC, XBCC, conv_w, conv_b, st_sconv + (size_t)j * NB_S * 3 * SSD_CONVD, out + O_P_SCONV + (size_t)j * NB_P * 3 * SSD_CONVD, out + O_S_SCONV + (size_t)j * NB_S * 3 * SSD_CONVD, gtid, NGT);
            }
            SEAM(pb + 1, pb + 2);
            if (IN(pb + 2)) {
                SITE_VARS();
                const float* dt_bias = args.in[11] + j * 64; const float* A_log = args.in[12] + j * 64; const float* Dp = args.in[13] + j * 64;
                const int g4 = lane >> 4, l15 = lane & 15, q4 = l15 >> 2, p4 = lane & 3;
                LAS unsigned char* Xi = lds + SX_OFF; LAS unsigned char* XSi = lds + SXS_OFF; LAS unsigned char* Bi = lds + SB_OFF; LAS unsigned char* Ci = lds + SC_OFF;
                LAS unsigned char* Hi = lds + SH_OFF; LAS unsigned char* Wi = lds + SW_OFF;
                LAS float* cumS = (LAS float*)(lds + SS_OFF); LAS float* dtS = cumS + 64; LAS float* tailS = cumS + 128; LAS float* ecumS = cumS + 192;
                for (int u = bx; u < NSTREAM * SSD_NH; u += G) {
                    const int s = u >> 6, hd = u & 63, grp = hd >> 3;
                    const int T = stream_T(s), row0 = stream_row0(s), Lv = T < 64 ? T : 64, nch = T < 64 ? 1 : T / 64;
                    const float Aneg = -__expf(A_log[hd]), dtb = dt_bias[hd], Dh = Dp[hd];
                    f32x4 st[4];
                    if (s < NB_P) {
#pragma unroll
                        for (int pt = 0; pt < 4; ++pt) st[pt] = (f32x4){0.f, 0.f, 0.f, 0.f};
                    } else {
#pragma unroll
                        for (int pt = 0; pt < 4; ++pt) st[pt] = *(const f32x4*)(st_sh + (((size_t)(j * NB_S + (s - NB_P)) * SSD_NH + hd) * SSD_HD + pt * 16 + l15) * SSD_DS + wave * 16 + 4 * g4);
                    }
                    v4u xr, br[2], cr[2]; float dtr;
#define SSD_LOADS(cn) do { const char* xb_ = (const char*)(XBCC + ((size_t)row0 + (size_t)(cn) * 64) * SSD_CONVD + hd * 64); const char* db_ = (const char*)(DT + ((size_t)row0 + (size_t)(cn) * 64) * 64 + hd); \
    xr = *(const v4u*)(xb_ + xo_u); if ((tid >> 3) >= Lv) xr = (v4u){0u, 0u, 0u, 0u}; \
    br[0] = *(const v4u*)(xb_ + bo_u0); cr[0] = *(const v4u*)(xb_ + bo_u0 + 2048); br[1] = *(const v4u*)(xb_ + bo_u1); cr[1] = *(const v4u*)(xb_ + bo_u1 + 2048); \
    if ((tid >> 4) >= Lv) { br[0] = (v4u){0u, 0u, 0u, 0u}; cr[0] = (v4u){0u, 0u, 0u, 0u}; } if ((tid >> 4) + 32 >= Lv) { br[1] = (v4u){0u, 0u, 0u, 0u}; cr[1] = (v4u){0u, 0u, 0u, 0u}; } \
    dtr = *(const float*)(db_ + do_u); } while (0)
                    const unsigned xo_u = (unsigned)(((tid >> 3) < Lv ? (tid >> 3) : Lv - 1) * SSD_CONVD + (tid & 7) * 8) * 2u;
                    const unsigned bo_u0 = (unsigned)(((tid >> 4) < Lv ? (tid >> 4) : Lv - 1) * SSD_CONVD + 4096 - hd * 64 + grp * 128 + (tid & 15) * 8) * 2u;
                    const unsigned bo_u1 = (unsigned)(((tid >> 4) + 32 < Lv ? (tid >> 4) + 32 : Lv - 1) * SSD_CONVD + 4096 - hd * 64 + grp * 128 + (tid & 15) * 8) * 2u;
                    const unsigned do_u = (unsigned)((lane < Lv ? lane : Lv - 1) * 64) * 4u;
                    SSD_LOADS(0);
                    for (int c = 0; c < nch; ++c) {
                        const int r0 = row0 + c * 64;
                        if (wave == 0) {
                            float dtv = 0.f; if (lane < Lv) dtv = softplus_f(dtr + dtb);
                            const float cs = wave_scan_add(dtv * Aneg);
                            const float c63 = RDLANE(cs, 63);
                            cumS[lane] = cs * 1.44269504f; dtS[lane] = cs * 1.44269504f - __builtin_amdgcn_logf(dtv); tailS[lane] = __expf(c63 - cs) * dtv; ecumS[lane] = __expf(cs);
                            if (lane == 0) cumS[256] = __expf(c63);
                        }
                        __syncthreads();
                        { const int t = tid >> 3, c8 = (tid & 7) * 8; *(LAS v4u*)(Xi + t * ST64 + c8 * 2) = xr;
                          const float tl = tailS[t]; v4u o;
                          o.x = pk2(bflo(xr.x) * tl, bfhi(xr.x) * tl); o.y = pk2(bflo(xr.y) * tl, bfhi(xr.y) * tl); o.z = pk2(bflo(xr.z) * tl, bfhi(xr.z) * tl); o.w = pk2(bflo(xr.w) * tl, bfhi(xr.w) * tl);
                          *(LAS v4u*)(XSi + t * ST64 + c8 * 2) = o; }
#pragma unroll
                        for (int i = 0; i < 2; ++i) { const int e = tid + 512 * i, t = e >> 4, c8 = (e & 15) * 8; *(LAS v4u*)(Bi + t * ST128 + c8 * 2) = br[i]; *(LAS v4u*)(Ci + t * ST128 + c8 * 2) = cr[i]; }
#pragma unroll
                        for (int pt = 0; pt < 4; ++pt) { v2u w; w.x = pk2(st[pt][0], st[pt][1]); w.y = pk2(st[pt][2], st[pt][3]); *(LAS v2u*)(Hi + (pt * 16 + l15) * ST128 + (wave * 16 + 4 * g4) * 2) = w; }
                        __syncthreads();
                        SSD_LOADS(c + 1 < nch ? c + 1 : nch - 1);
                        {
                            const int si = wave >> 1;
                            bf16x8 af[4];
#pragma unroll
                            for (int kk = 0; kk < 4; ++kk) af[kk] = *(const LAS bf16x8*)(Bi + (si * 16 + l15) * ST128 + (kk * 32 + 8 * g4) * 2);
                            const f32x4 g_s = *(const LAS f32x4*)(dtS + si * 16 + 4 * g4);
#pragma unroll
                            for (int tj = 0; tj < 2; ++tj) {
                                const int ti = 2 * (wave & 1) + tj, t = ti * 16 + l15;
                                v2u w; w.x = 0u; w.y = 0u;
                                if (si <= ti) {
                                    f32x4 d = (f32x4){0.f, 0.f, 0.f, 0.f};
#pragma unroll
                                    for (int kk = 0; kk < 4; ++kk) { const bf16x8 bfr = *(const LAS bf16x8*)(Ci + t * ST128 + (kk * 32 + 8 * g4) * 2); d = __builtin_amdgcn_mfma_f32_16x16x32_bf16(af[kk], bfr, d, 0, 0, 0); }
                                    const float cum_t = cumS[t]; float wv[4];
#pragma unroll
                                    for (int r = 0; r < 4; ++r) wv[r] = d[r] * __builtin_amdgcn_exp2f(cum_t - g_s[r]);
                                    if (si == ti) {
#pragma unroll
                                        for (int r = 0; r < 4; ++r) { float w_ = wv[r]; asm volatile("" : "+v"(w_)); wv[r] = (4 * g4 + r <= l15) ? w_ : 0.f; } }
                                    w.x = pk2(wv[0], wv[1]); w.y = pk2(wv[2], wv[3]);
                                }
                                *(LAS v2u*)(Wi + t * ST64 + (si * 16 + 4 * g4) * 2) = w;
                            }
                        }
                        __syncthreads();
                        {
                            const int ti = wave >> 1, t = ti * 16 + l15;
                            bf16x8 cf[4], wf[2];
#pragma unroll
                            for (int kk = 0; kk < 4; ++kk) cf[kk] = *(const LAS bf16x8*)(Ci + t * ST128 + (kk * 32 + 8 * g4) * 2);
#pragma unroll
                            for (int ks = 0; ks < 2; ++ks) wf[ks] = *(const LAS bf16x8*)(Wi + t * ST64 + (ks * 32 + 8 * g4) * 2);
                            const float ec = ecumS[t];
#pragma unroll
                            for (int pj = 0; pj < 2; ++pj) {
                                const int pt = 2 * (wave & 1) + pj;
                                f32x4 d = (f32x4){0.f, 0.f, 0.f, 0.f};
#pragma unroll
                                for (int kk = 0; kk < 4; ++kk) { const bf16x8 hf = *(const LAS bf16x8*)(Hi + (pt * 16 + l15) * ST128 + (kk * 32 + 8 * g4) * 2); d = __builtin_amdgcn_mfma_f32_16x16x32_bf16(hf, cf[kk], d, 0, 0, 0); }
                                d = d * ec;
#pragma unroll
                                for (int ks = 0; ks < 2; ++ks) { if (ks == 0 || ti >= 2) { const bf16x8 xf = lds_tr_frag(Xi, ST64, ks * 32 + 8 * g4, q4, (pt * 16 + 4 * p4) * 2); d = __builtin_amdgcn_mfma_f32_16x16x32_bf16(xf, wf[ks], d, 0, 0, 0); } }
                                const v2u xw = *(const LAS v2u*)(Xi + t * ST64 + (pt * 16 + 4 * g4) * 2);
                                d[0] += Dh * bflo(xw.x); d[1] += Dh * bfhi(xw.x); d[2] += Dh * bflo(xw.y); d[3] += Dh * bfhi(xw.y);
                                if (t < Lv) { v2u o; o.x = pk2(d[0], d[1]); o.y = pk2(d[2], d[3]); *(v2u*)(Y + (size_t)(r0 + t) * SSD_INNER + hd * 64 + pt * 16 + 4 * g4) = o; }
                            }
                        }
                        {
                            const float dec = cumS[256];
                            bf16x8 bf2[2];
#pragma unroll
                            for (int ks = 0; ks < 2; ++ks) bf2[ks] = lds_tr_frag(Bi, ST128, ks * 32 + 8 * g4, q4, (wave * 16 + 4 * p4) * 2);
#pragma unroll
                            for (int pt = 0; pt < 4; ++pt) { st[pt] = st[pt] * dec;
#pragma unroll
                                for (int ks = 0; ks < 2; ++ks) { const bf16x8 xf = lds_tr_frag(XSi, ST64, ks * 32 + 8 * g4, q4, (pt * 16 + 4 * p4) * 2); st[pt] = __builtin_amdgcn_mfma_f32_16x16x32_bf16(bf2[ks], xf, st[pt], 0, 0, 0); } }
                        }
                        __syncthreads();
                    }
                    {
                        float* ho = s < NB_P ? out + O_P_SH + ((size_t)(j * NB_P + s) * SSD_NH + hd) * SSD_HD * SSD_DS : out + O_S_SH + ((size_t)(j * NB_S + (s - NB_P)) * SSD_NH + hd) * SSD_HD * SSD_DS;
#pragma unroll
                        for (int pt = 0; pt < 4; ++pt) *(f32x4*)(ho + (size_t)(pt * 16 + l15) * SSD_DS + wave * 16 + 4 * g4) = st[pt];
                    }
                }
            }
            SEAM(pb + 2, pb + 3);
            if (IN(pb + 3)) {
                SITE_VARS();
                const float* norm_w = args.in[14] + (size_t)j * SSD_INNER;
                for (int row = gw; row < M; row += NGW) {
                    const size_t off0 = (size_t)row * SSD_INNER + lane * 8;
                    v4u yw[8], zw[8];
#pragma unroll
                    for (int grp = 0; grp < 8; ++grp) { yw[grp] = *(const v4u*)(Y + off0 + grp * 512); zw[grp] = *(const v4u*)(Z + off0 + grp * 512); }
#pragma unroll
                    for (int grp = 0; grp < 8; ++grp) {
                        float v[8];
                        v[0] = bflo(yw[grp].x) * silu_f(bflo(zw[grp].x)); v[1] = bfhi(yw[grp].x) * silu_f(bfhi(zw[grp].x)); v[2] = bflo(yw[grp].y) * silu_f(bflo(zw[grp].y)); v[3] = bfhi(yw[grp].y) * silu_f(bfhi(zw[grp].y));
                        v[4] = bflo(yw[grp].z) * silu_f(bflo(zw[grp].z)); v[5] = bfhi(yw[grp].z) * silu_f(bfhi(zw[grp].z)); v[6] = bflo(yw[grp].w) * silu_f(bflo(zw[grp].w)); v[7] = bfhi(yw[grp].w) * silu_f(bfhi(zw[grp].w));
                        float ss = 0.f;
#pragma unroll
                        for (int i = 0; i < 8; ++i) ss += v[i] * v[i];
                        const float r = rsqrtf(wave_sum(ss) * (1.f / 512.f) + RMS_EPS);
                        const f32x4 n0 = *(const f32x4*)(norm_w + grp * 512 + lane * 8), n1 = *(const f32x4*)(norm_w + grp * 512 + lane * 8 + 4);
                        v4u o; o.x = pk2(v[0] * r * n0[0], v[1] * r * n0[1]); o.y = pk2(v[2] * r * n0[2], v[3] * r * n0[3]); o.z = pk2(v[4] * r * n1[0], v[5] * r * n1[1]); o.w = pk2(v[6] * r * n1[2], v[7] * r * n1[3]);
                        *(v4u*)(Y + off0 + grp * 512) = o;
                    }
                }
            }
            SEAM(pb + 3, pb + 4);
            if (IN(pb + 4)) {
                SITE_VARS();
                pg8::Gemm g{Y, (const bf16*)(ws + WS_WSSD_OUT) + (size_t)j * DM * SSD_INNER, SSD_INNER, SSD_INNER, -1};
                pg8::SplitTailOrder S; S.init(M_P / 256, DM / 256, M_S / 256, G, bx, WGM_OUT);
                EpiResid E{XB, VPRE, DN_ALPHA, SLAB};
                pg8::gemm_phase<EpiResid, pg8::SplitTailOrder, PG8_ALIGN, PG8_SP2, true>(lds, g, S, E, tid);
            }
            SEAM(pb + 4, pb + 5);
            if (IN(pb + 5)) {
                SITE_VARS();
                const float* lg = args.in[27] + (size_t)li * DM; const float* lb = args.in[28] + (size_t)li * DM;
                for (int row = gw; row < M; row += NGW) {
                    const v4u* vr = (const v4u*)(VPRE + (size_t)row * DM) + lane;
                    const v4u* XBV = (const v4u*)XB;
                    float v[32]; float sm = 0.f;
#pragma unroll
                    for (int q = 0; q < 4; ++q) { v4u w = vr[64 * q]; if (row >= M_P) w = (XBV + (size_t)row * (DM / 8) + lane)[64 * q]; v[8 * q + 0] = bflo(w.x); v[8 * q + 1] = bfhi(w.x); v[8 * q + 2] = bflo(w.y); v[8 * q + 3] = bfhi(w.y); v[8 * q + 4] = bflo(w.z); v[8 * q + 5] = bfhi(w.z); v[8 * q + 6] = bflo(w.w); v[8 * q + 7] = bfhi(w.w); }
                    if (row >= M_P) {
#pragma unroll
                        for (int i = 0; i < 32; ++i) v[i] *= DN_ALPHA;
#pragma unroll
                        for (int kq = 0; kq < 4; ++kq)
#pragma unroll
                            for (int q = 0; q < 4; ++q) { const float* sp = SLAB + ((size_t)kq * M_S + (row - M_P)) * DM + 8 * (lane + 64 * q); const f32x4 s0 = *(const f32x4*)sp, s1 = *(const f32x4*)(sp + 4);
                                v[8 * q + 0] += s0[0]; v[8 * q + 1] += s0[1]; v[8 * q + 2] += s0[2]; v[8 * q + 3] += s0[3]; v[8 * q + 4] += s1[0]; v[8 * q + 5] += s1[1]; v[8 * q + 6] += s1[2]; v[8 * q + 7] += s1[3]; }
                    }
#pragma unroll
                    for (int i = 0; i < 32; ++i) sm += v[i];
                    const float mean = wave_sum(sm) * (1.f / DM); float s2 = 0.f;
#pragma unroll
                    for (int i = 0; i < 32; ++i) { v[i] -= mean; s2 += v[i] * v[i]; }
                    const float rstd = rsqrtf(wave_sum(s2) * (1.f / DM) + LN_EPS);
#pragma unroll
                    for (int q = 0; q < 4; ++q) { const int c = 8 * (lane + 64 * q); const f32x4 g0 = *(const f32x4*)(lg + c), g1 = *(const f32x4*)(lg + c + 4), b0 = *(const f32x4*)(lb + c), b1 = *(const f32x4*)(lb + c + 4);
                        f32x4 o0, o1;
#pragma unroll
                        for (int e = 0; e < 4; ++e) { o0[e] = v[8 * q + e] * rstd * g0[e] + b0[e]; o1[e] = v[8 * q + 4 + e] * rstd * g1[e] + b1[e]; }
                        v4u w; w.x = pk2(o0[0], o0[1]); w.y = pk2(o0[2], o0[3]); w.z = pk2(o1[0], o1[1]); w.w = pk2(o1[2], o1[3]); *(v4u*)(XB + (size_t)row * DM + c) = w; }
                }
            }
            SEAM(pb + 5, pb + 8);
        }
        {
            const int li = 2 * jp + 1, pb = 1 + 8 * li, j = jp;
            size_t lo_ = 0; asm volatile("" : "+s"(lo_)); unsigned char* ws = ws0 + lo_; float* out = out0 + lo_;
            bf16* XM = (bf16*)(ws + WS_M_XM); bf16* Q = (bf16*)(ws + WS_M_Q); bf16* YG = (bf16*)(ws + WS_M_YG); bf16* Z = (bf16*)(ws + WS_M_Z); bf16* O = (bf16*)(ws + WS_M_O);
            bf16* XC = (bf16*)(ws + WS_M_XC); bf16* Kb = (bf16*)(ws + WS_M_K); bf16* Vb = (bf16*)(ws + WS_M_V); bf16* H = (bf16*)(ws + WS_M_H);
            float* GATES = (float*)(ws + WS_M_GATES); bf16* VPRE = (bf16*)(ws + WS_M_VPRE); float* SLAB = (float*)(ws + WS_M_VPRE + 136 * MiB);
            bf16* Sg = (bf16*)(ws + WS_M_S); float* TOK = (float*)(ws + WS_M_TOK); float* CHK = (float*)(ws + WS_M_CHK); float* CHP = (float*)(ws + WS_M_CHP); float* MPREV = (float*)(ws + WS_M_CHK + 768 * 1024);
            if (IN(pb + 0)) {
                SITE_VARS();
                pg8::Gemm g{XB, (const bf16*)(ws + WS_WML_IN) + (size_t)j * ML_NPAD * DM, DM, DM, -1};
                pg8::StaticOrder S; S.init(NPANEL, ML_NPAD / 256, G, bx);
                static_assert(WS_M_Z - WS_M_XM == ACT_U && WS_M_O - WS_M_Z == ACT_U, "XM | Z | O equally spaced");
                EpiMlIn E{XM, ACT_U / 2, GATES};
                pg8::gemm_phase<EpiMlIn, pg8::StaticOrder, PG8_ALIGN, PG8_SP2>(lds, g, S, E, tid);
            }
            SEAM(pb + 0, pb + 1);
            if (IN(pb + 1)) {
                SITE_VARS();
                const float* conv_w = args.in[17] + (size_t)j * 4 * ML_INNER; const float* conv_b = args.in[18] + (size_t)j * ML_INNER;
                conv_pass<ML_INNER>(XM, XC, conv_w, conv_b, st_mconv + (size_t)j * NB_S * 3 * ML_INNER, out + O_P_MCONV + (size_t)j * NB_P * 3 * ML_INNER, out + O_S_MCONV + (size_t)j * NB_S * 3 * ML_INNER, gtid, NGT);
                { const float* b_i = args.in[22] + j * 8; const float* b_f = args.in[23] + j * 8;
                  for (int it = gw; it < ML_NCHUNK * ML_NH; it += NGW) { const int ci = it >> 3, hd = it & 7; const int r0 = ci < 512 ? ci * 64 : M_P + (ci - 512) * 16, Lv = ci < 512 ? 64 : 16;
                      float b, a, pm; ml_gate_scalars(GATES, r0, Lv, hd, b_i[hd], b_f[hd], lane, b, a, pm);
                      if (lane == 63) { CHP[(ci * 8 + hd) * 2] = b; CHP[(ci * 8 + hd) * 2 + 1] = pm; } } }
                __syncthreads();
                pg8::Gemm g{XM, (const bf16*)(ws + WS_WML_V) + (size_t)j * 4096 * 512, ML_INNER, 512, 1};
                pg8::StaticOrder S; S.init(NPANEL, 16, G, bx, WGM_HEAD);
                EpiHead<0> E{Vb, nullptr, 1.f};
                pg8::gemm_phase<EpiHead<0>, pg8::StaticOrder, PG8_ALIGN, PG8_SP2>(lds, g, S, E, tid);
            }
            SEAM(pb + 1, pb + 2);
            if (IN(pb + 2)) {
                SITE_VARS();
                if (gw < NB_P * ML_NH) {
                    const int s = gw >> 3, hd = gw & 7;
                    const float blo = CHP[((s * 128 + lane) * 8 + hd) * 2], plo = CHP[((s * 128 + lane) * 8 + hd) * 2 + 1], bhi = CHP[((s * 128 + 64 + lane) * 8 + hd) * 2], phi = CHP[((s * 128 + 64 + lane) * 8 + hd) * 2 + 1];
                    float m = 0.f, mlo = 0.f, mhi = 0.f;
                    for (int cc = 0; cc < 128; ++cc) { if (cc < 64) { if (lane == cc) mlo = m; } else { if (lane == cc - 64) mhi = m; }
                        const float bb = RDLANE(cc < 64 ? blo : bhi, cc & 63), pp = RDLANE(cc < 64 ? plo : phi, cc & 63); m = bb + fmaxf(m, pp); }
                    MPREV[(s * 128 + lane) * 8 + hd] = mlo; MPREV[(s * 128 + 64 + lane) * 8 + hd] = mhi;
                }
                pg8::Gemm g{XC, (const bf16*)(ws + WS_WML_QK) + (size_t)j * 8192 * 512, ML_INNER, 512, 2};
                pg8::StaticOrder S; S.init(NPANEL, 32, G, bx, WGM_HEAD);
                EpiHead<1> E{Q, Kb, ML_QSCALE};
                pg8::gemm_phase<EpiHead<1>, pg8::StaticOrder, PG8_ALIGN, PG8_SP2>(lds, g, S, E, tid);
            }
            SEAM(pb + 2, pb + 3);
            if (IN(pb + 3)) {
                SITE_VARS();
                const int g4 = lane >> 4, l15 = lane & 15;
                const float* b_i = args.in[22] + j * 8; const float* b_f = args.in[23] + j * 8;
                LAS unsigned char* Qi = lds; LAS unsigned char* Ki = lds + 66560;
                LAS float* eS = (LAS float*)(lds + 133120); LAS float* aS = eS + 64; LAS float* denP = eS + 128;
                for (int u = bx; u < ML_NCHUNK * ML_NH; u += G) {
                    const int ci = u >> 3, hd = u & 7;
                    const int r0 = ci < 512 ? ci * 64 : M_P + (ci - 512) * 16, Lv = ci < 512 ? 64 : 16;
#pragma unroll
                    for (int i = 0; i < 8; ++i) { const int e = tid + 512 * i, t = e >> 6, c8 = (e & 63) * 8; v4u qv = (v4u){0u, 0u, 0u, 0u}, kv = (v4u){0u, 0u, 0u, 0u};
                        if (t < Lv) { qv = *(const v4u*)(Q + (size_t)(r0 + t) * ML_INNER + hd * 512 + c8); kv = *(const v4u*)(Kb + (size_t)(r0 + t) * ML_INNER + hd * 512 + c8); }
                        *(LAS v4u*)(Qi + t * 1040 + c8 * 2) = qv; *(LAS v4u*)(Ki + t * 1040 + c8 * 2) = kv; }
                    float gT = 0.f, emT = 1.f, tailT = 0.f;
                    if (wave == 0) {
                        float b, a, pm; ml_gate_scalars(GATES, r0, Lv, hd, b_i[hd], b_f[hd], lane, b, a, pm);
                        float mprev;
                        if (ci < 512) { mprev = MPREV[ci * 8 + hd];
                        } else mprev = st_mm[(size_t)(j * NB_S + (ci - 512)) * ML_NH + hd];
                        const float mt = b + fmaxf(mprev, pm);
                        const float b63 = RDLANE(b, 63), mnew = RDLANE(mt, 63);
                        eS[lane] = b - mt; aS[lane] = a;
                        gT = __expf(b + mprev - mt); emT = __expf(-mt); tailT = __expf(fminf(a + b63 - mnew, 0.f));
                        if (lane == 0) { CHK[(ci * 8 + hd) * 2] = __expf(b63 + mprev - mnew); CHK[(ci * 8 + hd) * 2 + 1] = mnew; }
                    }
                    __syncthreads();
                    {
                        const int ti = wave >> 1, t = ti * 16 + l15; const float et = eS[t]; float dsum = 0.f;
#pragma unroll
                        for (int sjj = 0; sjj < 2; ++sjj) {
                            const int sj = 2 * (wave & 1) + sjj; v2u w; w.x = 0u; w.y = 0u;
                            if (sj <= ti) {
                                f32x4 d = (f32x4){0.f, 0.f, 0.f, 0.f};
#pragma unroll
                                for (int kk = 0; kk < 16; ++kk) { const bf16x8 af = *(const LAS bf16x8*)(Ki + (sj * 16 + l15) * 1040 + (kk * 32 + 8 * g4) * 2), bfr = *(const LAS bf16x8*)(Qi + t * 1040 + (kk * 32 + 8 * g4) * 2);
                                    d = __builtin_amdgcn_mfma_f32_16x16x32_bf16(af, bfr, d, 0, 0, 0); }
                                const f32x4 as4 = *(const LAS f32x4*)(aS + sj * 16 + 4 * g4); float sv[4];
#pragma unroll
                                for (int r = 0; r < 4; ++r) { const int sidx = sj * 16 + 4 * g4 + r; sv[r] = sidx <= t ? d[r] * __expf(fminf(et + as4[r], 0.f)) : 0.f; dsum += sv[r]; }
                                w.x = pk2(sv[0], sv[1]); w.y = pk2(sv[2], sv[3]);
                            }
                            *(v2u*)(Sg + ((size_t)(ci * 8 + hd) * 64 + t) * 64 + sj * 16 + 4 * g4) = w;
                        }
                        dsum += BPERM(dsum, lane ^ 16); dsum += BPERM(dsum, lane ^ 32);
                        if (g4 == 0) denP[(wave & 1) * 64 + t] = dsum;
                    }
                    __syncthreads();
                    if (wave == 0 && lane < Lv) *(f32x4*)(TOK + ((size_t)(r0 + lane) * 8 + hd) * 4) = (f32x4){gT, emT, denP[lane] + denP[64 + lane], tailT};
                    __syncthreads();
                }
            }
            SEAM(pb + 3, pb + 4);
            if (IN(pb + 4)) {
                SITE_VARS();
                const int v16 = wave & 3, lw = wave & 3, ltid = tid & 255;
#define FRESHI(x) ({ int x__ = (x); asm volatile("" : "+v"(x__)); x__; })
#define LDSV(T, off) (*(LAS T*)(lds + (off)))
#define TRFRAG(off, stride) ({ const v4s lo_ = __builtin_amdgcn_ds_read_tr16_b64_v4i16((LAS v4s*)(lds + (off))); const v4s hi_ = __builtin_amdgcn_ds_read_tr16_b64_v4i16((LAS v4s*)(lds + (off) + 16 * (stride))); \
    (bf16x8){lo_[0], lo_[1], lo_[2], lo_[3], hi_[0], hi_[1], hi_[2], hi_[3]}; })
#define SB() __builtin_amdgcn_sched_barrier(0)
                LAS f32x4* Ib = (LAS f32x4*)(lds + MI_OFF);
                LAS float* scal = (LAS float*)(lds + MSC_OFF);
                LAS float* nS = (LAS float*)(lds + MN_OFF); LAS float* nPart = (LAS float*)(lds + MNP_OFF); LAS float* qnP = (LAS float*)(lds + MQN_OFF); LAS float* decS = (LAS float*)(lds + MDEC_OFF);
                LAS unsigned short* nB = (LAS unsigned short*)(lds + MNB_OFF); LAS unsigned short* tailB = (LAS unsigned short*)(lds + MTB_OFF);
                if (wave < 4) {
                for (int u = bx; u < 2304; u += G) {
                    int s, hd, vs;
                    if (u < 256) { const int pr = (u & 7) + 8 * (u >> 6); vs = (u >> 3) & 7; s = pr >> 3; hd = pr & 7; }
                    else { const int up = u - 256, pr = (up & 7) + 8 * (up >> 6); vs = (up >> 3) & 7; s = NB_P + (pr >> 3); hd = pr & 7; }
                    const int T = stream_T(s), row0 = stream_row0(s), Lv = T < 64 ? T : 64, nch = T < 64 ? 1 : T / 64;
                    const int ci0 = s < NB_P ? s * 128 : 512 + (s - NB_P);
                    const size_t sbi = s < NB_P ? 0 : (size_t)(j * NB_S + (s - NB_P)) * ML_NH + hd;
                    f32x4 R[32];
                    if (s < NB_P) {
                        if (true) {
#pragma unroll
                            for (int i = 0; i < 32; ++i) R[i] = (f32x4){0.f, 0.f, 0.f, 0.f};
                        }
                        nS[tid] = 0.f; nB[tid] = 0;
                    } else {
                        int t2_ = tid; asm volatile("" : "+v"(t2_));
                        const unsigned stio = (unsigned)((t2_ >> 4) * 256 + (t2_ & 15) * 16);
                        const unsigned stld = (unsigned)((4 * ((t2_ >> 4) & 3)) * 256 + (((t2_ >> 6) & 3) * 16 + (t2_ & 15)) * 4);
#pragma unroll
                        for (int h = 0; h < 2; ++h) {
                            const float* gp = st_mC + sbi * ML_HD * ML_HD + (size_t)(h * 256 + (t2_ >> 4)) * ML_HD + vs * 64 + (t2_ & 15) * 4;
#pragma unroll
                            for (int pp = 0; pp < 2; ++pp) { f32x4 tmp[4];
#pragma unroll
                                for (int p = 0; p < 4; ++p) tmp[p] = *(const f32x4*)(gp + (size_t)(pp * 4 + p) * 32 * ML_HD);
#pragma unroll
                                for (int p = 0; p < 4; ++p) LDSV(f32x4, (pp * 4 + p) * 8192 + stio) = tmp[p]; SB(); }
                            __syncthreads();
                            if (true) {
#pragma unroll
                                for (int i2 = 0; i2 < 2; ++i2)
#pragma unroll
                                    for (int kt = 0; kt < 8; ++kt)
#pragma unroll
                                        for (int r = 0; r < 4; ++r) R[(2 * h + i2) * 8 + kt][r] = LDSV(float, (i2 * 128 + kt * 16 + r) * 256 + stld);
                            }
                            __syncthreads();
                        }
                        { const float n0_ = st_mn[sbi * ML_HD + tid]; nS[tid] = n0_; nB[tid] = (unsigned short)f2bf(n0_); }
                    }
                    const int ltid_u = FRESHI(ltid), lane_u = FRESHI(lane);
                    const int lnu = FRESHI(lane); const int ug4 = lnu >> 4, ul15 = lnu & 15;
                    const unsigned m_rowQ = (unsigned)(ul15 * ST128 + 8 * ug4); unsigned m_rowQh = m_rowQ + 32; asm volatile("" : "+v"(m_rowQh));
                    const unsigned m_trK0 = (unsigned)((4 * ug4 + (ul15 >> 2)) * STK + 8 * (lnu & 3) + MQ_K);
                    const unsigned m_trVT0 = (unsigned)((4 * ug4 + (ul15 >> 2)) * STV + 8 * (lnu & 3) + v16 * 32 + MVT_OFF);
                    v4u sa[2], va[2]; float tlv[2]; f32x4 tk; float dcv;
                    const char* Qu = (const char*)(Q + (size_t)row0 * ML_INNER + hd * 512); const char* Ku = (const char*)(Kb + (size_t)row0 * ML_INNER + hd * 512);
#define ML_LOADX(set, cn, qi, x_, rowq_, colq_) do { const size_t go_ = ((size_t)(cn) * 64 * ML_INNER + (qi) * 128) * 2; const int rr_ = (rowq_) + 16 * (x_), rc_ = rr_ < Lv ? rr_ : Lv - 1; const unsigned qk_ = (unsigned)(rc_ * (ML_INNER * 2)) + (colq_); \
    R[(set) * 8 + (x_)] = *(const f32x4*)(Qu + go_ + qk_); R[(set) * 8 + 4 + (x_)] = *(const f32x4*)(Ku + go_ + qk_); } while (0)
#define ML_LOADS(set, cn, qi) do { const int tl_ = FRESHI(ltid); const int rq_ = tl_ >> 4; const unsigned cq_ = (unsigned)(tl_ & 15) * 16u; \
    ML_LOADX(set, cn, qi, 0, rq_, cq_); ML_LOADX(set, cn, qi, 1, rq_, cq_); ML_LOADX(set, cn, qi, 2, rq_, cq_); ML_LOADX(set, cn, qi, 3, rq_, cq_); } while (0)
#define ML_LOADS_S(cn) do { const int rn0_ = row0 + (cn) * 64; const int tl_ = FRESHI(ltid); \
    _Pragma("unroll") for (int x_ = 0; x_ < 2; ++x_) { const int tq_ = (tl_ >> 3) + 32 * x_, tc_ = tq_ < Lv ? tq_ : Lv - 1; \
        sa[x_] = *(const v4u*)(Sg + (size_t)((ci0 + (cn)) * 8 + hd) * 4096 + (tl_ + 256 * x_) * 8); \
        va[x_] = *(const v4u*)(Vb + (size_t)(rn0_ + tc_) * ML_INNER + hd * 512 + vs * 64 + (tl_ & 7) * 8); tlv[x_] = TOK[((size_t)(rn0_ + tc_) * 8 + hd) * 4 + 3]; } \
    { const int t6_ = tl_ & 63, t6c_ = t6_ < Lv ? t6_ : Lv - 1; tk = *(const f32x4*)(TOK + ((size_t)(rn0_ + t6c_) * 8 + hd) * 4); } \
    dcv = CHK[((ci0 + (cn)) * 8 + hd) * 2]; } while (0)
#define ML_WRITES(bufi, set) do { const int tw_ = ltid_u; const unsigned stq_ = (unsigned)((tw_ >> 4) * ST128 + (tw_ & 15) * 16), stk_ = (unsigned)((tw_ >> 4) * STK + (tw_ & 15) * 16 + MQ_K); \
    _Pragma("unroll") for (int x_ = 0; x_ < 4; ++x_) { LDSV(f32x4, (bufi) * MQ_BUF + x_ * 16 * ST128 + stq_) = R[(set) * 8 + x_]; LDSV(f32x4, (bufi) * MQ_BUF + x_ * 16 * STK + stk_) = R[(set) * 8 + 4 + x_]; } } while (0)
#define ML_WRITES_S(cn) do { const int tw_ = FRESHI(ltid); const unsigned sts_ = (unsigned)((tw_ >> 3) * ST64 + (tw_ & 7) * 16 + MS_OFF), stv_ = (unsigned)((tw_ >> 3) * STV + (tw_ & 7) * 16 + MV_OFF); \
    _Pragma("unroll") for (int x_ = 0; x_ < 2; ++x_) { if ((tw_ >> 3) + 32 * x_ >= Lv) { va[x_] = (v4u){0u, 0u, 0u, 0u}; tlv[x_] = 0.f; } \
        LDSV(v4u, x_ * 32 * ST64 + sts_) = sa[x_]; LDSV(v4u, x_ * 32 * STV + stv_) = va[x_]; const float tl2_ = tlv[x_]; \
        v4u o_; o_.x = pk2(bflo(va[x_].x) * tl2_, bfhi(va[x_].x) * tl2_); o_.y = pk2(bflo(va[x_].y) * tl2_, bfhi(va[x_].y) * tl2_); o_.z = pk2(bflo(va[x_].z) * tl2_, bfhi(va[x_].z) * tl2_); o_.w = pk2(bflo(va[x_].w) * tl2_, bfhi(va[x_].w) * tl2_); \
        LDSV(v4u, (MVT_OFF - MV_OFF) + ((cn) & 1) * MV_IMG + x_ * 32 * STV + stv_) = o_; } \
    if ((tw_ & 63) >= Lv) tk = (f32x4){0.f, 1.f, 1.f, 0.f}; \
    if (tw_ < 64) { LAS float* sc_ = scal + ((cn) & 1) * 256; sc_[tw_] = tk[0]; sc_[64 + tw_] = tk[1]; sc_[128 + tw_] = tk[2]; sc_[192 + tw_] = tk[3]; tailB[((cn) & 1) * 64 + tw_] = (unsigned short)f2bf(tk[3]); } \
    if (tw_ == 64) decS[(cn) & 1] = dcv; } while (0)
                    if (!true) {
                        ML_LOADS(0, 0, 0); ML_LOADS_S(0); ML_LOADS(1, 0, 1); ML_LOADS(2, 0, 2); ML_LOADS(3, 0, 3);
                        ML_WRITES(0, 0); ML_WRITES_S(0);
                    }
                    __syncthreads();
                    f32x4 qn_acc = (f32x4){0.f, 0.f, 0.f, 0.f};
                    for (int c = 0; c < nch; ++c) {
                        const int r0 = row0 + c * 64;
                        const int cnx = c + 1 < nch ? c + 1 : nch - 1;
                        f32x4 accQ[4];
#pragma unroll
                        for (int tt = 0; tt < 4; ++tt) accQ[tt] = (f32x4){0.f, 0.f, 0.f, 0.f};
                        const LAS float* scc = scal + (c & 1) * 256;
                        const float dec = decS[c & 1];
#pragma unroll
                        for (int i = 0; i < 4; ++i) {
                            const int b = i & 1;
                            if (true) {
                                const unsigned rowQ = m_rowQ + b * MQ_BUF, rowQh = m_rowQh + b * MQ_BUF;
                                const unsigned trK = m_trK0 + b * MQ_BUF;
                                const unsigned trVT = m_trVT0 + (c & 1) * MV_IMG;
                                if (i == 0) {
                                    const unsigned trV = m_trVT0 - (MVT_OFF - MV_OFF), rowS = (unsigned)(ul15 * ST64 + 8 * ug4 + MS_OFF);
                                    f32x4 accI[4];
#pragma unroll
                                    for (int tt = 0; tt < 4; ++tt) accI[tt] = (f32x4){0.f, 0.f, 0.f, 0.f};
                                    bf16x8 vf2[2]; v2u sl2[2][4], sh2[2][4];
#pragma unroll
                                    for (int ks = 0; ks < 2; ++ks) { vf2[ks] = TRFRAG(ks * 32 * STV + trV, STV);
#pragma unroll
                                        for (int tt = 0; tt < 4; ++tt) { sl2[ks][tt] = LDSV(v2u, tt * 16 * ST64 + ks * 64 + rowS); sh2[ks][tt] = LDSV(v2u, tt * 16 * ST64 + ks * 64 + 32 + rowS); } }
                                    SB();
#pragma unroll
                                    for (int ks = 0; ks < 2; ++ks) {
#pragma unroll
                                        for (int tt = 0; tt < 4; ++tt) { pg8::u32x4 sw; sw.x = sl2[ks][tt].x; sw.y = sl2[ks][tt].y; sw.z = sh2[ks][tt].x; sw.w = sh2[ks][tt].y;
                                            accI[tt] = __builtin_amdgcn_mfma_f32_16x16x32_bf16(vf2[ks], __builtin_bit_cast(bf16x8, sw), accI[tt], 0, 0, 0); } }
#pragma unroll
                                    for (int tt = 0; tt < 4; ++tt) Ib[(v16 * 4 + tt) * 64 + lnu] = accI[tt];
                                    SB();
                                }
                                v2u ql[8], qh[8]; bf16x8 k0w[4], k1w[4], afr[2];
#define QRD(n) do { ql[(n) & 7] = LDSV(v2u, ((n) & 3) * 16 * ST128 + ((n) >> 2) * 64 + rowQ); qh[(n) & 7] = LDSV(v2u, ((n) & 3) * 16 * ST128 + ((n) >> 2) * 64 + rowQh); asm volatile("" ::: "memory"); } while (0)
#define AFQ(kk) do { const f32x4 sa0 = R[i * 8 + 2 * (kk)], sb0 = R[i * 8 + 2 * (kk) + 1]; pg8::u32x4 aw; aw.x = cvt_pk_bf16(sa0[0], sa0[1]); aw.y = cvt_pk_bf16(sa0[2], sa0[3]); aw.z = cvt_pk_bf16(sb0[0], sb0[1]); aw.w = cvt_pk_bf16(sb0[2], sb0[3]); afr[(kk) & 1] = __builtin_bit_cast(bf16x8, aw); } while (0)
#define QMF(n) do { pg8::u32x4 bw; bw.x = ql[(n) & 7].x; bw.y = ql[(n) & 7].y; bw.z = qh[(n) & 7].x; bw.w = qh[(n) & 7].y; accQ[(n) & 3] = __builtin_amdgcn_mfma_f32_16x16x32_bf16(afr[((n) >> 2) & 1], __builtin_bit_cast(bf16x8, bw), accQ[(n) & 3], 0, 0, 0); } while (0)
#define KRD(t) do { k0w[(t) & 3] = TRFRAG((t) * 32 + trK, STK); k1w[(t) & 3] = TRFRAG(32 * STK + (t) * 32 + trK, STK); } while (0)
#define KDEC(dst, t) do { const f32x4 r_ = R[i * 8 + (t)]; _Pragma("unroll") for (int e_ = 0; e_ < 4; ++e_) { float t_; asm("v_mul_f32 %0, %1, %2" : "=v"(t_) : "v"(r_[e_]), "v"(dec)); dst[e_] = t_; } } while (0)
#define KMF(sv, t) do { sv = __builtin_amdgcn_mfma_f32_16x16x32_bf16(k0w[(t) & 3], vt0, sv, 0, 0, 0); sv = __builtin_amdgcn_mfma_f32_16x16x32_bf16(k1w[(t) & 3], vt1, sv, 0, 0, 0); R[i * 8 + (t)] = sv; } while (0)
                                QRD(0); QRD(1); QRD(2); QRD(3); QRD(4); QRD(5); QRD(6); QRD(7); AFQ(0); SB();
                                const bf16x8 vt0 = TRFRAG(trVT, STV), vt1 = TRFRAG(trVT + 32 * STV, STV);
                                QMF(0); QRD(8); SB();
                                AFQ(1); QMF(1); QRD(9); SB();
                                QMF(2); QRD(10); SB();
                                QMF(3); QRD(11); SB();
                                QMF(4); QRD(12); SB();
                                AFQ(2); QMF(5); QRD(13); SB();
                                QMF(6); QRD(14); SB();
                                QMF(7); QRD(15); SB();
                                QMF(8); KRD(0); SB();
                                AFQ(3); QMF(9); SB();
                                QMF(10); KRD(1); SB();
                                QMF(11); SB();
                                QMF(12); KRD(2); SB();
                                QMF(13); SB();
                                QMF(14); KRD(3); SB();
                                QMF(15); SB();
                                f32x4 svA, svB; KDEC(svA, 0); SB();
                                KDEC(svB, 1); KMF(svA, 0); KRD(4); SB();
                                KDEC(svA, 2); KMF(svB, 1); KRD(5); SB();
                                KDEC(svB, 3); KMF(svA, 2); KRD(6); SB();
                                KDEC(svA, 4); KMF(svB, 3); KRD(7); SB();
                                KDEC(svB, 5); KMF(svA, 4); SB();
                                KDEC(svA, 6); KMF(svB, 5); SB();
                                KDEC(svB, 7); KMF(svA, 6); SB();
                                KMF(svB, 7); SB();
#undef QRD
#undef AFQ
#undef QMF
#undef KRD
#undef KDEC
#undef KMF
                            } else {
                                const int tlq = ltid_u; const int rowq = tlq >> 4; const unsigned colq = (unsigned)(tlq & 15) * 16u;
                                ML_LOADX(i, cnx, i, 0, rowq, colq);
                                SB();
                                const int lnd = FRESHI(lane); const int g4 = lnd >> 4, l15 = lnd & 15;
                                const bool dofold = (ltid < 128) && !(i == 0 && c == 0);
                                const int kr = ((i + 3) & 3) * 128 + (ltid & 127);
                                const float fo_n = nS[kr], fo_p = nPart[((i + 1) & 1) * 128 + (ltid & 127)];
                                const unsigned tbo = MTB_OFF + (c & 1) * 128 + 8 * g4;
                                const v2u t0l = LDSV(v2u, tbo), t0h = LDSV(v2u, tbo + 32), t1l = LDSV(v2u, tbo + 64), t1h = LDSV(v2u, tbo + 96);
                                const unsigned trK = (unsigned)((4 * g4 + (l15 >> 2)) * STK + 8 * (lnd & 3) + MQ_K + b * MQ_BUF + lw * 64);
                                const bf16x8 kfa0 = TRFRAG(trK, STK), kfa1 = TRFRAG(32 * STK + trK, STK);
                                SB();
                                ML_LOADX(i, cnx, i, 1, rowq, colq);
                                SB();
                                if (dofold) { const float dc = i == 0 ? decS[(c + 1) & 1] : dec; const float nn = dc * fo_n + fo_p; nS[kr] = nn; nB[kr] = (unsigned short)f2bf(nn); }
                                { pg8::u32x4 w0, w1; w0.x = t0l.x; w0.y = t0l.y; w0.z = t0h.x; w0.w = t0h.y; w1.x = t1l.x; w1.y = t1l.y; w1.z = t1h.x; w1.w = t1h.y;
                                  const bf16x8 tf0 = __builtin_bit_cast(bf16x8, w0), tf1 = __builtin_bit_cast(bf16x8, w1);
                                  const bf16x8 kfb0 = TRFRAG(32 + trK, STK), kfb1 = TRFRAG(32 * STK + 32 + trK, STK);
                                  f32x4 pn = (f32x4){0.f, 0.f, 0.f, 0.f}; pn = __builtin_amdgcn_mfma_f32_16x16x32_bf16(kfa0, tf0, pn, 0, 0, 0); pn = __builtin_amdgcn_mfma_f32_16x16x32_bf16(kfa1, tf1, pn, 0, 0, 0);
                                  if (l15 == 0) *(LAS f32x4*)(nPart + (i & 1) * 128 + (2 * lw) * 16 + 4 * g4) = pn;
                                  SB(); ML_LOADX(i, cnx, i, 2, rowq, colq); SB();
                                  f32x4 pm = (f32x4){0.f, 0.f, 0.f, 0.f}; pm = __builtin_amdgcn_mfma_f32_16x16x32_bf16(kfb0, tf0, pm, 0, 0, 0); pm = __builtin_amdgcn_mfma_f32_16x16x32_bf16(kfb1, tf1, pm, 0, 0, 0);
                                  if (l15 == 0) *(LAS f32x4*)(nPart + (i & 1) * 128 + (2 * lw + 1) * 16 + 4 * g4) = pm; }
                                SB();
                                ML_LOADX(i, cnx, i, 3, rowq, colq);
                                if (i == 0) ML_LOADS_S(cnx);
                                SB();
                                { const unsigned qro = (unsigned)(b * MQ_BUF + (lw * 16 + l15) * ST128 + 16 * g4), nbo = (unsigned)(MNB_OFF + (i * 128 + 8 * g4) * 2);
                                  bf16x8 qf[4], nf[4];
#pragma unroll
                                  for (int kk = 0; kk < 4; ++kk) { qf[kk] = LDSV(bf16x8, qro + kk * 64); nf[kk] = LDSV(bf16x8, nbo + kk * 64); }
                                  SB();
#pragma unroll
                                  for (int kk = 0; kk < 4; ++kk) qn_acc = __builtin_amdgcn_mfma_f32_16x16x32_bf16(qf[kk], nf[kk], qn_acc, 0, 0, 0); }
                                SB();
                                ML_WRITES(b ^ 1, (i + 1) & 3);
                                if (i == 3) { ML_WRITES_S(cnx); if (l15 == 0) *(LAS f32x4*)(qnP + lw * 16 + 4 * g4) = qn_acc; qn_acc = (f32x4){0.f, 0.f, 0.f, 0.f}; }
                            }
                            __syncthreads();
                        }
                        if (true) {
                            const int lnf = lnu; const int l15 = ul15, g4 = ug4;
                            float qn4[4], gt4[4], em4[4], dn4[4]; f32x4 ib4[4];
#pragma unroll
                            for (int tt = 0; tt < 4; ++tt) { const int t = tt * 16 + l15; qn4[tt] = qnP[t]; gt4[tt] = scc[t]; em4[tt] = scc[64 + t]; dn4[tt] = scc[128 + t]; ib4[tt] = Ib[(v16 * 4 + tt) * 64 + lnf]; }
                            SB();
#pragma unroll
                            for (int tt = 0; tt < 4; ++tt) { const int t = tt * 16 + l15;
                                const float den = dn4[tt] + gt4[tt] * qn4[tt];
                                const float rd = __builtin_amdgcn_rcpf(fmaxf(fabsf(den), em4[tt]));
                                const f32x4 hv = (ib4[tt] + accQ[tt] * gt4[tt]) * rd;
                                if (t < Lv) { v2u o; o.x = pk2(hv[0], hv[1]); o.y = pk2(hv[2], hv[3]); *(v2u*)(H + (size_t)(r0 + t) * ML_INNER + hd * 512 + vs * 64 + v16 * 16 + 4 * g4) = o; } }
                        }
                    }
                    if (!true && ltid < 128) { const int kr = 3 * 128 + ltid; nS[kr] = decS[(nch - 1) & 1] * nS[kr] + nPart[128 + ltid]; }
                    __syncthreads();
                    {
                        const size_t sbo = s < NB_P ? (size_t)(j * NB_P + s) * ML_NH + hd : sbi;
                        int t2_ = tid; asm volatile("" : "+v"(t2_));
                        const unsigned stio = (unsigned)((t2_ >> 4) * 256 + (t2_ & 15) * 16);
                        const unsigned stld = (unsigned)((4 * ((t2_ >> 4) & 3)) * 256 + (((t2_ >> 6) & 3) * 16 + (t2_ & 15)) * 4);
                        if (vs == 0) { out[(s < NB_P ? O_P_MN : O_S_MN) + sbo * ML_HD + tid] = nS[tid]; if (tid == 0) out[(s < NB_P ? O_P_MM : O_S_MM) + sbo] = CHK[((ci0 + nch - 1) * 8 + hd) * 2 + 1]; }
                        __syncthreads();
#pragma unroll
                        for (int h = 0; h < 2; ++h) {
                            if (true) {
#pragma unroll
                                for (int i2 = 0; i2 < 2; ++i2)
#pragma unroll
                                    for (int kt = 0; kt < 8; ++kt)
#pragma unroll
                                        for (int r = 0; r < 4; ++r) LDSV(float, (i2 * 128 + kt * 16 + r) * 256 + stld) = R[(2 * h + i2) * 8 + kt][r];
                            }
                            __syncthreads();
                            float* gp = out + (s < NB_P ? O_P_MC : O_S_MC) + sbo * ML_HD * ML_HD + (size_t)(h * 256 + (t2_ >> 4)) * ML_HD + vs * 64 + (t2_ & 15) * 4;
#pragma unroll 1
                            for (int p = 0; p < 8; ++p) *(f32x4*)(gp + (size_t)p * 32 * ML_HD) = LDSV(f32x4, p * 8192 + stio);
                            __syncthreads();
                        }
                    }
                    __syncthreads();
#undef ML_LOADS
#undef ML_LOADS_S
#undef ML_WRITES
#undef ML_WRITES_S
                }
                } else {
                for (int u = bx; u < 2304; u += G) {
                    int s, hd, vs;
                    if (u < 256) { const int pr = (u & 7) + 8 * (u >> 6); vs = (u >> 3) & 7; s = pr >> 3; hd = pr & 7; }
                    else { const int up = u - 256, pr = (up & 7) + 8 * (up >> 6); vs = (up >> 3) & 7; s = NB_P + (pr >> 3); hd = pr & 7; }
                    const int T = stream_T(s), row0 = stream_row0(s), Lv = T < 64 ? T : 64, nch = T < 64 ? 1 : T / 64;
                    const int ci0 = s < NB_P ? s * 128 : 512 + (s - NB_P);
                    const size_t sbi = s < NB_P ? 0 : (size_t)(j * NB_S + (s - NB_P)) * ML_NH + hd;
                    f32x4 R[32];
                    if (s < NB_P) {
                        if (false) {
#pragma unroll
                            for (int i = 0; i < 32; ++i) R[i] = (f32x4){0.f, 0.f, 0.f, 0.f};
                        }
                        nS[tid] = 0.f; nB[tid] = 0;
                    } else {
                        int t2_ = tid; asm volatile("" : "+v"(t2_));
                        const unsigned stio = (unsigned)((t2_ >> 4) * 256 + (t2_ & 15) * 16);
                        const unsigned stld = (unsigned)((4 * ((t2_ >> 4) & 3)) * 256 + (((t2_ >> 6) & 3) * 16 + (t2_ & 15)) * 4);
#pragma unroll
                        for (int h = 0; h < 2; ++h) {
                            const float* gp = st_mC + sbi * ML_HD * ML_HD + (size_t)(h * 256 + (t2_ >> 4)) * ML_HD + vs * 64 + (t2_ & 15) * 4;
#pragma unroll
                            for (int pp = 0; pp < 2; ++pp) { f32x4 tmp[4];
#pragma unroll
                                for (int p = 0; p < 4; ++p) tmp[p] = *(const f32x4*)(gp + (size_t)(pp * 4 + p) * 32 * ML_HD);
#pragma unroll
                                for (int p = 0; p < 4; ++p) LDSV(f32x4, (pp * 4 + p) * 8192 + stio) = tmp[p]; SB(); }
                            __syncthreads();
                            if (false) {
#pragma unroll
                                for (int i2 = 0; i2 < 2; ++i2)
#pragma unroll
                                    for (int kt = 0; kt < 8; ++kt)
#pragma unroll
                                        for (int r = 0; r < 4; ++r) R[(2 * h + i2) * 8 + kt][r] = LDSV(float, (i2 * 128 + kt * 16 + r) * 256 + stld);
                            }
                            __syncthreads();
                        }
                        { const float n0_ = st_mn[sbi * ML_HD + tid]; nS[tid] = n0_; nB[tid] = (unsigned short)f2bf(n0_); }
                    }
                    const int ltid_u = FRESHI(ltid), lane_u = FRESHI(lane);
                    const int lnu = FRESHI(lane); const int ug4 = lnu >> 4, ul15 = lnu & 15;
                    const unsigned m_rowQ = (unsigned)(ul15 * ST128 + 8 * ug4); unsigned m_rowQh = m_rowQ + 32; asm volatile("" : "+v"(m_rowQh));
                    const unsigned m_trK0 = (unsigned)((4 * ug4 + (ul15 >> 2)) * STK + 8 * (lnu & 3) + MQ_K);
                    const unsigned m_trVT0 = (unsigned)((4 * ug4 + (ul15 >> 2)) * STV + 8 * (lnu & 3) + v16 * 32 + MVT_OFF);
                    v4u sa[2], va[2]; float tlv[2]; f32x4 tk; float dcv;
                    const char* Qu = (const char*)(Q + (size_t)row0 * ML_INNER + hd * 512); const char* Ku = (const char*)(Kb + (size_t)row0 * ML_INNER + hd * 512);
#define ML_LOADX(set, cn, qi, x_, rowq_, colq_) do { const size_t go_ = ((size_t)(cn) * 64 * ML_INNER + (qi) * 128) * 2; const int rr_ = (rowq_) + 16 * (x_), rc_ = rr_ < Lv ? rr_ : Lv - 1; const unsigned qk_ = (unsigned)(rc_ * (ML_INNER * 2)) + (colq_); \
    R[(set) * 8 + (x_)] = *(const f32x4*)(Qu + go_ + qk_); R[(set) * 8 + 4 + (x_)] = *(const f32x4*)(Ku + go_ + qk_); } while (0)
#define ML_LOADS(set, cn, qi) do { const int tl_ = FRESHI(ltid); const int rq_ = tl_ >> 4; const unsigned cq_ = (unsigned)(tl_ & 15) * 16u; \
    ML_LOADX(set, cn, qi, 0, rq_, cq_); ML_LOADX(set, cn, qi, 1, rq_, cq_); ML_LOADX(set, cn, qi, 2, rq_, cq_); ML_LOADX(set, cn, qi, 3, rq_, cq_); } while (0)
#define ML_LOADS_S(cn) do { const int rn0_ = row0 + (cn) * 64; const int tl_ = FRESHI(ltid); \
    _Pragma("unroll") for (int x_ = 0; x_ < 2; ++x_) { const int tq_ = (tl_ >> 3) + 32 * x_, tc_ = tq_ < Lv ? tq_ : Lv - 1; \
        sa[x_] = *(const v4u*)(Sg + (size_t)((ci0 + (cn)) * 8 + hd) * 4096 + (tl_ + 256 * x_) * 8); \
        va[x_] = *(const v4u*)(Vb + (size_t)(rn0_ + tc_) * ML_INNER + hd * 512 + vs * 64 + (tl_ & 7) * 8); tlv[x_] = TOK[((size_t)(rn0_ + tc_) * 8 + hd) * 4 + 3]; } \
    { const int t6_ = tl_ & 63, t6c_ = t6_ < Lv ? t6_ : Lv - 1; tk = *(const f32x4*)(TOK + ((size_t)(rn0_ + t6c_) * 8 + hd) * 4); } \
    dcv = CHK[((ci0 + (cn)) * 8 + hd) * 2]; } while (0)
#define ML_WRITES(bufi, set) do { const int tw_ = ltid_u; const unsigned stq_ = (unsigned)((tw_ >> 4) * ST128 + (tw_ & 15) * 16), stk_ = (unsigned)((tw_ >> 4) * STK + (tw_ & 15) * 16 + MQ_K); \
    _Pragma("unroll") for (int x_ = 0; x_ < 4; ++x_) { LDSV(f32x4, (bufi) * MQ_BUF + x_ * 16 * ST128 + stq_) = R[(set) * 8 + x_]; LDSV(f32x4, (bufi) * MQ_BUF + x_ * 16 * STK + stk_) = R[(set) * 8 + 4 + x_]; } } while (0)
#define ML_WRITES_S(cn) do { const int tw_ = FRESHI(ltid); const unsigned sts_ = (unsigned)((tw_ >> 3) * ST64 + (tw_ & 7) * 16 + MS_OFF), stv_ = (unsigned)((tw_ >> 3) * STV + (tw_ & 7) * 16 + MV_OFF); \
    _Pragma("unroll") for (int x_ = 0; x_ < 2; ++x_) { if ((tw_ >> 3) + 32 * x_ >= Lv) { va[x_] = (v4u){0u, 0u, 0u, 0u}; tlv[x_] = 0.f; } \
        LDSV(v4u, x_ * 32 * ST64 + sts_) = sa[x_]; LDSV(v4u, x_ * 32 * STV + stv_) = va[x_]; const float tl2_ = tlv[x_]; \
        v4u o_; o_.x = pk2(bflo(va[x_].x) * tl2_, bfhi(va[x_].x) * tl2_); o_.y = pk2(bflo(va[x_].y) * tl2_, bfhi(va[x_].y) * tl2_); o_.z = pk2(bflo(va[x_].z) * tl2_, bfhi(va[x_].z) * tl2_); o_.w = pk2(bflo(va[x_].w) * tl2_, bfhi(va[x_].w) * tl2_); \
        LDSV(v4u, (MVT_OFF - MV_OFF) + ((cn) & 1) * MV_IMG + x_ * 32 * STV + stv_) = o_; } \
    if ((tw_ & 63) >= Lv) tk = (f32x4){0.f, 1.f, 1.f, 0.f}; \
    if (tw_ < 64) { LAS float* sc_ = scal + ((cn) & 1) * 256; sc_[tw_] = tk[0]; sc_[64 + tw_] = tk[1]; sc_[128 + tw_] = tk[2]; sc_[192 + tw_] = tk[3]; tailB[((cn) & 1) * 64 + tw_] = (unsigned short)f2bf(tk[3]); } \
    if (tw_ == 64) decS[(cn) & 1] = dcv; } while (0)
                    if (!false) {
                        ML_LOADS(0, 0, 0); ML_LOADS_S(0); ML_LOADS(1, 0, 1); ML_LOADS(2, 0, 2); ML_LOADS(3, 0, 3);
                        ML_WRITES(0, 0); ML_WRITES_S(0);
                    }
                    __syncthreads();
                    f32x4 qn_acc = (f32x4){0.f, 0.f, 0.f, 0.f};
                    for (int c = 0; c < nch; ++c) {
                        const int r0 = row0 + c * 64;
                        const int cnx = c + 1 < nch ? c + 1 : nch - 1;
                        f32x4 accQ[4];
#pragma unroll
                        for (int tt = 0; tt < 4; ++tt) accQ[tt] = (f32x4){0.f, 0.f, 0.f, 0.f};
                        const LAS float* scc = scal + (c & 1) * 256;
                        const float dec = decS[c & 1];
#pragma unroll
                        for (int i = 0; i < 4; ++i) {
                            const int b = i & 1;
                            if (false) {
                                const unsigned rowQ = m_rowQ + b * MQ_BUF, rowQh = m_rowQh + b * MQ_BUF;
                                const unsigned trK = m_trK0 + b * MQ_BUF;
                                const unsigned trVT = m_trVT0 + (c & 1) * MV_IMG;
                                if (i == 0) {
                                    const unsigned trV = m_trVT0 - (MVT_OFF - MV_OFF), rowS = (unsigned)(ul15 * ST64 + 8 * ug4 + MS_OFF);
                                    f32x4 accI[4];
#pragma unroll
                                    for (int tt = 0; tt < 4; ++tt) accI[tt] = (f32x4){0.f, 0.f, 0.f, 0.f};
                                    bf16x8 vf2[2]; v2u sl2[2][4], sh2[2][4];
#pragma unroll
                                    for (int ks = 0; ks < 2; ++ks) { vf2[ks] = TRFRAG(ks * 32 * STV + trV, STV);
#pragma unroll
                                        for (int tt = 0; tt < 4; ++tt) { sl2[ks][tt] = LDSV(v2u, tt * 16 * ST64 + ks * 64 + rowS); sh2[ks][tt] = LDSV(v2u, tt * 16 * ST64 + ks * 64 + 32 + rowS); } }
                                    SB();
#pragma unroll
                                    for (int ks = 0; ks < 2; ++ks) {
#pragma unroll
                                        for (int tt = 0; tt < 4; ++tt) { pg8::u32x4 sw; sw.x = sl2[ks][tt].x; sw.y = sl2[ks][tt].y; sw.z = sh2[ks][tt].x; sw.w = sh2[ks][tt].y;
                                            accI[tt] = __builtin_amdgcn_mfma_f32_16x16x32_bf16(vf2[ks], __builtin_bit_cast(bf16x8, sw), accI[tt], 0, 0, 0); } }
#pragma unroll
                                    for (int tt = 0; tt < 4; ++tt) Ib[(v16 * 4 + tt) * 64 + lnu] = accI[tt];
                                    SB();
                                }
                                v2u ql[8], qh[8]; bf16x8 k0w[4], k1w[4], afr[2];
#define QRD(n) do { ql[(n) & 7] = LDSV(v2u, ((n) & 3) * 16 * ST128 + ((n) >> 2) * 64 + rowQ); qh[(n) & 7] = LDSV(v2u, ((n) & 3) * 16 * ST128 + ((n) >> 2) * 64 + rowQh); asm volatile("" ::: "memory"); } while (0)
#define AFQ(kk) do { const f32x4 sa0 = R[i * 8 + 2 * (kk)], sb0 = R[i * 8 + 2 * (kk) + 1]; pg8::u32x4 aw; aw.x = cvt_pk_bf16(sa0[0], sa0[1]); aw.y = cvt_pk_bf16(sa0[2], sa0[3]); aw.z = cvt_pk_bf16(sb0[0], sb0[1]); aw.w = cvt_pk_bf16(sb0[2], sb0[3]); afr[(kk) & 1] = __builtin_bit_cast(bf16x8, aw); } while (0)
#define QMF(n) do { pg8::u32x4 bw; bw.x = ql[(n) & 7].x; bw.y = ql[(n) & 7].y; bw.z = qh[(n) & 7].x; bw.w = qh[(n) & 7].y; accQ[(n) & 3] = __builtin_amdgcn_mfma_f32_16x16x32_bf16(afr[((n) >> 2) & 1], __builtin_bit_cast(bf16x8, bw), accQ[(n) & 3], 0, 0, 0); } while (0)
#define KRD(t) do { k0w[(t) & 3] = TRFRAG((t) * 32 + trK, STK); k1w[(t) & 3] = TRFRAG(32 * STK + (t) * 32 + trK, STK); } while (0)
#define KDEC(dst, t) do { const f32x4 r_ = R[i * 8 + (t)]; _Pragma("unroll") for (int e_ = 0; e_ < 4; ++e_) { float t_; asm("v_mul_f32 %0, %1, %2" : "=v"(t_) : "v"(r_[e_]), "v"(dec)); dst[e_] = t_; } } while (0)
#define KMF(sv, t) do { sv = __builtin_amdgcn_mfma_f32_16x16x32_bf16(k0w[(t) & 3], vt0, sv, 0, 0, 0); sv = __builtin_amdgcn_mfma_f32_16x16x32_bf16(k1w[(t) & 3], vt1, sv, 0, 0, 0); R[i * 8 + (t)] = sv; } while (0)
                                QRD(0); QRD(1); QRD(2); QRD(3); QRD(4); QRD(5); QRD(6); QRD(7); AFQ(0); SB();
                                const bf16x8 vt0 = TRFRAG(trVT, STV), vt1 = TRFRAG(trVT + 32 * STV, STV);
                                QMF(0); QRD(8); SB();
                                AFQ(1); QMF(1); QRD(9); SB();
                                QMF(2); QRD(10); SB();
                                QMF(3); QRD(11); SB();
                                QMF(4); QRD(12); SB();
                                AFQ(2); QMF(5); QRD(13); SB();
                                QMF(6); QRD(14); SB();
                                QMF(7); QRD(15); SB();
                                QMF(8); KRD(0); SB();
                                AFQ(3); QMF(9); SB();
                                QMF(10); KRD(1); SB();
                                QMF(11); SB();
                                QMF(12); KRD(2); SB();
                                QMF(13); SB();
                                QMF(14); KRD(3); SB();
                                QMF(15); SB();
                                f32x4 svA, svB; KDEC(svA, 0); SB();
                                KDEC(svB, 1); KMF(svA, 0); KRD(4); SB();
                                KDEC(svA, 2); KMF(svB, 1); KRD(5); SB();
                                KDEC(svB, 3); KMF(svA, 2); KRD(6); SB();
                                KDEC(svA, 4); KMF(svB, 3); KRD(7); SB();
                                KDEC(svB, 5); KMF(svA, 4); SB();
                                KDEC(svA, 6); KMF(svB, 5); SB();
                                KDEC(svB, 7); KMF(svA, 6); SB();
                                KMF(svB, 7); SB();
#undef QRD
#undef AFQ
#undef QMF
#undef KRD
#undef KDEC
#undef KMF
                            } else {
                                const int tlq = ltid_u; const int rowq = tlq >> 4; const unsigned colq = (unsigned)(tlq & 15) * 16u;
                                ML_LOADX(i, cnx, i, 0, rowq, colq);
                                SB();
                                const int lnd = FRESHI(lane); const int g4 = lnd >> 4, l15 = lnd & 15;
                                const bool dofold = (ltid < 128) && !(i == 0 && c == 0);
                                const int kr = ((i + 3) & 3) * 128 + (ltid & 127);
                                const float fo_n = nS[kr], fo_p = nPart[((i + 1) & 1) * 128 + (ltid & 127)];
                                const unsigned tbo = MTB_OFF + (c & 1) * 128 + 8 * g4;
                                const v2u t0l = LDSV(v2u, tbo), t0h = LDSV(v2u, tbo + 32), t1l = LDSV(v2u, tbo + 64), t1h = LDSV(v2u, tbo + 96);
                                const unsigned trK = (unsigned)((4 * g4 + (l15 >> 2)) * STK + 8 * (lnd & 3) + MQ_K + b * MQ_BUF + lw * 64);
                                const bf16x8 kfa0 = TRFRAG(trK, STK), kfa1 = TRFRAG(32 * STK + trK, STK);
                                SB();
                                ML_LOADX(i, cnx, i, 1, rowq, colq);
                                SB();
                                if (dofold) { const float dc = i == 0 ? decS[(c + 1) & 1] : dec; const float nn = dc * fo_n + fo_p; nS[kr] = nn; nB[kr] = (unsigned short)f2bf(nn); }
                                { pg8::u32x4 w0, w1; w0.x = t0l.x; w0.y = t0l.y; w0.z = t0h.x; w0.w = t0h.y; w1.x = t1l.x; w1.y = t1l.y; w1.z = t1h.x; w1.w = t1h.y;
                                  const bf16x8 tf0 = __builtin_bit_cast(bf16x8, w0), tf1 = __builtin_bit_cast(bf16x8, w1);
                                  const bf16x8 kfb0 = TRFRAG(32 + trK, STK), kfb1 = TRFRAG(32 * STK + 32 + trK, STK);
                                  f32x4 pn = (f32x4){0.f, 0.f, 0.f, 0.f}; pn = __builtin_amdgcn_mfma_f32_16x16x32_bf16(kfa0, tf0, pn, 0, 0, 0); pn = __builtin_amdgcn_mfma_f32_16x16x32_bf16(kfa1, tf1, pn, 0, 0, 0);
                                  if (l15 == 0) *(LAS f32x4*)(nPart + (i & 1) * 128 + (2 * lw) * 16 + 4 * g4) = pn;
                                  SB(); ML_LOADX(i, cnx, i, 2, rowq, colq); SB();
                                  f32x4 pm = (f32x4){0.f, 0.f, 0.f, 0.f}; pm = __builtin_amdgcn_mfma_f32_16x16x32_bf16(kfb0, tf0, pm, 0, 0, 0); pm = __builtin_amdgcn_mfma_f32_16x16x32_bf16(kfb1, tf1, pm, 0, 0, 0);
                                  if (l15 == 0) *(LAS f32x4*)(nPart + (i & 1) * 128 + (2 * lw + 1) * 16 + 4 * g4) = pm; }
                                SB();
                                ML_LOADX(i, cnx, i, 3, rowq, colq);
                                if (i == 0) ML_LOADS_S(cnx);
                                SB();
                                { const unsigned qro = (unsigned)(b * MQ_BUF + (lw * 16 + l15) * ST128 + 16 * g4), nbo = (unsigned)(MNB_OFF + (i * 128 + 8 * g4) * 2);
                                  bf16x8 qf[4], nf[4];
#pragma unroll
                                  for (int kk = 0; kk < 4; ++kk) { qf[kk] = LDSV(bf16x8, qro + kk * 64); nf[kk] = LDSV(bf16x8, nbo + kk * 64); }
                                  SB();
#pragma unroll
                                  for (int kk = 0; kk < 4; ++kk) qn_acc = __builtin_amdgcn_mfma_f32_16x16x32_bf16(qf[kk], nf[kk], qn_acc, 0, 0, 0); }
                                SB();
                                ML_WRITES(b ^ 1, (i + 1) & 3);
                                if (i == 3) { ML_WRITES_S(cnx); if (l15 == 0) *(LAS f32x4*)(qnP + lw * 16 + 4 * g4) = qn_acc; qn_acc = (f32x4){0.f, 0.f, 0.f, 0.f}; }
                            }
                            __syncthreads();
                        }
                        if (false) {
                            const int lnf = lnu; const int l15 = ul15, g4 = ug4;
                            float qn4[4], gt4[4], em4[4], dn4[4]; f32x4 ib4[4];
#pragma unroll
                            for (int tt = 0; tt < 4; ++tt) { const int t = tt * 16 + l15; qn4[tt] = qnP[t]; gt4[tt] = scc[t]; em4[tt] = scc[64 + t]; dn4[tt] = scc[128 + t]; ib4[tt] = Ib[(v16 * 4 + tt) * 64 + lnf]; }
                            SB();
#pragma unroll
                            for (int tt = 0; tt < 4; ++tt) { const int t = tt * 16 + l15;
                                const float den = dn4[tt] + gt4[tt] * qn4[tt];
                                const float rd = __builtin_amdgcn_rcpf(fmaxf(fabsf(den), em4[tt]));
                                const f32x4 hv = (ib4[tt] + accQ[tt] * gt4[tt]) * rd;
                                if (t < Lv) { v2u o; o.x = pk2(hv[0], hv[1]); o.y = pk2(hv[2], hv[3]); *(v2u*)(H + (size_t)(r0 + t) * ML_INNER + hd * 512 + vs * 64 + v16 * 16 + 4 * g4) = o; } }
                        }
                    }
                    if (!false && ltid < 128) { const int kr = 3 * 128 + ltid; nS[kr] = decS[(nch - 1) & 1] * nS[kr] + nPart[128 + ltid]; }
                    __syncthreads();
                    {
                        const size_t sbo = s < NB_P ? (size_t)(j * NB_P + s) * ML_NH + hd : sbi;
                        int t2_ = tid; asm volatile("" : "+v"(t2_));
                        const unsigned stio = (unsigned)((t2_ >> 4) * 256 + (t2_ & 15) * 16);
                        const unsigned stld = (unsigned)((4 * ((t2_ >> 4) & 3)) * 256 + (((t2_ >> 6) & 3) * 16 + (t2_ & 15)) * 4);
                        if (vs == 0) { out[(s < NB_P ? O_P_MN : O_S_MN) + sbo * ML_HD + tid] = nS[tid]; if (tid == 0) out[(s < NB_P ? O_P_MM : O_S_MM) + sbo] = CHK[((ci0 + nch - 1) * 8 + hd) * 2 + 1]; }
                        __syncthreads();
#pragma unroll
                        for (int h = 0; h < 2; ++h) {
                            if (false) {
#pragma unroll
                                for (int i2 = 0; i2 < 2; ++i2)
#pragma unroll
                                    for (int kt = 0; kt < 8; ++kt)
#pragma unroll
                                        for (int r = 0; r < 4; ++r) LDSV(float, (i2 * 128 + kt * 16 + r) * 256 + stld) = R[(2 * h + i2) * 8 + kt][r];
                            }
                            __syncthreads();
                            float* gp = out + (s < NB_P ? O_P_MC : O_S_MC) + sbo * ML_HD * ML_HD + (size_t)(h * 256 + (t2_ >> 4)) * ML_HD + vs * 64 + (t2_ & 15) * 4;
#pragma unroll 1
                            for (int p = 0; p < 8; ++p) *(f32x4*)(gp + (size_t)p * 32 * ML_HD) = LDSV(f32x4, p * 8192 + stio);
                            __syncthreads();
                        }
                    }
                    __syncthreads();
#undef ML_LOADS
#undef ML_LOADS_S
#undef ML_WRITES
#undef ML_WRITES_S
                }
                }
#undef LDSV
#undef TRFRAG
#undef FRESHI
#undef SB
            }
            SEAM(pb + 4, pb + 5);
            if (IN(pb + 5)) {
                SITE_VARS();
                const float* norm_w = args.in[24] + (size_t)j * ML_INNER; const float* skip = args.in[25] + (size_t)j * ML_INNER;
                for (int it = gw; it < M * 2; it += NGW) {
                    const int row = it >> 1, hh = (it & 1) * 4; const size_t off0 = (size_t)row * ML_INNER + hh * 512 + lane * 8;
                    v4u hw4[4], ow4[4], xw4[4], zw4[4];
#pragma unroll
                    for (int q = 0; q < 4; ++q) { hw4[q] = *(const v4u*)(H + off0 + q * 512); ow4[q] = *(const v4u*)(O + off0 + q * 512); xw4[q] = *(const v4u*)(XC + off0 + q * 512); zw4[q] = *(const v4u*)(Z + off0 + q * 512); }
#pragma unroll
                    for (int q = 0; q < 4; ++q) {
                        const int hd = hh + q; const v4u hw = hw4[q], ow = ow4[q], xw = xw4[q], zw = zw4[q];
                        float h[8] = {bflo(hw.x), bfhi(hw.x), bflo(hw.y), bfhi(hw.y), bflo(hw.z), bfhi(hw.z), bflo(hw.w), bfhi(hw.w)};
                        const float og[8] = {bflo(ow.x), bfhi(ow.x), bflo(ow.y), bfhi(ow.y), bflo(ow.z), bfhi(ow.z), bflo(ow.w), bfhi(ow.w)};
                        const float xc[8] = {bflo(xw.x), bfhi(xw.x), bflo(xw.y), bfhi(xw.y), bflo(xw.z), bfhi(xw.z), bflo(xw.w), bfhi(xw.w)};
                        const float zz[8] = {bflo(zw.x), bfhi(zw.x), bflo(zw.y), bfhi(zw.y), bflo(zw.z), bfhi(zw.z), bflo(zw.w), bfhi(zw.w)};
                        float sm = 0.f;
#pragma unroll
                        for (int i = 0; i < 8; ++i) sm += h[i];
                        const float mu = wave_sum(sm) * (1.f / 512.f); float s2 = 0.f;
#pragma unroll
                        for (int i = 0; i < 8; ++i) { h[i] -= mu; s2 += h[i] * h[i]; }
                        const float rstd = rsqrtf(wave_sum(s2) * (1.f / 512.f) + LN_EPS);
                        const float* nw = norm_w + hd * 512 + lane * 8; const float* sk = skip + hd * 512 + lane * 8;
                        const f32x4 n0 = *(const f32x4*)nw, n1 = *(const f32x4*)(nw + 4), k0 = *(const f32x4*)sk, k1 = *(const f32x4*)(sk + 4);
                        const float nwv[8] = {n0[0], n0[1], n0[2], n0[3], n1[0], n1[1], n1[2], n1[3]}, skv[8] = {k0[0], k0[1], k0[2], k0[3], k1[0], k1[1], k1[2], k1[3]};
                        float y[8];
#pragma unroll
                        for (int i = 0; i < 8; ++i) y[i] = (sigmoid_f(og[i]) * (h[i] * rstd * nwv[i]) + skv[i] * xc[i]) * silu_f(zz[i]);
                        v4u o; o.x = pk2(y[0], y[1]); o.y = pk2(y[2], y[3]); o.z = pk2(y[4], y[5]); o.w = pk2(y[6], y[7]);
                        *(v4u*)(YG + off0 + q * 512) = o;
                    }
                }
            }
            SEAM(pb + 5, pb + 6);
            if (IN(pb + 6)) {
                SITE_VARS();
                pg8::Gemm g{YG, (const bf16*)(ws + WS_WML_OUT) + (size_t)j * DM * ML_INNER, ML_INNER, ML_INNER, -1};
                pg8::SplitTailOrder S; S.init(M_P / 256, DM / 256, M_S / 256, G, bx, WGM_OUT);
                EpiResid E{XB, VPRE, DN_ALPHA, SLAB};
                pg8::gemm_phase<EpiResid, pg8::SplitTailOrder, PG8_ALIGN, PG8_SP2, true>(lds, g, S, E, tid);
            }
            SEAM(pb + 6, pb + 7);
            if (IN(pb + 7)) {
                SITE_VARS();
                const float* lg = args.in[27] + (size_t)li * DM; const float* lb = args.in[28] + (size_t)li * DM;
                const bool lastl = (li == 3);
                for (int row = gw; row < M; row += NGW) {
                    const v4u* vr = (const v4u*)(VPRE + (size_t)row * DM) + lane;
                    const v4u* XBV = (const v4u*)XB;
                    float v[32]; float sm = 0.f;
#pragma unroll
                    for (int q = 0; q < 4; ++q) { v4u w = vr[64 * q]; if (row >= M_P) w = (XBV + (size_t)row * (DM / 8) + lane)[64 * q]; v[8 * q + 0] = bflo(w.x); v[8 * q + 1] = bfhi(w.x); v[8 * q + 2] = bflo(w.y); v[8 * q + 3] = bfhi(w.y); v[8 * q + 4] = bflo(w.z); v[8 * q + 5] = bfhi(w.z); v[8 * q + 6] = bflo(w.w); v[8 * q + 7] = bfhi(w.w); }
                    if (row >= M_P) {
#pragma unroll
                        for (int i = 0; i < 32; ++i) v[i] *= DN_ALPHA;
#pragma unroll
                        for (int kq = 0; kq < 4; ++kq)
#pragma unroll
                            for (int q = 0; q < 4; ++q) { const float* sp = SLAB + ((size_t)kq * M_S + (row - M_P)) * DM + 8 * (lane + 64 * q); const f32x4 s0 = *(const f32x4*)sp, s1 = *(const f32x4*)(sp + 4);
                                v[8 * q + 0] += s0[0]; v[8 * q + 1] += s0[1]; v[8 * q + 2] += s0[2]; v[8 * q + 3] += s0[3]; v[8 * q + 4] += s1[0]; v[8 * q + 5] += s1[1]; v[8 * q + 6] += s1[2]; v[8 * q + 7] += s1[3]; }
                    }
#pragma unroll
                    for (int i = 0; i < 32; ++i) sm += v[i];
                    const float mean = wave_sum(sm) * (1.f / DM); float s2 = 0.f;
#pragma unroll
                    for (int i = 0; i < 32; ++i) { v[i] -= mean; s2 += v[i] * v[i]; }
                    const float rstd = rsqrtf(wave_sum(s2) * (1.f / DM) + LN_EPS);
#pragma unroll
                    for (int q = 0; q < 4; ++q) { const int c = 8 * (lane + 64 * q); const f32x4 g0 = *(const f32x4*)(lg + c), g1 = *(const f32x4*)(lg + c + 4), b0 = *(const f32x4*)(lb + c), b1 = *(const f32x4*)(lb + c + 4);
                        f32x4 o0, o1;
#pragma unroll
                        for (int e = 0; e < 4; ++e) { o0[e] = v[8 * q + e] * rstd * g0[e] + b0[e]; o1[e] = v[8 * q + 4 + e] * rstd * g1[e] + b1[e]; }
                        if (lastl) { float* orow = out + (size_t)row * DM + c; *(f32x4*)orow = o0; *(f32x4*)(orow + 4) = o1; } else { v4u w; w.x = pk2(o0[0], o0[1]); w.y = pk2(o0[2], o0[3]); w.z = pk2(o1[0], o1[1]); w.w = pk2(o1[2], o1[3]); *(v4u*)(XB + (size_t)row * DM + c) = w; } }
                }
            }
            SEAM(pb + 7, pb + 8);
        }
    }
#undef IN
#undef SEAM
}

static bool phase_used(int ph) { if (ph == 0) return true; const int i = (ph - 1) / 8, k = (ph - 1) % 8; return (i & 1) ? (k < 8) : (k < 6); }
constexpr int N_PHASE_IDS = 33;

extern "C" void kernel_launch(void* const* d_in, const int* in_sizes, int n_in, void* d_out, int out_size, void* d_ws, size_t ws_size, hipStream_t stream) {
    static int grid = 0;
    if (grid == 0) {
        if (n_in != 29 || (size_t)out_size != O_END || ws_size < WS_END) { fprintf(stderr, "kernel_launch: shape mismatch: n_in %d out %d (want %zu) ws %zu (want %zu)\n", n_in, out_size, (size_t)O_END, ws_size, (size_t)WS_END); grid = -1; return; }
        int dev = 0, cus = 0;
        if (hipGetDevice(&dev) != hipSuccess || hipDeviceGetAttribute(&cus, hipDeviceAttributeMultiprocessorCount, dev) != hipSuccess) { grid = -1; return; }
        if (hipFuncSetAttribute((const void*)mk_fwd, hipFuncAttributeMaxDynamicSharedMemorySize, LDS_BYTES) != hipSuccess) { fprintf(stderr, "kernel_launch: hipFuncSetAttribute failed\n"); grid = -1; return; }
        int per_cu = 0;
        (void)hipOccupancyMaxActiveBlocksPerMultiprocessor(&per_cu, (const void*)mk_fwd, NWAVES * 64, LDS_BYTES);
        (void)hipGetLastError();
        grid = cus;
    }
    if (grid < 0) return;
    if (hipMemsetAsync((char*)d_ws + WS_CTL, 0, CTL_ZERO_BYTES, stream) != hipSuccess) return;
    Args a{};
    for (int i = 0; i < 29; ++i) a.in[i] = (const float*)d_in[i];
    a.out = (float*)d_out; a.ws = (unsigned char*)d_ws;
#if MK_ONE_LAUNCH
    a.ph_lo = 0; a.ph_hi = N_PHASE_IDS;
    hipLaunchKernelGGL(mk_fwd, dim3(grid), dim3(NWAVES * 64), LDS_BYTES, stream, a);
#else
    for (int ph = 0; ph < N_PHASE_IDS; ++ph) {
        if (!phase_used(ph)) continue;
        a.ph_lo = ph; a.ph_hi = ph + 1;
        hipLaunchKernelGGL(mk_fwd, dim3(grid), dim3(NWAVES * 64), LDS_BYTES, stream, a);
    }
#endif
}
```

```cpp
#include <hip/hip_runtime.h>
#include <cstdio>
#include <cstdint>

#ifndef MK_ONE_LAUNCH
#define MK_ONE_LAUNCH 1
#endif

namespace pg8 {
#define PG8_LAS __attribute__((address_space(3)))
typedef unsigned short bf16_t;
typedef short bf16x8 __attribute__((ext_vector_type(8)));
typedef float f32x4 __attribute__((ext_vector_type(4)));
typedef unsigned u32x4 __attribute__((ext_vector_type(4)));
typedef unsigned u32x2 __attribute__((ext_vector_type(2)));
constexpr int BM = 256, BK = 64, HALF = 128, HTB = HALF * BK * 2  , STAGE_BYTES = 8 * HTB, NXCD = 8, WGM = 8;

__host__ __device__ __forceinline__ int lds_byte(int r, int c) { const int st = (r >> 4) * 2 + (c >> 5), rr = r & 15, cc = c & 31, ob = rr * 64 + cc * 2; return st * 1024 + (ob ^ (((ob >> 9) & 1) << 5)); }
__host__ __device__ __forceinline__ void stage_rc(int b, int& R, int& C) { const int st = b / 1024, sb = b % 1024, swz = sb ^ (((sb >> 9) & 1) << 5); R = (st >> 1) * 16 + swz / 64; C = (st & 1) * 32 + (swz % 64) / 2; }
__host__ __device__ __forceinline__ int perm32(int rho) { const int n = rho >> 4, i = rho & 15; return 8 * (i >> 2) + 4 * n + (i & 3); }

struct Unit { int pm, pn, kq; };
struct Gemm { const bf16_t* A; const bf16_t* Bt; int lda; int K; int hshift; };

struct StaticOrder {
    int nM, nN, nwg, G, c, wgm;
    __host__ __device__ void init(int nM_, int nN_, int G_, int c_, int wgm_ = 4) { nM = nM_; nN = nN_; nwg = nM * nN; G = G_; c = c_; wgm = wgm_; }
    __host__ __device__ bool next(int i, Unit& u) const {
        const long L = (long)i * G + c; if (L >= nwg) return false;
        int wgid = (int)L; { const int q = nwg / NXCD, r = nwg % NXCD, xcd = wgid % NXCD, off = wgid / NXCD; wgid = (xcd < r ? xcd * (q + 1) : r * (q + 1) + (xcd - r) * q) + off; }
        const int nig = wgm * nN, gid = wgid / nig, fm = gid * wgm, gsz = (nM - fm) < wgm ? (nM - fm) : wgm;
        u.pm = fm + ((wgid % nig) % gsz); u.pn = (wgid % nig) / gsz; u.kq = -1; return true;
    }
    __device__ __forceinline__ void a_ready(const Unit&) const {}
    __device__ __forceinline__ void done(const Unit&) const {}
};

struct SplitTailOrder {
    StaticOrder base; int nMf, nN, ntail, G, c;
    __host__ __device__ void init(int nMf_, int nN_, int ntail_, int G_, int c_, int wgm_ = 4) { nMf = nMf_; nN = nN_; ntail = ntail_; G = G_; c = c_; base.init(nMf_, nN_, G_, c_, wgm_); }
    __host__ __device__ bool next(int i, Unit& u) const {
        const long L = (long)i * G + c; const int nfull = nMf * nN;
        if (L < nfull) return base.next(i, u);
        const int x = (int)(L - nfull); if (x >= ntail * nN * 4) return false;
        u.pm = nMf + x / (nN * 4); u.pn = (x >> 2) % nN; u.kq = x & 3; return true;
    }
    __device__ __forceinline__ void a_ready(const Unit&) const {}
    __device__ __forceinline__ void done(const Unit&) const {}
};
__device__ __forceinline__ u32x4 xw_a(const u32x4 w0, const u32x4 w1) { u32x4 r;
    r.x = (unsigned)__builtin_amdgcn_update_dpp((int)w0.x, (int)w1.x, 0x128, 0xf, 0xc, false); r.y = (unsigned)__builtin_amdgcn_update_dpp((int)w0.y, (int)w1.y, 0x128, 0xf, 0xc, false);
    r.z = (unsigned)__builtin_amdgcn_update_dpp((int)w0.z, (int)w1.z, 0x128, 0xf, 0xc, false); r.w = (unsigned)__builtin_amdgcn_update_dpp((int)w0.w, (int)w1.w, 0x128, 0xf, 0xc, false); return r; }
__device__ __forceinline__ u32x4 xw_b(const u32x4 w0, const u32x4 w1) { u32x4 r;
    r.x = (unsigned)__builtin_amdgcn_update_dpp((int)w1.x, (int)w0.x, 0x128, 0xf, 0x3, false); r.y = (unsigned)__builtin_amdgcn_update_dpp((int)w1.y, (int)w0.y, 0x128, 0xf, 0x3, false);
    r.z = (unsigned)__builtin_amdgcn_update_dpp((int)w1.z, (int)w0.z, 0x128, 0xf, 0x3, false); r.w = (unsigned)__builtin_amdgcn_update_dpp((int)w1.w, (int)w0.w, 0x128, 0xf, 0x3, false); return r; }
__device__ __forceinline__ unsigned cvt_pk_bf16(float lo, float hi) { unsigned r; asm volatile("v_cvt_pk_bf16_f32 %0, %1, %2" : "=v"(r) : "v"(lo), "v"(hi)); return r; }

template <class Epi, class Sched, bool ALIGN_EPI = false, bool SP2 = false, bool SPLITK = false>
__device__ __forceinline__ void gemm_phase(PG8_LAS unsigned char* lds, const Gemm g, const Sched& S, const Epi& E, const int tid_in) {
    int tid_ = tid_in; asm volatile("" : "+v"(tid_));
    const int tid = tid_, wid = __builtin_amdgcn_readfirstlane(tid >> 6), lane = tid & 63, wr = wid >> 2, wc = wid & 3, fr = lane & 15, fq = lane >> 4;
    const int K = g.K, nt = K / BK, lda = g.lda;
    unsigned voffA[2], voffB[2];
#pragma unroll
    for (int i = 0; i < 2; ++i) { int R, C; stage_rc(tid * 16 + i * 8192, R, C); const int Rb = Epi::PERM ? (64 * (R >> 5) + perm32(R & 31)) : R;
        voffA[i] = (unsigned)(R * lda + C) * 2u; voffB[i] = (unsigned)(Rb * K + C) * 2u; }
    const size_t kstep = (size_t)(BK * 2);
    const size_t hstepA = (size_t)HALF * lda * 2, hstepB = (size_t)(Epi::PERM ? 32 : HALF) * K * 2;
    const unsigned ldsw = (unsigned)wid * 1024u;
    const int aoff = lds_byte(wr * 64 + fr, fq * 8), boff = lds_byte(wc * 32 + fr, fq * 8);
#define PG8_KOFF(u) ((SPLITK && (u).kq > 0) ? (size_t)(u).kq * (size_t)(K / 4) * 2 : (size_t)0)
#define PG8_ABASE(u) ((const char*)g.A + ((size_t)(u).pm * 256 * lda + (g.hshift >= 0 ? (size_t)((u).pn >> g.hshift) * 512 : (size_t)0)) * 2 + PG8_KOFF(u))
#define PG8_BBASE(u) ((const char*)g.Bt + (size_t)(u).pn * 256 * K * 2 + PG8_KOFF(u))
#define PG8_SA(b, h) (((b) * 2 + (h)) * HTB)
#define PG8_SB(b, h) ((4 + (b) * 2 + (h)) * HTB)
#define PG8_STAGE(bufoff, gbase, voff) do { _Pragma("unroll") for (int _i = 0; _i < 2; ++_i) \
        __builtin_amdgcn_global_load_lds((const unsigned*)((const char*)(gbase) + (voff)[_i]), (PG8_LAS unsigned*)(lds + (bufoff) + ldsw + _i * 8192), 16, 0, 0); } while (0)
#define PG8_LDA(dst, b, h) do { _Pragma("unroll") for (int m = 0; m < 4; ++m) _Pragma("unroll") for (int k = 0; k < 2; ++k) dst[m][k] = *(const PG8_LAS bf16x8*)(lds + PG8_SA(b, h) + aoff + m * 2048 + k * 1024); } while (0)
#define PG8_LDB(dst, b, h) do { _Pragma("unroll") for (int n = 0; n < 2; ++n) _Pragma("unroll") for (int k = 0; k < 2; ++k) dst[n][k] = *(const PG8_LAS bf16x8*)(lds + PG8_SB(b, h) + boff + n * 2048 + k * 1024); } while (0)
#define PG8_MMA(ai, bj, At, Bt) do { __builtin_amdgcn_s_setprio(1); _Pragma("unroll") for (int m = 0; m < 4; ++m) _Pragma("unroll") for (int n = 0; n < 2; ++n) _Pragma("unroll") for (int k = 0; k < 2; ++k) \
        acc[ai][bj][m][n] = __builtin_amdgcn_mfma_f32_16x16x32_bf16(Bt[n][k], At[m][k], acc[ai][bj][m][n], 0, 0, 0); __builtin_amdgcn_s_setprio(0); } while (0)
#define PG8_WAIT_V(n) asm volatile("s_waitcnt vmcnt(" #n ")" ::: "memory")
#define PG8_WAIT_L(n) asm volatile("s_waitcnt lgkmcnt(" #n ")" ::: "memory")
#define PG8_BAR __builtin_amdgcn_s_barrier()
#define PG8_SCHED __builtin_amdgcn_sched_barrier(0)
    Unit cur, nxt; int ui = 0;
    if (!S.next(0, cur)) return;
    int ntc = (SPLITK && cur.kq >= 0) ? nt / 4 : nt;
    f32x4 acc[2][2][4][2];
#pragma unroll
    for (int a = 0; a < 2; ++a)
#pragma unroll
        for (int b = 0; b < 2; ++b)
#pragma unroll
            for (int m = 0; m < 4; ++m)
#pragma unroll
                for (int n = 0; n < 2; ++n) acc[a][b][m][n] = (f32x4){0.f, 0.f, 0.f, 0.f};
    bf16x8 At[4][2], B0[2][2], B1[2][2];
    const char* cA = PG8_ABASE(cur); const char* cB = PG8_BBASE(cur);
    S.a_ready(cur);
    if constexpr (SP2) {
        PG8_STAGE(PG8_SB(0, 0), cB, voffB); PG8_STAGE(PG8_SB(0, 1), cB + hstepB, voffB); PG8_STAGE(PG8_SA(0, 0), cA, voffA); PG8_STAGE(PG8_SA(0, 1), cA + hstepA, voffA);
        if (wr == 1) PG8_BAR;
        PG8_WAIT_V(2); PG8_BAR;
        PG8_STAGE(PG8_SB(1, 0), cB + kstep, voffB); PG8_STAGE(PG8_SA(1, 0), cA + kstep, voffA); PG8_STAGE(PG8_SB(1, 1), cB + hstepB + kstep, voffB);
        PG8_WAIT_V(6); PG8_BAR;
    } else {
        PG8_STAGE(PG8_SB(0, 0), cB, voffB); PG8_STAGE(PG8_SA(0, 0), cA, voffA); PG8_STAGE(PG8_SB(0, 1), cB + hstepB, voffB); PG8_STAGE(PG8_SA(0, 1), cA + hstepA, voffA);
        if (wr == 1) PG8_BAR;
        PG8_WAIT_V(4); PG8_BAR;
        PG8_STAGE(PG8_SB(1, 0), cB + kstep, voffB); PG8_STAGE(PG8_SA(1, 0), cA + kstep, voffA); PG8_STAGE(PG8_SB(1, 1), cB + hstepB + kstep, voffB);
        PG8_WAIT_V(6); PG8_BAR;
    }
    for (;;) {
        const bool has_next = S.next(ui + 1, nxt);
        const char* nA = has_next ? PG8_ABASE(nxt) : cA; const char* nB = has_next ? PG8_BBASE(nxt) : cB;
        for (int t = 0; t < ntc; t += 2) {
            const bool last = (t == ntc - 2);
            const char* a1 = cA + (size_t)(t + 1) * kstep;
            const char* a2 = last ? nA : cA + (size_t)(t + 2) * kstep; const char* b2 = last ? nB : cB + (size_t)(t + 2) * kstep;
            const char* a3 = a2 + kstep; const char* b3 = b2 + kstep;
            if (last && has_next) S.a_ready(nxt);
            if constexpr (SP2) {
            PG8_LDB(B0, 0, 0); PG8_LDB(B1, 0, 1); PG8_SCHED; PG8_LDA(At, 0, 0); PG8_STAGE(PG8_SA(1, 1), a1 + hstepA, voffA);
            PG8_WAIT_V(8); PG8_WAIT_L(0); PG8_BAR; PG8_MMA(0, 0, At, B0); PG8_MMA(0, 1, At, B1); PG8_BAR; PG8_SCHED;
            PG8_LDA(At, 0, 1); PG8_STAGE(PG8_SB(0, 0), b2, voffB); PG8_STAGE(PG8_SB(0, 1), b2 + hstepB, voffB); PG8_STAGE(PG8_SA(0, 0), a2, voffA);
            PG8_WAIT_V(8); PG8_WAIT_L(0); PG8_BAR; PG8_MMA(1, 0, At, B0); PG8_MMA(1, 1, At, B1); PG8_BAR; PG8_SCHED;
            PG8_LDB(B0, 1, 0); PG8_LDB(B1, 1, 1); PG8_SCHED; PG8_LDA(At, 1, 0); PG8_STAGE(PG8_SA(0, 1), a2 + hstepA, voffA);
            PG8_WAIT_V(8); PG8_WAIT_L(0); PG8_BAR; PG8_MMA(0, 0, At, B0); PG8_MMA(0, 1, At, B1); PG8_BAR; PG8_SCHED;
            PG8_LDA(At, 1, 1); PG8_STAGE(PG8_SB(1, 0), b3, voffB); PG8_STAGE(PG8_SB(1, 1), b3 + hstepB, voffB); PG8_STAGE(PG8_SA(1, 0), a3, voffA);
            PG8_WAIT_V(8); PG8_WAIT_L(0); PG8_BAR; PG8_MMA(1, 0, At, B0); PG8_MMA(1, 1, At, B1); PG8_BAR; PG8_SCHED;
            } else {
            PG8_LDB(B0, 0, 0); PG8_SCHED; PG8_LDA(At, 0, 0); PG8_STAGE(PG8_SA(1, 1), a1 + hstepA, voffA);
            PG8_WAIT_L(8); PG8_BAR; PG8_WAIT_L(0); PG8_MMA(0, 0, At, B0); PG8_BAR; PG8_SCHED;
            PG8_LDB(B1, 0, 1); PG8_STAGE(PG8_SB(0, 0), b2, voffB);
            PG8_BAR; PG8_WAIT_L(0); PG8_MMA(0, 1, At, B1); PG8_BAR;
            PG8_LDA(At, 0, 1); PG8_STAGE(PG8_SA(0, 0), a2, voffA);
            PG8_BAR; PG8_WAIT_L(0); PG8_MMA(1, 0, At, B0); PG8_BAR; PG8_SCHED;
            PG8_STAGE(PG8_SB(0, 1), b2 + hstepB, voffB);
            PG8_WAIT_V(6); PG8_BAR; PG8_MMA(1, 1, At, B1); PG8_BAR;
            PG8_LDB(B0, 1, 0); PG8_SCHED; PG8_LDA(At, 1, 0); PG8_STAGE(PG8_SA(0, 1), a2 + hstepA, voffA);
            PG8_WAIT_L(8); PG8_BAR; PG8_WAIT_L(0); PG8_MMA(0, 0, At, B0); PG8_BAR; PG8_SCHED;
            PG8_LDB(B1, 1, 1); PG8_STAGE(PG8_SB(1, 0), b3, voffB);
            PG8_BAR; PG8_WAIT_L(0); PG8_MMA(0, 1, At, B1); PG8_BAR;
            PG8_LDA(At, 1, 1); PG8_STAGE(PG8_SA(1, 0), a3, voffA);
            PG8_BAR; PG8_WAIT_L(0); PG8_MMA(1, 0, At, B0); PG8_BAR; PG8_SCHED;
            PG8_STAGE(PG8_SB(1, 1), b3 + hstepB, voffB);
            PG8_WAIT_V(6); PG8_BAR; PG8_MMA(1, 1, At, B1); PG8_BAR;
            }
        }
        if constexpr (ALIGN_EPI) { if (wr == 0) PG8_BAR; }
        E(acc, cur, wr, wc, fr, fq); S.done(cur);
        if (!has_next) break;
#pragma unroll
        for (int a = 0; a < 2; ++a)
#pragma unroll
            for (int b = 0; b < 2; ++b)
#pragma unroll
                for (int m = 0; m < 4; ++m)
#pragma unroll
                    for (int n = 0; n < 2; ++n) acc[a][b][m][n] = (f32x4){0.f, 0.f, 0.f, 0.f};
        cur = nxt; cA = nA; cB = nB; ++ui; ntc = (SPLITK && cur.kq >= 0) ? nt / 4 : nt;
        if constexpr (ALIGN_EPI) { if (wr == 1) PG8_BAR; }
    }
    PG8_WAIT_V(0);
    if constexpr (!ALIGN_EPI) { if (wr == 0) PG8_BAR; }
    PG8_BAR;
#undef PG8_KOFF
#undef PG8_ABASE
#undef PG8_BBASE
#undef PG8_SA
#undef PG8_SB
#undef PG8_STAGE
#undef PG8_LDA
#undef PG8_LDB
#undef PG8_MMA
#undef PG8_WAIT_V
#undef PG8_WAIT_L
#undef PG8_BAR
#undef PG8_SCHED
}
}

#ifndef WGM_OUT
#define WGM_OUT 2
#endif
#ifndef WGM_HEAD
#define WGM_HEAD 4
#endif
#define PG8_SP2 true
#define PG8_ALIGN true

constexpr int DM = 2048;
constexpr int NB_P = 4, T_P = 8192, NB_S = 32, T_S = 16;
constexpr int M_P = NB_P * T_P, M_S = NB_S * T_S, M = M_P + M_S;
constexpr int NSTREAM = NB_P + NB_S;
constexpr int NPANEL = M / 256;
constexpr int SSD_INNER = 4096, SSD_HD = 64, SSD_NH = 64, SSD_NG = 8, SSD_DS = 128, SSD_CONVD = 6144, SSD_PROJ = 10304, SSD_NPAD = 10496;
constexpr int ML_INNER = 4096, ML_NH = 8, ML_HD = 512, ML_PROJ = 12304, ML_NPAD = 12544;
constexpr float DN_ALPHA = 1.6817928305074290f;
constexpr float LN_EPS = 1e-5f, RMS_EPS = 1e-6f;
constexpr float ML_QSCALE = 0.04419417382415922f;

constexpr size_t O_YP = 0;
constexpr size_t O_YS = O_YP + (size_t)M_P * DM;
constexpr size_t O_P_SCONV = O_YS + (size_t)M_S * DM;
constexpr size_t O_P_SH = O_P_SCONV + (size_t)2 * NB_P * 3 * SSD_CONVD;
constexpr size_t O_P_MCONV = O_P_SH + (size_t)2 * NB_P * SSD_NH * SSD_HD * SSD_DS;
constexpr size_t O_P_MC = O_P_MCONV + (size_t)2 * NB_P * 3 * ML_INNER;
constexpr size_t O_P_MN = O_P_MC + (size_t)2 * NB_P * ML_NH * ML_HD * ML_HD;
constexpr size_t O_P_MM = O_P_MN + (size_t)2 * NB_P * ML_NH * ML_HD;
constexpr size_t O_S_SCONV = O_P_MM + (size_t)2 * NB_P * ML_NH;
constexpr size_t O_S_SH = O_S_SCONV + (size_t)2 * NB_S * 3 * SSD_CONVD;
constexpr size_t O_S_MCONV = O_S_SH + (size_t)2 * NB_S * SSD_NH * SSD_HD * SSD_DS;
constexpr size_t O_S_MC = O_S_MCONV + (size_t)2 * NB_S * 3 * ML_INNER;
constexpr size_t O_S_MN = O_S_MC + (size_t)2 * NB_S * ML_NH * ML_HD * ML_HD;
constexpr size_t O_S_MM = O_S_MN + (size_t)2 * NB_S * ML_NH * ML_HD;
constexpr size_t O_END = O_S_MM + (size_t)2 * NB_S * ML_NH;

constexpr size_t MiB = 1u << 20;
constexpr size_t WS_CTL = 0, CTL_ZERO_BYTES = 1 * MiB;
constexpr size_t WS_WSSD_IN = 1 * MiB;
constexpr size_t WS_WSSD_OUT = 83 * MiB;
constexpr size_t WS_WML_IN = 115 * MiB;
constexpr size_t WS_WML_QK = 213 * MiB;
constexpr size_t WS_WML_V = 229 * MiB;
constexpr size_t WS_WML_OUT = 237 * MiB;
constexpr size_t WS_XB = 269 * MiB;
constexpr size_t WS_ACT = 399 * MiB;
constexpr size_t ACT_U = (size_t)M * 4096 * 2;
static_assert(ACT_U == 260 * MiB, "unit");
constexpr size_t WS_S_XBCC = WS_ACT + 920 * MiB;
constexpr size_t WS_S_Z = WS_ACT, WS_S_XBC = WS_ACT + 260 * MiB, WS_S_Y = WS_ACT + 650 * MiB, WS_S_DT = WS_ACT + 910 * MiB, WS_S_VPRE = WS_S_XBC;
constexpr size_t WS_M_XM = WS_ACT, WS_M_Q = WS_ACT, WS_M_YG = WS_ACT, WS_M_Z = WS_ACT + 260 * MiB, WS_M_O = WS_ACT + 520 * MiB, WS_M_XC = WS_ACT + 780 * MiB,
                 WS_M_K = WS_ACT + 1040 * MiB, WS_M_VPRE = WS_M_K, WS_M_V = WS_ACT + 1300 * MiB, WS_M_H = WS_M_V, WS_M_GATES = WS_ACT + 1560 * MiB;
constexpr size_t WS_M_S = WS_ACT + 1564 * MiB, WS_M_TOK = WS_ACT + 1600 * MiB, WS_M_CHK = WS_ACT + 1605 * MiB, WS_M_CHP = WS_M_CHK + 512 * 1024;
constexpr size_t WS_END = WS_ACT + 1606 * MiB;
constexpr int ML_NCHUNK = 512 + NB_S;
constexpr int CW_BAR = 4096;

constexpr int NWAVES = 8;
constexpr int ST64 = 144, ST128 = 272;
constexpr int SX_OFF = 0, SXS_OFF = 9216, SB_OFF = 18432, SC_OFF = 35840, SH_OFF = 53248, SW_OFF = 70656, SS_OFF = 79872;
constexpr int RING_BYTES = 131072;
constexpr int LDS_BYTES = 163840;
constexpr int MISC_OFF = LDS_BYTES - 256;
constexpr int STK = 288, STV = 160, MQ_K = 17408, MQ_BUF = 35840, MV_IMG = 10240;
constexpr int MS_OFF = 71680, MV_OFF = 80896, MVT_OFF = 91136, MP_OFF = 111616, MSC_OFF = 128000, MN_OFF = 130048, MNP_OFF = 132096, MQN_OFF = 133120, MNB_OFF = 133376, MTB_OFF = 134400, MDEC_OFF = 135168, MI_OFF = 135424;

#define GAS __attribute__((address_space(1)))
#define LAS __attribute__((address_space(3)))
typedef unsigned short bf16;
typedef unsigned v4u __attribute__((ext_vector_type(4)));
typedef unsigned v2u __attribute__((ext_vector_type(2)));
typedef float f32x4 __attribute__((ext_vector_type(4)));
#define LDS_WAIT() asm volatile("s_waitcnt lgkmcnt(0)" ::: "memory")
#define VM_WAIT() asm volatile("s_waitcnt vmcnt(0)" ::: "memory")
typedef __bf16 bf16x2n __attribute__((ext_vector_type(2)));
__device__ __forceinline__ unsigned f2bf(float f) { return (unsigned)__builtin_bit_cast(unsigned short, (__bf16)f); }
__device__ __forceinline__ unsigned pk2(float lo, float hi) { bf16x2n v; v[0] = (__bf16)lo; v[1] = (__bf16)hi; return __builtin_bit_cast(unsigned, v); }
__device__ __forceinline__ float bf2f(unsigned b) { return __builtin_bit_cast(float, b << 16); }
__device__ __forceinline__ float bflo(unsigned w) { return __builtin_bit_cast(float, w << 16); }
__device__ __forceinline__ float bfhi(unsigned w) { return __builtin_bit_cast(float, w & 0xffff0000u); }
__device__ __forceinline__ float silu_f(float x) { return x * __builtin_amdgcn_rcpf(1.f + __expf(-x)); }
__device__ __forceinline__ float sigmoid_f(float x) { return __builtin_amdgcn_rcpf(1.f + __expf(-x)); }
__device__ __forceinline__ float softplus_f(float x) { return fmaxf(x, 0.f) + __logf(1.f + __expf(-fabsf(x))); }
__device__ __forceinline__ float logsigmoid_f(float x) { return fminf(x, 0.f) - __logf(1.f + __expf(-fabsf(x))); }
#define RDLANE(v, l) __builtin_bit_cast(float, __builtin_amdgcn_readlane(__builtin_bit_cast(int, (float)(v)), (l)))
#define BPERM(v, srclane) __builtin_bit_cast(float, __builtin_amdgcn_ds_bpermute((srclane) << 2, __builtin_bit_cast(int, (float)(v))))
#define DPPF(oldv, srcv, ctrl, rmask) __builtin_bit_cast(float, __builtin_amdgcn_update_dpp(__builtin_bit_cast(int, (float)(oldv)), __builtin_bit_cast(int, (float)(srcv)), (ctrl), (rmask), 0xf, false))
__device__ __forceinline__ float wave_scan_add(float v) {
    v += DPPF(0.f, v, 0x111, 0xf); v += DPPF(0.f, v, 0x112, 0xf); v += DPPF(0.f, v, 0x114, 0xf); v += DPPF(0.f, v, 0x118, 0xf);
    v += DPPF(0.f, v, 0x142, 0xa); v += DPPF(0.f, v, 0x143, 0xc);
    return v;
}
__device__ __forceinline__ float wave_scan_max(float v) {
    const float ni = -3.0e38f;
    v = fmaxf(v, DPPF(ni, v, 0x111, 0xf)); v = fmaxf(v, DPPF(ni, v, 0x112, 0xf)); v = fmaxf(v, DPPF(ni, v, 0x114, 0xf)); v = fmaxf(v, DPPF(ni, v, 0x118, 0xf));
    v = fmaxf(v, DPPF(ni, v, 0x142, 0xa)); v = fmaxf(v, DPPF(ni, v, 0x143, 0xc));
    return v;
}
__device__ __forceinline__ float wave_sum(float v) { return __builtin_bit_cast(float, __builtin_amdgcn_readlane(__builtin_bit_cast(int, wave_scan_add(v)), 63)); }

#define XB_TMO      128
#define XB_XCNT(j)  (256  + 64 * (j))
#define XB_XSUB(j)  (1280 + 64 * (j))
#define XB_XGEN(j)  (2304 + 64 * (j))
#define XB_TOP      3328
#define XB_TOPGEN   3392
#define XCD_BAR_WORDS 3456
#define XB_SPIN_CAP (1u << 21)

__device__ __forceinline__ unsigned xb_ld(unsigned* p)              { return __hip_atomic_load(p, __ATOMIC_RELAXED, __HIP_MEMORY_SCOPE_AGENT); }
__device__ __forceinline__ unsigned xb_add(unsigned* p, unsigned v) { return __hip_atomic_fetch_add(p, v, __ATOMIC_RELAXED, __HIP_MEMORY_SCOPE_AGENT); }
__device__ __forceinline__ unsigned xb_xcc_id() { return (unsigned)__builtin_amdgcn_s_getreg((3 << 11) | 20) & 0xFu; }
#define XB_SPIN(cond, bar) do { unsigned _sp = 0; while (cond) { __builtin_amdgcn_s_sleep(1); \
    if ((++_sp & 255u) == 0u) { if (xb_ld(&(bar)[XB_TMO])) break; if (_sp > XB_SPIN_CAP) { atomicAdd(&(bar)[XB_TMO], 1u); break; } } } } while (0)

struct XcdBarrier {
    unsigned* bar; unsigned x;
    volatile LAS unsigned* st;
};
__device__ __forceinline__ XcdBarrier xcd_barrier_post(unsigned* bar, volatile LAS unsigned* st) {
    XcdBarrier b; b.bar = bar; b.x = xb_xcc_id(); b.st = st;
    if (threadIdx.x == 0) (void)xb_add(&bar[XB_XCNT(b.x)], 1u);
    return b;
}
__device__ __forceinline__ void xcd_barrier_complete(unsigned* bar, unsigned x, unsigned& nloc, unsigned& nx) {
    const unsigned G = gridDim.x * gridDim.y * gridDim.z;
    unsigned sum, cnt, mine, sp = 0u;
    for (;;) {
        sum = 0u; cnt = 0u; mine = 0u;
#pragma unroll
        for (unsigned j = 0; j < 16; ++j) { const unsigned c = xb_ld(&bar[XB_XCNT(j)]); sum += c; cnt += (c > 0u) ? 1u : 0u; mine = (j == x) ? c : mine; }
        if (sum == G) break;
        __builtin_amdgcn_s_sleep(1);
        if ((++sp & 255u) == 0u) { if (xb_ld(&bar[XB_TMO])) break; if (sp > XB_SPIN_CAP) { atomicAdd(&bar[XB_TMO], 1u); break; } }
    }
    nloc = mine > 0u ? mine : 1u; nx = cnt > 0u ? cnt : 1u;
}
__device__ __forceinline__ void xcd_barrier(const XcdBarrier& b, const bool leader) {
    asm volatile("s_waitcnt vmcnt(0)" ::: "memory");
    __syncthreads();
    if (leader) {
        size_t bo_ = 0; asm volatile("" : "+s"(bo_)); unsigned* bar = b.bar + bo_;
        __builtin_amdgcn_s_waitcnt(0);
        unsigned nloc = b.st[0], nx = b.st[1];
        if (nloc == 0u) { xcd_barrier_complete(bar, b.x, nloc, nx); b.st[0] = nloc; b.st[1] = nx; }
        const unsigned old = xb_add(&bar[XB_XSUB(b.x)], 1u);
        const unsigned gen = old / nloc;
        if (old + 1u == (gen + 1u) * nloc) {
            __builtin_amdgcn_fence(__ATOMIC_RELEASE, "agent");
            asm volatile("s_waitcnt vmcnt(0)" ::: "memory");
            const unsigned og = xb_add(&bar[XB_TOP], 1u);
            const unsigned tg = og / nx;
            if (og + 1u == (tg + 1u) * nx) xb_add(&bar[XB_TOPGEN], 1u);
            else XB_SPIN(xb_ld(&bar[XB_TOPGEN]) == tg, bar);
            __builtin_amdgcn_fence(__ATOMIC_ACQUIRE, "agent");
            xb_add(&bar[XB_XGEN(b.x)], 1u);
            asm volatile("s_waitcnt vmcnt(0)" ::: "memory");
        } else {
            XB_SPIN(xb_ld(&bar[XB_XGEN(b.x)]) == gen, bar);
            __builtin_amdgcn_fence(__ATOMIC_ACQUIRE, "agent");
            asm volatile("s_waitcnt vmcnt(0)" ::: "memory");
        }
    }
    __syncthreads();
}

using pg8::Unit; using pg8::u32x4; using pg8::cvt_pk_bf16; using pg8::xw_a; using pg8::xw_b;
struct EpiSsdIn {
    static constexpr bool PERM = true, AFTER_DRAIN = false;
    bf16* Z; bf16* XBC; float* DT;
    __device__ __forceinline__ void operator()(const f32x4 (&acc)[2][2][4][2], const Unit& u, int wr, int wc, int fr, int fq) const {
        if (u.pn < 40) {
            bf16* base; int ldc, colt;
            if (u.pn < 16) { base = Z; ldc = 4096; colt = u.pn * 256; } else { base = XBC; ldc = 6144; colt = (u.pn - 16) * 256; }
            const int rowx = u.pm * 256 + wr * 64 + (fr & 7), colx = colt + wc * 64 + 8 * fq + 32 * (fr >> 3);
#pragma unroll
            for (int ai = 0; ai < 2; ++ai)
#pragma unroll
                for (int m = 0; m < 4; ++m) { bf16* rowp = base + (size_t)(rowx + ai * 128 + m * 16) * ldc + colx; u32x4 w[2];
#pragma unroll
                    for (int bj = 0; bj < 2; ++bj) { const f32x4 v0 = acc[ai][bj][m][0], v1 = acc[ai][bj][m][1];
                        w[bj].x = cvt_pk_bf16(v0[0], v0[1]); w[bj].y = cvt_pk_bf16(v0[2], v0[3]); w[bj].z = cvt_pk_bf16(v1[0], v1[1]); w[bj].w = cvt_pk_bf16(v1[2], v1[3]); }
                    *(u32x4*)(rowp) = xw_a(w[0], w[1]); *(u32x4*)(rowp + (size_t)8 * ldc) = xw_b(w[0], w[1]); }
        } else if (wc == 0) {
            const int row0 = u.pm * 256 + wr * 64 + fr;
#pragma unroll
            for (int ai = 0; ai < 2; ++ai)
#pragma unroll
                for (int m = 0; m < 4; ++m) { float* rowp = DT + (size_t)(row0 + ai * 128 + m * 16) * 64 + 8 * fq;
#pragma unroll
                    for (int bj = 0; bj < 2; ++bj) { *(f32x4*)(rowp + 32 * bj) = acc[ai][bj][m][0]; *(f32x4*)(rowp + 32 * bj + 4) = acc[ai][bj][m][1]; } }
        }
    }
};
struct EpiMlIn {
    static constexpr bool PERM = true, AFTER_DRAIN = false;
    bf16* XM; size_t tstride; float* GATES;
    __device__ __forceinline__ void operator()(const f32x4 (&acc)[2][2][4][2], const Unit& u, int wr, int wc, int fr, int fq) const {
        const int row0 = u.pm * 256 + wr * 64 + fr;
        if (u.pn < 48) {
            bf16* base = XM + (size_t)(u.pn >> 4) * tstride;
            const int rowx = u.pm * 256 + wr * 64 + (fr & 7), colx = (u.pn & 15) * 256 + wc * 64 + 8 * fq + 32 * (fr >> 3);
#pragma unroll
            for (int ai = 0; ai < 2; ++ai)
#pragma unroll
                for (int m = 0; m < 4; ++m) { bf16* rowp = base + (size_t)(rowx + ai * 128 + m * 16) * 4096 + colx; u32x4 w[2];
#pragma unroll
                    for (int bj = 0; bj < 2; ++bj) { const f32x4 v0 = acc[ai][bj][m][0], v1 = acc[ai][bj][m][1];
                        w[bj].x = cvt_pk_bf16(v0[0], v0[1]); w[bj].y = cvt_pk_bf16(v0[2], v0[3]); w[bj].z = cvt_pk_bf16(v1[0], v1[1]); w[bj].w = cvt_pk_bf16(v1[2], v1[3]); }
                    *(u32x4*)(rowp) = xw_a(w[0], w[1]); *(u32x4*)(rowp + 8 * 4096) = xw_b(w[0], w[1]); }
        } else if (wc == 0 && fq < 2) {
#pragma unroll
            for (int ai = 0; ai < 2; ++ai)
#pragma unroll
                for (int m = 0; m < 4; ++m) { float* rowp = GATES + (size_t)(row0 + ai * 128 + m * 16) * 16 + 8 * fq;
                    *(f32x4*)(rowp) = acc[ai][0][m][0]; *(f32x4*)(rowp + 4) = acc[ai][0][m][1]; }
        }
    }
};
template <int MODE> struct EpiHead {
    static constexpr bool PERM = true, AFTER_DRAIN = false;
    bf16* O0; bf16* O1; float scale0;
    __device__ __forceinline__ void operator()(const f32x4 (&acc)[2][2][4][2], const Unit& u, int wr, int wc, int fr, int fq) const {
        bf16* base; int colt; float sc = 1.f;
        if (MODE == 0) { base = O0; colt = u.pn * 256; }
        else { const int head = u.pn >> 2, sub = u.pn & 3; if (sub < 2) { base = O0; colt = head * 512 + sub * 256; sc = scale0; } else { base = O1; colt = head * 512 + (sub - 2) * 256; } }
        const int rowx = u.pm * 256 + wr * 64 + (fr & 7), colx = colt + wc * 64 + 8 * fq + 32 * (fr >> 3);
#pragma unroll
        for (int ai = 0; ai < 2; ++ai)
#pragma unroll
            for (int m = 0; m < 4; ++m) { bf16* rowp = base + (size_t)(rowx + ai * 128 + m * 16) * 4096 + colx; u32x4 w[2];
#pragma unroll
                for (int bj = 0; bj < 2; ++bj) { const f32x4 v0 = acc[ai][bj][m][0] * sc, v1 = acc[ai][bj][m][1] * sc;
                    w[bj].x = cvt_pk_bf16(v0[0], v0[1]); w[bj].y = cvt_pk_bf16(v0[2], v0[3]); w[bj].z = cvt_pk_bf16(v1[0], v1[1]); w[bj].w = cvt_pk_bf16(v1[2], v1[3]); }
                *(u32x4*)(rowp) = xw_a(w[0], w[1]); *(u32x4*)(rowp + 8 * 4096) = xw_b(w[0], w[1]); }
    }
};
struct EpiResid {
    static constexpr bool PERM = true, AFTER_DRAIN = false;
    const bf16* XB; bf16* V; float alpha; float* SLAB;
    __device__ __forceinline__ void operator()(const f32x4 (&acc)[2][2][4][2], const Unit& u, int wr, int wc, int fr, int fq) const {
        const int row0 = u.pm * 256 + wr * 64 + fr, col0 = u.pn * 256 + wc * 64 + 8 * fq;
        if (u.kq >= 0) {
#pragma unroll
            for (int ai = 0; ai < 2; ++ai)
#pragma unroll
                for (int m = 0; m < 4; ++m) { float* sp = SLAB + ((size_t)u.kq * M_S + (row0 + ai * 128 + m * 16 - M_P)) * DM + col0;
#pragma unroll
                    for (int bj = 0; bj < 2; ++bj) { *(f32x4*)(sp + bj * 32) = acc[ai][bj][m][0]; *(f32x4*)(sp + bj * 32 + 4) = acc[ai][bj][m][1]; } }
            return;
        }
#pragma unroll
        for (int ai = 0; ai < 2; ++ai)
#pragma unroll
            for (int m = 0; m < 4; ++m) { const size_t off = (size_t)(row0 + ai * 128 + m * 16) * DM + col0; u32x4 w[2];
#pragma unroll
                for (int bj = 0; bj < 2; ++bj) { const v4u xw = *(const v4u*)(XB + off + bj * 32); const f32x4 v0 = acc[ai][bj][m][0], v1 = acc[ai][bj][m][1];
                    w[bj].x = cvt_pk_bf16(alpha * bflo(xw.x) + v0[0], alpha * bfhi(xw.x) + v0[1]); w[bj].y = cvt_pk_bf16(alpha * bflo(xw.y) + v0[2], alpha * bfhi(xw.y) + v0[3]);
                    w[bj].z = cvt_pk_bf16(alpha * bflo(xw.z) + v1[0], alpha * bfhi(xw.z) + v1[1]); w[bj].w = cvt_pk_bf16(alpha * bflo(xw.w) + v1[2], alpha * bfhi(xw.w) + v1[3]); }
                bf16* vp = V + (size_t)(u.pm * 256 + wr * 64 + (fr & 7) + ai * 128 + m * 16) * DM + col0 + 32 * (fr >> 3);
                *(u32x4*)(vp) = xw_a(w[0], w[1]); *(u32x4*)(vp + 8 * DM) = xw_b(w[0], w[1]); }
    }
};

__device__ __forceinline__ void transpose_item(const float* W, int ldw, int nvalid, int K, bf16* WT, int kb, int nb, LAS float* scr, int lane) {
    const int k0 = 64 * kb, n0 = 32 * nb;
    const int n4 = (lane & 7) * 4, nn = n0 + n4;
    f32x4 wv[8];
#pragma unroll
    for (int i = 0; i < 8; ++i) { const int kk = (lane >> 3) + 8 * i; wv[i] = nn < nvalid ? *(const f32x4*)(W + (size_t)(k0 + kk) * ldw + nn) : (f32x4){0.f, 0.f, 0.f, 0.f}; }
#pragma unroll
    for (int i = 0; i < 8; ++i) { const int kk = (lane >> 3) + 8 * i; LAS float* d = scr + kk * 33 + n4; d[0] = wv[i][0]; d[1] = wv[i][1]; d[2] = wv[i][2]; d[3] = wv[i][3]; }
    LDS_WAIT(); asm volatile("" ::: "memory");
    const int c = lane & 7;
#pragma unroll
    for (int j = 0; j < 4; ++j) { const int n = (lane >> 3) + 8 * j; const LAS float* s = scr + (8 * c) * 33 + n;
        v4u o; o.x = pk2(s[0 * 33], s[1 * 33]); o.y = pk2(s[2 * 33], s[3 * 33]); o.z = pk2(s[4 * 33], s[5 * 33]); o.w = pk2(s[6 * 33], s[7 * 33]);
        *(v4u*)(WT + (size_t)(n0 + n) * K + k0 + 8 * c) = o; }
    LDS_WAIT(); asm volatile("" ::: "memory");
}

typedef short bf16x8 __attribute__((ext_vector_type(8)));
typedef short v4s __attribute__((ext_vector_type(4)));
__device__ __forceinline__ bf16x8 lds_tr_frag(LAS unsigned char* img, int stride, int krow0, int q, int colbyte) {
    const v4s lo = __builtin_amdgcn_ds_read_tr16_b64_v4i16((LAS v4s*)(img + (krow0 + q) * stride + colbyte));
    const v4s hi = __builtin_amdgcn_ds_read_tr16_b64_v4i16((LAS v4s*)(img + (krow0 + 4 + q) * stride + colbyte));
    return (bf16x8){lo[0], lo[1], lo[2], lo[3], hi[0], hi[1], hi[2], hi[3]};
}
__device__ __forceinline__ void ml_gate_scalars(const float* GATES, int r0, int Lv, int hd, float bi, float bfv, int lane, float& b, float& a, float& pm) {
    float lf = 0.f, li = -1e30f;
    if (lane < Lv) { const float* gp = GATES + (size_t)(r0 + lane) * 16; li = gp[hd] + bi; lf = logsigmoid_f(gp[8 + hd] + bfv); }
    b = wave_scan_add(lf);
    a = li - b; pm = wave_scan_max(a);
}
template <int C> __device__ __forceinline__ void conv_pass(const bf16* raw, bf16* outp, const float* cw, const float* cb, const float* st_in, float* so_p, float* so_s, size_t gtid, size_t NGT) {
    constexpr int NCH = C / 8, NBLK = M / 16;
    for (size_t it = gtid; it < (size_t)NBLK * NCH; it += NGT) {
        const int rb = (int)(it / NCH), c0 = (int)(it % NCH) * 8;
        int s, t0; if (rb < M_P / 16) { s = rb >> 9; t0 = (rb & 511) * 16; } else { s = NB_P + (rb - M_P / 16); t0 = 0; }
        const int row0 = rb * 16;
        const bool lastblk = (s >= NB_P) || ((rb & 511) == 511);
        v4u rw[16];
#pragma unroll
        for (int r = 0; r < 16; ++r) rw[r] = *(const v4u*)(raw + (size_t)(row0 + r) * C + c0);
        float h0[8], h1[8], h2[8];
        if (t0 > 0) { const v4u a = *(const v4u*)(raw + (size_t)(row0 - 3) * C + c0), b = *(const v4u*)(raw + (size_t)(row0 - 2) * C + c0), c = *(const v4u*)(raw + (size_t)(row0 - 1) * C + c0);
            h0[0] = bflo(a.x); h0[1] = bfhi(a.x); h0[2] = bflo(a.y); h0[3] = bfhi(a.y); h0[4] = bflo(a.z); h0[5] = bfhi(a.z); h0[6] = bflo(a.w); h0[7] = bfhi(a.w);
            h1[0] = bflo(b.x); h1[1] = bfhi(b.x); h1[2] = bflo(b.y); h1[3] = bfhi(b.y); h1[4] = bflo(b.z); h1[5] = bfhi(b.z); h1[6] = bflo(b.w); h1[7] = bfhi(b.w);
            h2[0] = bflo(c.x); h2[1] = bfhi(c.x); h2[2] = bflo(c.y); h2[3] = bfhi(c.y); h2[4] = bflo(c.z); h2[5] = bfhi(c.z); h2[6] = bflo(c.w); h2[7] = bfhi(c.w);
        } else if (s >= NB_P) { const float* sp = st_in + (size_t)(s - NB_P) * 3 * C + c0;
#pragma unroll
            for (int e = 0; e < 8; ++e) { h0[e] = sp[e]; h1[e] = sp[C + e]; h2[e] = sp[2 * C + e]; }
        } else {
#pragma unroll
            for (int e = 0; e < 8; ++e) { h0[e] = 0.f; h1[e] = 0.f; h2[e] = 0.f; } }
        float w0[8], w1[8], w2[8], w3[8], bb[8];
#pragma unroll
        for (int e = 0; e < 8; ++e) { w0[e] = cw[c0 + e]; w1[e] = cw[C + c0 + e]; w2[e] = cw[2 * C + c0 + e]; w3[e] = cw[3 * C + c0 + e]; bb[e] = cb[c0 + e]; }
#pragma unroll
        for (int r = 0; r < 16; ++r) {
            const v4u w = rw[r]; const float x[8] = {bflo(w.x), bfhi(w.x), bflo(w.y), bfhi(w.y), bflo(w.z), bfhi(w.z), bflo(w.w), bfhi(w.w)};
            float y[8];
#pragma unroll
            for (int e = 0; e < 8; ++e) { y[e] = silu_f(bb[e] + w0[e] * h0[e] + w1[e] * h1[e] + w2[e] * h2[e] + w3[e] * x[e]); h0[e] = h1[e]; h1[e] = h2[e]; h2[e] = x[e]; }
            v4u o; o.x = pk2(y[0], y[1]); o.y = pk2(y[2], y[3]); o.z = pk2(y[4], y[5]); o.w = pk2(y[6], y[7]);
            *(v4u*)(outp + (size_t)(row0 + r) * C + c0) = o;
        }
        if (lastblk) { float* so = (s < NB_P ? so_p + (size_t)s * 3 * C : so_s + (size_t)(s - NB_P) * 3 * C) + c0;
#pragma unroll
            for (int e = 0; e < 8; ++e) { so[e] = h0[e]; so[C + e] = h1[e]; so[2 * C + e] = h2[e]; } }
    }
}
struct Args { const float* in[29]; float* out; unsigned char* ws; int ph_lo, ph_hi; };

__device__ __forceinline__ int stream_T(int s) { return s < NB_P ? T_P : T_S; }
__device__ __forceinline__ int stream_row0(int s) { return s < NB_P ? s * T_P : M_P + (s - NB_P) * T_S; }

__global__ void __launch_bounds__(NWAVES * 64, 2) mk_fwd(Args args) {
    extern __shared__ __attribute__((aligned(16))) unsigned char lds_raw[];
    LAS unsigned char* lds = (LAS unsigned char*)lds_raw;
    volatile LAS unsigned* MISC = (volatile LAS unsigned*)(lds + MISC_OFF);
    const int G = gridDim.x, bx = blockIdx.x;
    const int wave0 = __builtin_amdgcn_readfirstlane((int)threadIdx.x >> 6);
    const int NGW = G * NWAVES; const size_t NGT = (size_t)G * (NWAVES * 64);
#define SITE_VARS() int lane__; asm volatile("v_mbcnt_lo_u32_b32 %0, -1, 0\n\tv_mbcnt_hi_u32_b32 %0, -1, %0" : "=v"(lane__)); int tid_ = wave0 * 64 + lane__; asm volatile("" : "+v"(tid_)); const int tid = tid_, lane = tid & 63, wave = __builtin_amdgcn_readfirstlane(tid >> 6); \
    const int gw = bx * NWAVES + wave; const size_t gtid = (size_t)bx * (NWAVES * 64) + tid; (void)lane; (void)gw; (void)gtid
    unsigned char* ws0 = args.ws; unsigned char* ws = ws0;
    unsigned* ctl = (unsigned*)(ws + WS_CTL);
    float* out0 = args.out; float* out = out0; (void)out;

    for (int u = threadIdx.x; u < (LDS_BYTES - RING_BYTES) / 4; u += NWAVES * 64) ((LAS unsigned*)(lds + RING_BYTES))[u] = 0u;
    __syncthreads();
#if MK_ONE_LAUNCH
    XcdBarrier bar = xcd_barrier_post(ctl + CW_BAR, MISC + 8);
#define GRID_BAR() do { int lane__; asm volatile("v_mbcnt_lo_u32_b32 %0, -1, 0\n\tv_mbcnt_hi_u32_b32 %0, -1, %0" : "=v"(lane__)); xcd_barrier(bar, wave0 == 0 && lane__ == 0); } while (0)
#else
#define GRID_BAR() do { } while (0)
#endif
    const int lo = args.ph_lo, hi = args.ph_hi;
#define IN(k) (lo <= (k) && (k) < hi)
#define SEAM(a, b) do { if (IN(a) && IN(b)) GRID_BAR(); } while (0)

    const float* x_prompt = args.in[0]; const float* x_sample = args.in[1];
    const float* st_sconv = args.in[2]; const float* st_sh = args.in[3]; const float* st_mconv = args.in[4];
    const float* st_mC = args.in[5]; const float* st_mn = args.in[6]; const float* st_mm = args.in[7];
    bf16* XB = (bf16*)(ws + WS_XB);

    if (IN(0)) {
        SITE_VARS();
        LAS float* scr = (LAS float*)(lds + wave * 16384);
        constexpr int I_SIN = 32 * (SSD_NPAD / 32), I_SOUT = 64 * 64, I_MIN = 32 * (ML_NPAD / 32), I_H = 8 * 16, I_MOUT = 64 * 64;
        constexpr int PER_L = I_SIN + I_SOUT + I_MIN + 3 * 8 * I_H + I_MOUT;
        for (int it = gw; it < 2 * PER_L; it += NGW) {
            const int j = it / PER_L; int r = it % PER_L;
            if (r < I_SIN) { const int nbn = SSD_NPAD / 32; transpose_item(args.in[8] + (size_t)j * DM * SSD_PROJ, SSD_PROJ, SSD_PROJ, DM, (bf16*)(ws + WS_WSSD_IN) + (size_t)j * SSD_NPAD * DM, r / nbn, r % nbn, scr, lane); continue; } r -= I_SIN;
            if (r < I_SOUT) { transpose_item(args.in[15] + (size_t)j * SSD_INNER * DM, DM, DM, SSD_INNER, (bf16*)(ws + WS_WSSD_OUT) + (size_t)j * DM * SSD_INNER, r / 64, r % 64, scr, lane); continue; } r -= I_SOUT;
            if (r < I_MIN) { const int nbn = ML_NPAD / 32; transpose_item(args.in[16] + (size_t)j * DM * ML_PROJ, ML_PROJ, ML_PROJ, DM, (bf16*)(ws + WS_WML_IN) + (size_t)j * ML_NPAD * DM, r / nbn, r % nbn, scr, lane); continue; } r -= I_MIN;
            if (r < 3 * 8 * I_H) { const int which = r / (8 * I_H), rr = r % (8 * I_H), head = rr / I_H, it2 = rr % I_H;
                const float* W = args.in[19 + which] + ((size_t)(j * 8 + head) * 512) * 512;
                bf16* WT = which == 2 ? (bf16*)(ws + WS_WML_V) + ((size_t)j * 4096 + head * 512) * 512
                                      : (bf16*)(ws + WS_WML_QK) + ((size_t)j * 8192 + head * 1024 + which * 512) * 512;
                transpose_item(W, 512, 512, 512, WT, it2 / 16, it2 % 16, scr, lane); continue; } r -= 3 * 8 * I_H;
            transpose_item(args.in[26] + (size_t)j * ML_INNER * DM, DM, DM, ML_INNER, (bf16*)(ws + WS_WML_OUT) + (size_t)j * DM * ML_INNER, r / 64, r % 64, scr, lane);
        }
        for (size_t i = gtid; i < (size_t)M * DM / 8; i += NGT) {
            const size_t e = i * 8;
            const float* src = e < (size_t)M_P * DM ? x_prompt + e : x_sample + (e - (size_t)M_P * DM);
            const f32x4 a = *(const f32x4*)src, b = *(const f32x4*)(src + 4);
            v4u o; o.x = pk2(a[0], a[1]); o.y = pk2(a[2], a[3]); o.z = pk2(b[0], b[1]); o.w = pk2(b[2], b[3]);
            *(v4u*)(XB + e) = o;
        }
    }
    SEAM(0, 1);

    for (int jp = 0; jp < 2; ++jp) {
        {
            const int li = 2 * jp, pb = 1 + 8 * li, j = jp;
            size_t lo_ = 0; asm volatile("" : "+s"(lo_)); unsigned char* ws = ws0 + lo_; float* out = out0 + lo_;
            bf16* Z = (bf16*)(ws + WS_S_Z); bf16* XBC = (bf16*)(ws + WS_S_XBC); bf16* Y = (bf16*)(ws + WS_S_Y); bf16* XBCC = (bf16*)(ws + WS_S_XBCC); float* DT = (float*)(ws + WS_S_DT); bf16* VPRE = (bf16*)(ws + WS_S_VPRE); float* SLAB = (float*)(ws + WS_S_VPRE + 136 * MiB);
            const float* conv_w = args.in[9] + (size_t)j * 4 * SSD_CONVD; const float* conv_b = args.in[10] + (size_t)j * SSD_CONVD;
            if (IN(pb + 0)) {
                SITE_VARS();
                pg8::Gemm g{XB, (const bf16*)(ws + WS_WSSD_IN) + (size_t)j * SSD_NPAD * DM, DM, DM, -1};
                pg8::StaticOrder S; S.init(NPANEL, SSD_NPAD / 256, G, bx);
                EpiSsdIn E{Z, XBC, DT};
                pg8::gemm_phase<EpiSsdIn, pg8::StaticOrder, PG8_ALIGN, PG8_SP2>(lds, g, S, E, tid);
            }
            SEAM(pb + 0, pb + 1);
            if (IN(pb + 1)) {
                SITE_VARS();
                conv_pass<SSD_CONVD>(XBC, XBCC, conv_w, conv_b, st_sconv + (size_t)j * NB_S * 3 * SSD_CONVD, out + O_P_SCONV + (size_t)j * NB_P * 3 * SSD_CONVD, out + O_S_SCONV + (size_t)j * NB_S * 3 * SSD_CONVD, gtid, NGT);
            }
            SEAM(pb + 1, pb + 2);
            if (IN(pb + 2)) {
                SITE_VARS();
                const float* dt_bias = args.in[11] + j * 64; const float* A_log = args.in[12] + j * 64; const float* Dp = args.in[13] + j * 64;
                const int g4 = lane >> 4, l15 = lane & 15, q4 = l15 >> 2, p4 = lane & 3;
                LAS unsigned char* Xi = lds + SX_OFF; LAS unsigned char* XSi = lds + SXS_OFF; LAS unsigned char* Bi = lds + SB_OFF; LAS unsigned char* Ci = lds + SC_OFF;
                LAS unsigned char* Hi = lds + SH_OFF; LAS unsigned char* Wi = lds + SW_OFF;
                LAS float* cumS = (LAS float*)(lds + SS_OFF); LAS float* dtS = cumS + 64; LAS float* tailS = cumS + 128; LAS float* ecumS = cumS + 192;
                for (int u = bx; u < NSTREAM * SSD_NH; u += G) {
                    const int s = u >> 6, hd = u & 63, grp = hd >> 3;
                    const int T = stream_T(s), row0 = stream_row0(s), Lv = T < 64 ? T : 64, nch = T < 64 ? 1 : T / 64;
                    const float Aneg = -__expf(A_log[hd]), dtb = dt_bias[hd], Dh = Dp[hd];
                    f32x4 st[4];
                    if (s < NB_P) {
#pragma unroll
                        for (int pt = 0; pt < 4; ++pt) st[pt] = (f32x4){0.f, 0.f, 0.f, 0.f};
                    } else {
#pragma unroll
                        for (int pt = 0; pt < 4; ++pt) st[pt] = *(const f32x4*)(st_sh + (((size_t)(j * NB_S + (s - NB_P)) * SSD_NH + hd) * SSD_HD + pt * 16 + l15) * SSD_DS + wave * 16 + 4 * g4);
                    }
                    v4u xr, br[2], cr[2];
#define SSD_LOADS(cn) do { const char* xb_ = (const char*)(XBCC + ((size_t)row0 + (size_t)(cn) * 64) * SSD_CONVD + hd * 64); \
    xr = *(const v4u*)(xb_ + xo_u); if ((tid >> 3) >= Lv) xr = (v4u){0u, 0u, 0u, 0u}; \
    br[0] = *(const v4u*)(xb_ + bo_u0); cr[0] = *(const v4u*)(xb_ + bo_u0 + 2048); br[1] = *(const v4u*)(xb_ + bo_u1); cr[1] = *(const v4u*)(xb_ + bo_u1 + 2048); \
    if ((tid >> 4) >= Lv) { br[0] = (v4u){0u, 0u, 0u, 0u}; cr[0] = (v4u){0u, 0u, 0u, 0u}; } if ((tid >> 4) + 32 >= Lv) { br[1] = (v4u){0u, 0u, 0u, 0u}; cr[1] = (v4u){0u, 0u, 0u, 0u}; } \
    } while (0)
#define SSD_DTLOAD(cn) (*(const float*)((const char*)(DT + ((size_t)row0 + (size_t)(cn) * 64) * 64 + hd) + do_u))
#define SSD_SCALARS(bufp, dtrv) do { float dtv_ = 0.f; if (lane < Lv) dtv_ = softplus_f((dtrv) + dtb); const float cs_ = wave_scan_add(dtv_ * Aneg); const float c63_ = RDLANE(cs_, 63); LAS float* sb_ = (bufp); \
    sb_[lane] = cs_ * 1.44269504f; sb_[64 + lane] = cs_ * 1.44269504f - __builtin_amdgcn_logf(dtv_); sb_[128 + lane] = __expf(c63_ - cs_) * dtv_; sb_[192 + lane] = __expf(cs_); if (lane == 0) sb_[256] = __expf(c63_); } while (0)
                    const unsigned xo_u = (unsigned)(((tid >> 3) < Lv ? (tid >> 3) : Lv - 1) * SSD_CONVD + (tid & 7) * 8) * 2u;
                    const unsigned bo_u0 = (unsigned)(((tid >> 4) < Lv ? (tid >> 4) : Lv - 1) * SSD_CONVD + 4096 - hd * 64 + grp * 128 + (tid & 15) * 8) * 2u;
                    const unsigned bo_u1 = (unsigned)(((tid >> 4) + 32 < Lv ? (tid >> 4) + 32 : Lv - 1) * SSD_CONVD + 4096 - hd * 64 + grp * 128 + (tid & 15) * 8) * 2u;
                    const unsigned do_u = (unsigned)((lane < Lv ? lane : Lv - 1) * 64) * 4u;
                    SSD_LOADS(0);
                    float dtn = 0.f;
                    if (wave == 4) { const float dt0_ = SSD_DTLOAD(0); dtn = SSD_DTLOAD(nch > 1 ? 1 : 0); SSD_SCALARS(cumS, dt0_); }
                    __syncthreads();
                    for (int c = 0; c < nch; ++c) {
                        const int r0 = row0 + c * 64;
                        LAS float* cumC = cumS + (c & 1) * 320; LAS float* dtC = cumC + 64; LAS float* tailC = cumC + 128; LAS float* ecumC = cumC + 192;
                        { const int t = tid >> 3, c8 = (tid & 7) * 8; *(LAS v4u*)(Xi + t * ST64 + c8 * 2) = xr;
                          const float tl = tailC[t]; v4u o;
                          o.x = pk2(bflo(xr.x) * tl, bfhi(xr.x) * tl); o.y = pk2(bflo(xr.y) * tl, bfhi(xr.y) * tl); o.z = pk2(bflo(xr.z) * tl, bfhi(xr.z) * tl); o.w = pk2(bflo(xr.w) * tl, bfhi(xr.w) * tl);
                          *(LAS v4u*)(XSi + t * ST64 + c8 * 2) = o; }
#pragma unroll
                        for (int i = 0; i < 2; ++i) { const int e = tid + 512 * i, t = e >> 4, c8 = (e & 15) * 8; *(LAS v4u*)(Bi + t * ST128 + c8 * 2) = br[i]; *(LAS v4u*)(Ci + t * ST128 + c8 * 2) = cr[i]; }
#pragma unroll
                        for (int pt = 0; pt < 4; ++pt) { v2u w; w.x = pk2(st[pt][0], st[pt][1]); w.y = pk2(st[pt][2], st[pt][3]); *(LAS v2u*)(Hi + (pt * 16 + l15) * ST128 + (wave * 16 + 4 * g4) * 2) = w; }
                        __syncthreads();
                        SSD_LOADS(c + 1 < nch ? c + 1 : nch - 1);
                        if (wave == 4) { SSD_SCALARS(cumS + ((c + 1) & 1) * 320, dtn); dtn = SSD_DTLOAD(c + 2 < nch ? c + 2 : nch - 1); }
                        {
                            const int si = wave >> 1;
                            bf16x8 af[4];
#pragma unroll
                            for (int kk = 0; kk < 4; ++kk) af[kk] = *(const LAS bf16x8*)(Bi + (si * 16 + l15) * ST128 + (kk * 32 + 8 * g4) * 2);
                            const f32x4 g_s = *(const LAS f32x4*)(dtC + si * 16 + 4 * g4);
#pragma unroll
                            for (int tj = 0; tj < 2; ++tj) {
                                const int ti = 2 * (wave & 1) + tj, t = ti * 16 + l15;
                                v2u w; w.x = 0u; w.y = 0u;
                                if (si <= ti) {
                                    f32x4 d = (f32x4){0.f, 0.f, 0.f, 0.f};
#pragma unroll
                                    for (int kk = 0; kk < 4; ++kk) { const bf16x8 bfr = *(const LAS bf16x8*)(Ci + t * ST128 + (kk * 32 + 8 * g4) * 2); d = __builtin_amdgcn_mfma_f32_16x16x32_bf16(af[kk], bfr, d, 0, 0, 0); }
                                    const float cum_t = cumC[t]; float wv[4];
#pragma unroll
                                    for (int r = 0; r < 4; ++r) wv[r] = d[r] * __builtin_amdgcn_exp2f(cum_t - g_s[r]);
                                    if (si == ti) {
#pragma unroll
                                        for (int r = 0; r < 4; ++r) { float w_ = wv[r]; asm volatile("" : "+v"(w_)); wv[r] = (4 * g4 + r <= l15) ? w_ : 0.f; } }
                                    w.x = pk2(wv[0], wv[1]); w.y = pk2(wv[2], wv[3]);
                                }
                                *(LAS v2u*)(Wi + t * ST64 + (si * 16 + 4 * g4) * 2) = w;
                            }
                        }
                        __syncthreads();
                        {
                            const int ti = wave >> 1, t = ti * 16 + l15;
                            bf16x8 cf[4], wf[2];
#pragma unroll
                            for (int kk = 0; kk < 4; ++kk) cf[kk] = *(const LAS bf16x8*)(Ci + t * ST128 + (kk * 32 + 8 * g4) * 2);
#pragma unroll
                            for (int ks = 0; ks < 2; ++ks) wf[ks] = *(const LAS bf16x8*)(Wi + t * ST64 + (ks * 32 + 8 * g4) * 2);
                            const float ec = ecumC[t];
#pragma unroll
                            for (int pj = 0; pj < 2; ++pj) {
                                const int pt = 2 * (wave & 1) + pj;
                                f32x4 d = (f32x4){0.f, 0.f, 0.f, 0.f};
#pragma unroll
                                for (int kk = 0; kk < 4; ++kk) { const bf16x8 hf = *(const LAS bf16x8*)(Hi + (pt * 16 + l15) * ST128 + (kk * 32 + 8 * g4) * 2); d = __builtin_amdgcn_mfma_f32_16x16x32_bf16(hf, cf[kk], d, 0, 0, 0); }
                                d = d * ec;
#pragma unroll
                                for (int ks = 0; ks < 2; ++ks) { if (ks == 0 || ti >= 2) { const bf16x8 xf = lds_tr_frag(Xi, ST64, ks * 32 + 8 * g4, q4, (pt * 16 + 4 * p4) * 2); d = __builtin_amdgcn_mfma_f32_16x16x32_bf16(xf, wf[ks], d, 0, 0, 0); } }
                                const v2u xw = *(const LAS v2u*)(Xi + t * ST64 + (pt * 16 + 4 * g4) * 2);
                                d[0] += Dh * bflo(xw.x); d[1] += Dh * bfhi(xw.x); d[2] += Dh * bflo(xw.y); d[3] += Dh * bfhi(xw.y);
                                if (t < Lv) { v2u o; o.x = pk2(d[0], d[1]); o.y = pk2(d[2], d[3]); *(v2u*)(Y + (size_t)(r0 + t) * SSD_INNER + hd * 64 + pt * 16 + 4 * g4) = o; }
                            }
                        }
                        {
                            const float dec = cumC[256];
                            bf16x8 bf2[2];
#pragma unroll
                            for (int ks = 0; ks < 2; ++ks) bf2[ks] = lds_tr_frag(Bi, ST128, ks * 32 + 8 * g4, q4, (wave * 16 + 4 * p4) * 2);
#pragma unroll
                            for (int pt = 0; pt < 4; ++pt) { st[pt] = st[pt] * dec;
#pragma unroll
                                for (int ks = 0; ks < 2; ++ks) { const bf16x8 xf = lds_tr_frag(XSi, ST64, ks * 32 + 8 * g4, q4, (pt * 16 + 4 * p4) * 2); st[pt] = __builtin_amdgcn_mfma_f32_16x16x32_bf16(bf2[ks], xf, st[pt], 0, 0, 0); } }
                        }
                        __syncthreads();
                    }
                    {
                        float* ho = s < NB_P ? out + O_P_SH + ((size_t)(j * NB_P + s) * SSD_NH + hd) * SSD_HD * SSD_DS : out + O_S_SH + ((size_t)(j * NB_S + (s - NB_P)) * SSD_NH + hd) * SSD_HD * SSD_DS;
#pragma unroll
                        for (int pt = 0; pt < 4; ++pt) *(f32x4*)(ho + (size_t)(pt * 16 + l15) * SSD_DS + wave * 16 + 4 * g4) = st[pt];
                    }
                }
            }
            SEAM(pb + 2, pb + 3);
            if (IN(pb + 3)) {
                SITE_VARS();
                const float* norm_w = args.in[14] + (size_t)j * SSD_INNER;
                for (int row = gw; row < M; row += NGW) {
                    const size_t off0 = (size_t)row * SSD_INNER + lane * 8;
                    v4u yw[8], zw[8];
#pragma unroll
                    for (int grp = 0; grp < 8; ++grp) { yw[grp] = *(const v4u*)(Y + off0 + grp * 512); zw[grp] = *(const v4u*)(Z + off0 + grp * 512); }
#pragma unroll
                    for (int grp = 0; grp < 8; ++grp) {
                        float v[8];
                        v[0] = bflo(yw[grp].x) * silu_f(bflo(zw[grp].x)); v[1] = bfhi(yw[grp].x) * silu_f(bfhi(zw[grp].x)); v[2] = bflo(yw[grp].y) * silu_f(bflo(zw[grp].y)); v[3] = bfhi(yw[grp].y) * silu_f(bfhi(zw[grp].y));
                        v[4] = bflo(yw[grp].z) * silu_f(bflo(zw[grp].z)); v[5] = bfhi(yw[grp].z) * silu_f(bfhi(zw[grp].z)); v[6] = bflo(yw[grp].w) * silu_f(bflo(zw[grp].w)); v[7] = bfhi(yw[grp].w) * silu_f(bfhi(zw[grp].w));
                        float ss = 0.f;
#pragma unroll
                        for (int i = 0; i < 8; ++i) ss += v[i] * v[i];
                        const float r = rsqrtf(wave_sum(ss) * (1.f / 512.f) + RMS_EPS);
                        const f32x4 n0 = *(const f32x4*)(norm_w + grp * 512 + lane * 8), n1 = *(const f32x4*)(norm_w + grp * 512 + lane * 8 + 4);
                        v4u o; o.x = pk2(v[0] * r * n0[0], v[1] * r * n0[1]); o.y = pk2(v[2] * r * n0[2], v[3] * r * n0[3]); o.z = pk2(v[4] * r * n1[0], v[5] * r * n1[1]); o.w = pk2(v[6] * r * n1[2], v[7] * r * n1[3]);
                        *(v4u*)(Y + off0 + grp * 512) = o;
                    }
                }
            }
            SEAM(pb + 3, pb + 4);
            if (IN(pb + 4)) {
                SITE_VARS();
                pg8::Gemm g{Y, (const bf16*)(ws + WS_WSSD_OUT) + (size_t)j * DM * SSD_INNER, SSD_INNER, SSD_INNER, -1};
                pg8::SplitTailOrder S; S.init(M_P / 256, DM / 256, M_S / 256, G, bx, WGM_OUT);
                EpiResid E{XB, VPRE, DN_ALPHA, SLAB};
                pg8::gemm_phase<EpiResid, pg8::SplitTailOrder, PG8_ALIGN, PG8_SP2, true>(lds, g, S, E, tid);
            }
            SEAM(pb + 4, pb + 5);
            if (IN(pb + 5)) {
                SITE_VARS();
                const float* lg = args.in[27] + (size_t)li * DM; const float* lb = args.in[28] + (size_t)li * DM;
                for (int row = gw; row < M; row += NGW) {
                    const v4u* vr = (const v4u*)(VPRE + (size_t)row * DM) + lane;
                    const v4u* XBV = (const v4u*)XB;
                    float v[32]; float sm = 0.f;
#pragma unroll
                    for (int q = 0; q < 4; ++q) { v4u w = vr[64 * q]; if (row >= M_P) w = (XBV + (size_t)row * (DM / 8) + lane)[64 * q]; v[8 * q + 0] = bflo(w.x); v[8 * q + 1] = bfhi(w.x); v[8 * q + 2] = bflo(w.y); v[8 * q + 3] = bfhi(w.y); v[8 * q + 4] = bflo(w.z); v[8 * q + 5] = bfhi(w.z); v[8 * q + 6] = bflo(w.w); v[8 * q + 7] = bfhi(w.w); }
                    if (row >= M_P) {
#pragma unroll
                        for (int i = 0; i < 32; ++i) v[i] *= DN_ALPHA;
#pragma unroll
                        for (int kq = 0; kq < 4; ++kq)
#pragma unroll
                            for (int q = 0; q < 4; ++q) { const float* sp = SLAB + ((size_t)kq * M_S + (row - M_P)) * DM + 8 * (lane + 64 * q); const f32x4 s0 = *(const f32x4*)sp, s1 = *(const f32x4*)(sp + 4);
                                v[8 * q + 0] += s0[0]; v[8 * q + 1] += s0[1]; v[8 * q + 2] += s0[2]; v[8 * q + 3] += s0[3]; v[8 * q + 4] += s1[0]; v[8 * q + 5] += s1[1]; v[8 * q + 6] += s1[2]; v[8 * q + 7] += s1[3]; }
                    }
#pragma unroll
                    for (int i = 0; i < 32; ++i) sm += v[i];
                    const float mean = wave_sum(sm) * (1.f / DM); float s2 = 0.f;
#pragma unroll
                    for (int i = 0; i < 32; ++i) { v[i] -= mean; s2 += v[i] * v[i]; }
                    const float rstd = rsqrtf(wave_sum(s2) * (1.f / DM) + LN_EPS);
#pragma unroll
                    for (int q = 0; q < 4; ++q) { const int c = 8 * (lane + 64 * q); const f32x4 g0 = *(const f32x4*)(lg + c), g1 = *(const f32x4*)(lg + c + 4), b0 = *(const f32x4*)(lb + c), b1 = *(const f32x4*)(lb + c + 4);
                        f32x4 o0, o1;
#pragma unroll
                        for (int e = 0; e < 4; ++e) { o0[e] = v[8 * q + e] * rstd * g0[e] + b0[e]; o1[e] = v[8 * q + 4 + e] * rstd * g1[e] + b1[e]; }
                        v4u w; w.x = pk2(o0[0], o0[1]); w.y = pk2(o0[2], o0[3]); w.z = pk2(o1[0], o1[1]); w.w = pk2(o1[2], o1[3]); *(v4u*)(XB + (size_t)row * DM + c) = w; }
                }
            }
            SEAM(pb + 5, pb + 8);
        }
        {
            const int li = 2 * jp + 1, pb = 1 + 8 * li, j = jp;
            size_t lo_ = 0; asm volatile("" : "+s"(lo_)); unsigned char* ws = ws0 + lo_; float* out = out0 + lo_;
            bf16* XM = (bf16*)(ws + WS_M_XM); bf16* Q = (bf16*)(ws + WS_M_Q); bf16* YG = (bf16*)(ws + WS_M_YG); bf16* Z = (bf16*)(ws + WS_M_Z); bf16* O = (bf16*)(ws + WS_M_O);
            bf16* XC = (bf16*)(ws + WS_M_XC); bf16* Kb = (bf16*)(ws + WS_M_K); bf16* Vb = (bf16*)(ws + WS_M_V); bf16* H = (bf16*)(ws + WS_M_H);
            float* GATES = (float*)(ws + WS_M_GATES); bf16* VPRE = (bf16*)(ws + WS_M_VPRE); float* SLAB = (float*)(ws + WS_M_VPRE + 136 * MiB);
            bf16* Sg = (bf16*)(ws + WS_M_S); float* TOK = (float*)(ws + WS_M_TOK); float* CHK = (float*)(ws + WS_M_CHK); float* CHP = (float*)(ws + WS_M_CHP); float* MPREV = (float*)(ws + WS_M_CHK + 768 * 1024);
            if (IN(pb + 0)) {
                SITE_VARS();
                pg8::Gemm g{XB, (const bf16*)(ws + WS_WML_IN) + (size_t)j * ML_NPAD * DM, DM, DM, -1};
                pg8::StaticOrder S; S.init(NPANEL, ML_NPAD / 256, G, bx);
                static_assert(WS_M_Z - WS_M_XM == ACT_U && WS_M_O - WS_M_Z == ACT_U, "XM | Z | O equally spaced");
                EpiMlIn E{XM, ACT_U / 2, GATES};
                pg8::gemm_phase<EpiMlIn, pg8::StaticOrder, PG8_ALIGN, PG8_SP2>(lds, g, S, E, tid);
            }
            SEAM(pb + 0, pb + 1);
            if (IN(pb + 1)) {
                SITE_VARS();
                const float* conv_w = args.in[17] + (size_t)j * 4 * ML_INNER; const float* conv_b = args.in[18] + (size_t)j * ML_INNER;
                conv_pass<ML_INNER>(XM, XC, conv_w, conv_b, st_mconv + (size_t)j * NB_S * 3 * ML_INNER, out + O_P_MCONV + (size_t)j * NB_P * 3 * ML_INNER, out + O_S_MCONV + (size_t)j * NB_S * 3 * ML_INNER, gtid, NGT);
                { const float* b_i = args.in[22] + j * 8; const float* b_f = args.in[23] + j * 8;
                  for (int it = gw; it < ML_NCHUNK * ML_NH; it += NGW) { const int ci = it >> 3, hd = it & 7; const int r0 = ci < 512 ? ci * 64 : M_P + (ci - 512) * 16, Lv = ci < 512 ? 64 : 16;
                      float b, a, pm; ml_gate_scalars(GATES, r0, Lv, hd, b_i[hd], b_f[hd], lane, b, a, pm);
                      if (lane == 63) { CHP[(ci * 8 + hd) * 2] = b; CHP[(ci * 8 + hd) * 2 + 1] = pm; } } }
                __syncthreads();
                pg8::Gemm g{XM, (const bf16*)(ws + WS_WML_V) + (size_t)j * 4096 * 512, ML_INNER, 512, 1};
                pg8::StaticOrder S; S.init(NPANEL, 16, G, bx, WGM_HEAD);
                EpiHead<0> E{Vb, nullptr, 1.f};
                pg8::gemm_phase<EpiHead<0>, pg8::StaticOrder, PG8_ALIGN, PG8_SP2>(lds, g, S, E, tid);
            }
            SEAM(pb + 1, pb + 2);
            if (IN(pb + 2)) {
                SITE_VARS();
                if (gw < NB_P * ML_NH) {
                    const int s = gw >> 3, hd = gw & 7;
                    const float blo = CHP[((s * 128 + lane) * 8 + hd) * 2], plo = CHP[((s * 128 + lane) * 8 + hd) * 2 + 1], bhi = CHP[((s * 128 + 64 + lane) * 8 + hd) * 2], phi = CHP[((s * 128 + 64 + lane) * 8 + hd) * 2 + 1];
                    float m = 0.f, mlo = 0.f, mhi = 0.f;
                    for (int cc = 0; cc < 128; ++cc) { if (cc < 64) { if (lane == cc) mlo = m; } else { if (lane == cc - 64) mhi = m; }
                        const float bb = RDLANE(cc < 64 ? blo : bhi, cc & 63), pp = RDLANE(cc < 64 ? plo : phi, cc & 63); m = bb + fmaxf(m, pp); }
                    MPREV[(s * 128 + lane) * 8 + hd] = mlo; MPREV[(s * 128 + 64 + lane) * 8 + hd] = mhi;
                }
                pg8::Gemm g{XC, (const bf16*)(ws + WS_WML_QK) + (size_t)j * 8192 * 512, ML_INNER, 512, 2};
                pg8::StaticOrder S; S.init(NPANEL, 32, G, bx, WGM_HEAD);
                EpiHead<1> E{Q, Kb, ML_QSCALE};
                pg8::gemm_phase<EpiHead<1>, pg8::StaticOrder, PG8_ALIGN, PG8_SP2>(lds, g, S, E, tid);
            }
            SEAM(pb + 2, pb + 3);
            if (IN(pb + 3)) {
                SITE_VARS();
                const int g4 = lane >> 4, l15 = lane & 15;
                const float* b_i = args.in[22] + j * 8; const float* b_f = args.in[23] + j * 8;
                LAS unsigned char* Qi = lds; LAS unsigned char* Ki = lds + 66560;
                LAS float* eS = (LAS float*)(lds + 133120); LAS float* aS = eS + 64; LAS float* denP = eS + 128;
                for (int u = bx; u < ML_NCHUNK * ML_NH; u += G) {
                    const int ci = u >> 3, hd = u & 7;
                    const int r0 = ci < 512 ? ci * 64 : M_P + (ci - 512) * 16, Lv = ci < 512 ? 64 : 16;
#pragma unroll
                    for (int i = 0; i < 8; ++i) { const int e = tid + 512 * i, t = e >> 6, c8 = (e & 63) * 8; v4u qv = (v4u){0u, 0u, 0u, 0u}, kv = (v4u){0u, 0u, 0u, 0u};
                        if (t < Lv) { qv = *(const v4u*)(Q + (size_t)(r0 + t) * ML_INNER + hd * 512 + c8); kv = *(const v4u*)(Kb + (size_t)(r0 + t) * ML_INNER + hd * 512 + c8); }
                        *(LAS v4u*)(Qi + t * 1040 + c8 * 2) = qv; *(LAS v4u*)(Ki + t * 1040 + c8 * 2) = kv; }
                    float gT = 0.f, emT = 1.f, tailT = 0.f;
                    if (wave == 0) {
                        float b, a, pm; ml_gate_scalars(GATES, r0, Lv, hd, b_i[hd], b_f[hd], lane, b, a, pm);
                        float mprev;
                        if (ci < 512) { mprev = MPREV[ci * 8 + hd];
                        } else mprev = st_mm[(size_t)(j * NB_S + (ci - 512)) * ML_NH + hd];
                        const float mt = b + fmaxf(mprev, pm);
                        const float b63 = RDLANE(b, 63), mnew = RDLANE(mt, 63);
                        eS[lane] = b - mt; aS[lane] = a;
                        gT = __expf(b + mprev - mt); emT = __expf(-mt); tailT = __expf(fminf(a + b63 - mnew, 0.f));
                        if (lane == 0) { CHK[(ci * 8 + hd) * 2] = __expf(b63 + mprev - mnew); CHK[(ci * 8 + hd) * 2 + 1] = mnew; }
                    }
                    __syncthreads();
                    {
                        const int ti = wave >> 1, t = ti * 16 + l15; const float et = eS[t]; float dsum = 0.f;
#pragma unroll
                        for (int sjj = 0; sjj < 2; ++sjj) {
                            const int sj = 2 * (wave & 1) + sjj; v2u w; w.x = 0u; w.y = 0u;
                            if (sj <= ti) {
                                f32x4 d = (f32x4){0.f, 0.f, 0.f, 0.f};
#pragma unroll
                                for (int kk = 0; kk < 16; ++kk) { const bf16x8 af = *(const LAS bf16x8*)(Ki + (sj * 16 + l15) * 1040 + (kk * 32 + 8 * g4) * 2), bfr = *(const LAS bf16x8*)(Qi + t * 1040 + (kk * 32 + 8 * g4) * 2);
                                    d = __builtin_amdgcn_mfma_f32_16x16x32_bf16(af, bfr, d, 0, 0, 0); }
                                const f32x4 as4 = *(const LAS f32x4*)(aS + sj * 16 + 4 * g4); float sv[4];
#pragma unroll
                                for (int r = 0; r < 4; ++r) { const int sidx = sj * 16 + 4 * g4 + r; sv[r] = sidx <= t ? d[r] * __expf(fminf(et + as4[r], 0.f)) : 0.f; dsum += sv[r]; }
                                w.x = pk2(sv[0], sv[1]); w.y = pk2(sv[2], sv[3]);
                            }
                            *(v2u*)(Sg + ((size_t)(ci * 8 + hd) * 64 + t) * 64 + sj * 16 + 4 * g4) = w;
                        }
                        dsum += BPERM(dsum, lane ^ 16); dsum += BPERM(dsum, lane ^ 32);
                        if (g4 == 0) denP[(wave & 1) * 64 + t] = dsum;
                    }
                    __syncthreads();
                    if (wave == 0 && lane < Lv) *(f32x4*)(TOK + ((size_t)(r0 + lane) * 8 + hd) * 4) = (f32x4){gT, emT, denP[lane] + denP[64 + lane], tailT};
                    __syncthreads();
                }
            }
            SEAM(pb + 3, pb + 4);
            if (IN(pb + 4)) {
                SITE_VARS();
                const int v16 = wave & 3, lw = wave & 3, ltid = tid & 255;
#define FRESHI(x) ({ int x__ = (x); asm volatile("" : "+v"(x__)); x__; })
#define LDSV(T, off) (*(LAS T*)(lds + (off)))
#define TRFRAG(off, stride) ({ const v4s lo_ = __builtin_amdgcn_ds_read_tr16_b64_v4i16((LAS v4s*)(lds + (off))); const v4s hi_ = __builtin_amdgcn_ds_read_tr16_b64_v4i16((LAS v4s*)(lds + (off) + 16 * (stride))); \
    (bf16x8){lo_[0], lo_[1], lo_[2], lo_[3], hi_[0], hi_[1], hi_[2], hi_[3]}; })
#define SB() __builtin_amdgcn_sched_barrier(0)
                LAS f32x4* Ib = (LAS f32x4*)(lds + MI_OFF);
                LAS float* scal = (LAS float*)(lds + MSC_OFF);
                LAS float* nS = (LAS float*)(lds + MN_OFF); LAS float* nPart = (LAS float*)(lds + MNP_OFF); LAS float* qnP = (LAS float*)(lds + MQN_OFF); LAS float* decS = (LAS float*)(lds + MDEC_OFF);
                LAS unsigned short* nB = (LAS unsigned short*)(lds + MNB_OFF); LAS unsigned short* tailB = (LAS unsigned short*)(lds + MTB_OFF);
                if (wave < 4) {
                for (int u = bx; u < 2304; u += G) {
                    int s, hd, vs;
                    if (u < 256) { const int pr = (u & 7) + 8 * (u >> 6); vs = (u >> 3) & 7; s = pr >> 3; hd = pr & 7; }
                    else { const int up = u - 256, pr = (up & 7) + 8 * (up >> 6); vs = (up >> 3) & 7; s = NB_P + (pr >> 3); hd = pr & 7; }
                    const int T = stream_T(s), row0 = stream_row0(s), Lv = T < 64 ? T : 64, nch = T < 64 ? 1 : T / 64;
                    const int ci0 = s < NB_P ? s * 128 : 512 + (s - NB_P);
                    const size_t sbi = s < NB_P ? 0 : (size_t)(j * NB_S + (s - NB_P)) * ML_NH + hd;
                    f32x4 R[32];
                    if (s < NB_P) {
                        if (true) {
#pragma unroll
                            for (int i = 0; i < 32; ++i) R[i] = (f32x4){0.f, 0.f, 0.f, 0.f};
                        }
                        nS[tid] = 0.f; nB[tid] = 0;
                    } else {
                        int t2_ = tid; asm volatile("" : "+v"(t2_));
                        const unsigned stio = (unsigned)((t2_ >> 4) * 256 + (t2_ & 15) * 16);
                        const unsigned stld = (unsigned)((4 * ((t2_ >> 4) & 3)) * 256 + (((t2_ >> 6) & 3) * 16 + (t2_ & 15)) * 4);
#pragma unroll
                        for (int h = 0; h < 2; ++h) {
                            const float* gp = st_mC + sbi * ML_HD * ML_HD + (size_t)(h * 256 + (t2_ >> 4)) * ML_HD + vs * 64 + (t2_ & 15) * 4;
#pragma unroll
                            for (int pp = 0; pp < 2; ++pp) { f32x4 tmp[4];
#pragma unroll
                                for (int p = 0; p < 4; ++p) tmp[p] = *(const f32x4*)(gp + (size_t)(pp * 4 + p) * 32 * ML_HD);
#pragma unroll
                                for (int p = 0; p < 4; ++p) LDSV(f32x4, (pp * 4 + p) * 8192 + stio) = tmp[p]; SB(); }
                            __syncthreads();
                            if (true) {
#pragma unroll
                                for (int i2 = 0; i2 < 2; ++i2)
#pragma unroll
                                    for (int kt = 0; kt < 8; ++kt)
#pragma unroll
                                        for (int r = 0; r < 4; ++r) R[(2 * h + i2) * 8 + kt][r] = LDSV(float, (i2 * 128 + kt * 16 + r) * 256 + stld);
                            }
                            __syncthreads();
                        }
                        { const float n0_ = st_mn[sbi * ML_HD + tid]; nS[tid] = n0_; nB[tid] = (unsigned short)f2bf(n0_); }
                    }
                    const int ltid_u = FRESHI(ltid), lane_u = FRESHI(lane);
                    const int lnu = FRESHI(lane); const int ug4 = lnu >> 4, ul15 = lnu & 15;
                    const unsigned m_rowQ = (unsigned)(ul15 * ST128 + 8 * ug4); unsigned m_rowQh = m_rowQ + 32; asm volatile("" : "+v"(m_rowQh));
                    const unsigned m_trK0 = (unsigned)((4 * ug4 + (ul15 >> 2)) * STK + 8 * (lnu & 3) + MQ_K);
                    const unsigned m_trVT0 = (unsigned)((4 * ug4 + (ul15 >> 2)) * STV + 8 * (lnu & 3) + v16 * 32 + MVT_OFF);
                    v4u sa[2], va[2]; float tlv[2]; f32x4 tk; float dcv;
                    const char* Qu = (const char*)(Q + (size_t)row0 * ML_INNER + hd * 512); const char* Ku = (const char*)(Kb + (size_t)row0 * ML_INNER + hd * 512);
#define ML_LOADX(set, cn, qi, x_, rowq_, colq_) do { const size_t go_ = ((size_t)(cn) * 64 * ML_INNER + (qi) * 128) * 2; const int rr_ = (rowq_) + 16 * (x_), rc_ = rr_ < Lv ? rr_ : Lv - 1; const unsigned qk_ = (unsigned)(rc_ * (ML_INNER * 2)) + (colq_); \
    R[(set) * 8 + (x_)] = *(const f32x4*)(Qu + go_ + qk_); R[(set) * 8 + 4 + (x_)] = *(const f32x4*)(Ku + go_ + qk_); } while (0)
#define ML_LOADS(set, cn, qi) do { const int tl_ = FRESHI(ltid); const int rq_ = tl_ >> 4; const unsigned cq_ = (unsigned)(tl_ & 15) * 16u; \
    ML_LOADX(set, cn, qi, 0, rq_, cq_); ML_LOADX(set, cn, qi, 1, rq_, cq_); ML_LOADX(set, cn, qi, 2, rq_, cq_); ML_LOADX(set, cn, qi, 3, rq_, cq_); } while (0)
#define ML_LOADS_S(cn) do { const int rn0_ = row0 + (cn) * 64; const int tl_ = FRESHI(ltid); \
    _Pragma("unroll") for (int x_ = 0; x_ < 2; ++x_) { const int tq_ = (tl_ >> 3) + 32 * x_, tc_ = tq_ < Lv ? tq_ : Lv - 1; \
        sa[x_] = *(const v4u*)(Sg + (size_t)((ci0 + (cn)) * 8 + hd) * 4096 + (tl_ + 256 * x_) * 8); \
        va[x_] = *(const v4u*)(Vb + (size_t)(rn0_ + tc_) * ML_INNER + hd * 512 + vs * 64 + (tl_ & 7) * 8); tlv[x_] = TOK[((size_t)(rn0_ + tc_) * 8 + hd) * 4 + 3]; } \
    { const int t6_ = tl_ & 63, t6c_ = t6_ < Lv ? t6_ : Lv - 1; tk = *(const f32x4*)(TOK + ((size_t)(rn0_ + t6c_) * 8 + hd) * 4); } \
    dcv = CHK[((ci0 + (cn)) * 8 + hd) * 2]; } while (0)
#define ML_WRITES(bufi, set) do { const int tw_ = ltid_u; const unsigned stq_ = (unsigned)((tw_ >> 4) * ST128 + (tw_ & 15) * 16), stk_ = (unsigned)((tw_ >> 4) * STK + (tw_ & 15) * 16 + MQ_K); \
    _Pragma("unroll") for (int x_ = 0; x_ < 4; ++x_) { LDSV(f32x4, (bufi) * MQ_BUF + x_ * 16 * ST128 + stq_) = R[(set) * 8 + x_]; LDSV(f32x4, (bufi) * MQ_BUF + x_ * 16 * STK + stk_) = R[(set) * 8 + 4 + x_]; } } while (0)
#define ML_WRITES_S(cn) do { const int tw_ = FRESHI(ltid); const unsigned sts_ = (unsigned)((tw_ >> 3) * ST64 + (tw_ & 7) * 16 + MS_OFF), stv_ = (unsigned)((tw_ >> 3) * STV + (tw_ & 7) * 16 + MV_OFF); \
    _Pragma("unroll") for (int x_ = 0; x_ < 2; ++x_) { if ((tw_ >> 3) + 32 * x_ >= Lv) { va[x_] = (v4u){0u, 0u, 0u, 0u}; tlv[x_] = 0.f; } \
        LDSV(v4u, x_ * 32 * ST64 + sts_) = sa[x_]; LDSV(v4u, x_ * 32 * STV + stv_) = va[x_]; const float tl2_ = tlv[x_]; \
        v4u o_; o_.x = pk2(bflo(va[x_].x) * tl2_, bfhi(va[x_].x) * tl2_); o_.y = pk2(bflo(va[x_].y) * tl2_, bfhi(va[x_].y) * tl2_); o_.z = pk2(bflo(va[x_].z) * tl2_, bfhi(va[x_].z) * tl2_); o_.w = pk2(bflo(va[x_].w) * tl2_, bfhi(va[x_].w) * tl2_); \
        LDSV(v4u, (MVT_OFF - MV_OFF) + ((cn) & 1) * MV_IMG + x_ * 32 * STV + stv_) = o_; } \
    if ((tw_ & 63) >= Lv) tk = (f32x4){0.f, 1.f, 1.f, 0.f}; \
    if (tw_ < 64) { LAS float* sc_ = scal + ((cn) & 1) * 256; sc_[tw_] = tk[0]; sc_[64 + tw_] = tk[1]; sc_[128 + tw_] = tk[2]; sc_[192 + tw_] = tk[3]; tailB[((cn) & 1) * 64 + tw_] = (unsigned short)f2bf(tk[3]); } \
    if (tw_ == 64) decS[(cn) & 1] = dcv; } while (0)
                    if (!true) {
                        ML_LOADS(0, 0, 0); ML_LOADS_S(0); ML_LOADS(1, 0, 1); ML_LOADS(2, 0, 2); ML_LOADS(3, 0, 3);
                        ML_WRITES(0, 0); ML_WRITES_S(0);
                    }
                    __syncthreads();
                    f32x4 qn_acc = (f32x4){0.f, 0.f, 0.f, 0.f};
                    for (int c = 0; c < nch; ++c) {
                        const int r0 = row0 + c * 64;
                        const int cnx = c + 1 < nch ? c + 1 : nch - 1;
                        f32x4 accQ[4];
#pragma unroll
                        for (int tt = 0; tt < 4; ++tt) accQ[tt] = (f32x4){0.f, 0.f, 0.f, 0.f};
                        const LAS float* scc = scal + (c & 1) * 256;
                        const float dec = decS[c & 1];
#pragma unroll
                        for (int i = 0; i < 4; ++i) {
                            const int b = i & 1;
                            if (true) {
                                const unsigned rowQ = m_rowQ + b * MQ_BUF, rowQh = m_rowQh + b * MQ_BUF;
                                const unsigned trK = m_trK0 + b * MQ_BUF;
                                const unsigned trVT = m_trVT0 + (c & 1) * MV_IMG;
                                if (i == 0) {
                                    const unsigned trV = m_trVT0 - (MVT_OFF - MV_OFF), rowS = (unsigned)(ul15 * ST64 + 8 * ug4 + MS_OFF);
                                    f32x4 accI[4];
#pragma unroll
                                    for (int tt = 0; tt < 4; ++tt) accI[tt] = (f32x4){0.f, 0.f, 0.f, 0.f};
                                    bf16x8 vf2[2]; v2u sl2[2][4], sh2[2][4];
#pragma unroll
                                    for (int ks = 0; ks < 2; ++ks) { vf2[ks] = TRFRAG(ks * 32 * STV + trV, STV);
#pragma unroll
                                        for (int tt = 0; tt < 4; ++tt) { sl2[ks][tt] = LDSV(v2u, tt * 16 * ST64 + ks * 64 + rowS); sh2[ks][tt] = LDSV(v2u, tt * 16 * ST64 + ks * 64 + 32 + rowS); } }
                                    SB();
#pragma unroll
                                    for (int ks = 0; ks < 2; ++ks) {
#pragma unroll
                                        for (int tt = 0; tt < 4; ++tt) { pg8::u32x4 sw; sw.x = sl2[ks][tt].x; sw.y = sl2[ks][tt].y; sw.z = sh2[ks][tt].x; sw.w = sh2[ks][tt].y;
                                            accI[tt] = __builtin_amdgcn_mfma_f32_16x16x32_bf16(vf2[ks], __builtin_bit_cast(bf16x8, sw), accI[tt], 0, 0, 0); } }
#pragma unroll
                                    for (int tt = 0; tt < 4; ++tt) Ib[(v16 * 4 + tt) * 64 + lnu] = accI[tt];
                                    SB();
                                }
                                v2u ql[8], qh[8]; bf16x8 k0w[4], k1w[4], afr[2];
#define QRD(n) do { ql[(n) & 7] = LDSV(v2u, ((n) & 3) * 16 * ST128 + ((n) >> 2) * 64 + rowQ); qh[(n) & 7] = LDSV(v2u, ((n) & 3) * 16 * ST128 + ((n) >> 2) * 64 + rowQh); asm volatile("" ::: "memory"); } while (0)
#define AFQ(kk) do { const f32x4 sa0 = R[i * 8 + 2 * (kk)], sb0 = R[i * 8 + 2 * (kk) + 1]; pg8::u32x4 aw; aw.x = cvt_pk_bf16(sa0[0], sa0[1]); aw.y = cvt_pk_bf16(sa0[2], sa0[3]); aw.z = cvt_pk_bf16(sb0[0], sb0[1]); aw.w = cvt_pk_bf16(sb0[2], sb0[3]); afr[(kk) & 1] = __builtin_bit_cast(bf16x8, aw); } while (0)
#define QMF(n) do { pg8::u32x4 bw; bw.x = ql[(n) & 7].x; bw.y = ql[(n) & 7].y; bw.z = qh[(n) & 7].x; bw.w = qh[(n) & 7].y; accQ[(n) & 3] = __builtin_amdgcn_mfma_f32_16x16x32_bf16(afr[((n) >> 2) & 1], __builtin_bit_cast(bf16x8, bw), accQ[(n) & 3], 0, 0, 0); } while (0)
#define KRD(t) do { k0w[(t) & 3] = TRFRAG((t) * 32 + trK, STK); k1w[(t) & 3] = TRFRAG(32 * STK + (t) * 32 + trK, STK); } while (0)
#define KDEC(dst, t) do { const f32x4 r_ = R[i * 8 + (t)]; _Pragma("unroll") for (int e_ = 0; e_ < 4; ++e_) { float t_; asm("v_mul_f32 %0, %1, %2" : "=v"(t_) : "v"(r_[e_]), "v"(dec)); dst[e_] = t_; } } while (0)
#define KMF(sv, t) do { sv = __builtin_amdgcn_mfma_f32_16x16x32_bf16(k0w[(t) & 3], vt0, sv, 0, 0, 0); sv = __builtin_amdgcn_mfma_f32_16x16x32_bf16(k1w[(t) & 3], vt1, sv, 0, 0, 0); R[i * 8 + (t)] = sv; } while (0)
                                QRD(0); QRD(1); QRD(2); QRD(3); QRD(4); QRD(5); QRD(6); QRD(7); AFQ(0); SB();
                                const bf16x8 vt0 = TRFRAG(trVT, STV), vt1 = TRFRAG(trVT + 32 * STV, STV);
                                QMF(0); QRD(8); SB();
                                AFQ(1); QMF(1); QRD(9); SB();
                                QMF(2); QRD(10); SB();
                                QMF(3); QRD(11); SB();
                                QMF(4); QRD(12); SB();
                                AFQ(2); QMF(5); QRD(13); SB();
                                QMF(6); QRD(14); SB();
                                QMF(7); QRD(15); SB();
                                QMF(8); KRD(0); SB();
                                AFQ(3); QMF(9); SB();
                                QMF(10); KRD(1); SB();
                                QMF(11); SB();
                                QMF(12); KRD(2); SB();
                                QMF(13); SB();
                                QMF(14); KRD(3); SB();
                                QMF(15); SB();
                                f32x4 svA, svB; KDEC(svA, 0); SB();
                                KDEC(svB, 1); KMF(svA, 0); KRD(4); SB();
                                KDEC(svA, 2); KMF(svB, 1); KRD(5); SB();
                                KDEC(svB, 3); KMF(svA, 2); KRD(6); SB();
                                KDEC(svA, 4); KMF(svB, 3); KRD(7); SB();
                                KDEC(svB, 5); KMF(svA, 4); SB();
                                KDEC(svA, 6); KMF(svB, 5); SB();
                                KDEC(svB, 7); KMF(svA, 6); SB();
                                KMF(svB, 7); SB();
#undef QRD
#undef AFQ
#undef QMF
#undef KRD
#undef KDEC
#undef KMF
                            } else {
                                const int tlq = ltid_u; const int rowq = tlq >> 4; const unsigned colq = (unsigned)(tlq & 15) * 16u;
                                ML_LOADX(i, cnx, i, 0, rowq, colq);
                                SB();
                                const int lnd = FRESHI(lane); const int g4 = lnd >> 4, l15 = lnd & 15;
                                const bool dofold = (ltid < 128) && !(i == 0 && c == 0);
                                const int kr = ((i + 3) & 3) * 128 + (ltid & 127);
                                const float fo_n = nS[kr], fo_p = nPart[((i + 1) & 1) * 128 + (ltid & 127)];
                                const unsigned tbo = MTB_OFF + (c & 1) * 128 + 8 * g4;
                                const v2u t0l = LDSV(v2u, tbo), t0h = LDSV(v2u, tbo + 32), t1l = LDSV(v2u, tbo + 64), t1h = LDSV(v2u, tbo + 96);
                                const unsigned trK = (unsigned)((4 * g4 + (l15 >> 2)) * STK + 8 * (lnd & 3) + MQ_K + b * MQ_BUF + lw * 64);
                                const bf16x8 kfa0 = TRFRAG(trK, STK), kfa1 = TRFRAG(32 * STK + trK, STK);
                                SB();
                                ML_LOADX(i, cnx, i, 1, rowq, colq);
                                SB();
                                if (dofold) { const float dc = i == 0 ? decS[(c + 1) & 1] : dec; const float nn = dc * fo_n + fo_p; nS[kr] = nn; nB[kr] = (unsigned short)f2bf(nn); }
                                { pg8::u32x4 w0, w1; w0.x = t0l.x; w0.y = t0l.y; w0.z = t0h.x; w0.w = t0h.y; w1.x = t1l.x; w1.y = t1l.y; w1.z = t1h.x; w1.w = t1h.y;
                                  const bf16x8 tf0 = __builtin_bit_cast(bf16x8, w0), tf1 = __builtin_bit_cast(bf16x8, w1);
                                  const bf16x8 kfb0 = TRFRAG(32 + trK, STK), kfb1 = TRFRAG(32 * STK + 32 + trK, STK);
                                  f32x4 pn = (f32x4){0.f, 0.f, 0.f, 0.f}; pn = __builtin_amdgcn_mfma_f32_16x16x32_bf16(kfa0, tf0, pn, 0, 0, 0); pn = __builtin_amdgcn_mfma_f32_16x16x32_bf16(kfa1, tf1, pn, 0, 0, 0);
                                  if (l15 == 0) *(LAS f32x4*)(nPart + (i & 1) * 128 + (2 * lw) * 16 + 4 * g4) = pn;
                                  SB(); ML_LOADX(i, cnx, i, 2, rowq, colq); SB();
                                  f32x4 pm = (f32x4){0.f, 0.f, 0.f, 0.f}; pm = __builtin_amdgcn_mfma_f32_16x16x32_bf16(kfb0, tf0, pm, 0, 0, 0); pm = __builtin_amdgcn_mfma_f32_16x16x32_bf16(kfb1, tf1, pm, 0, 0, 0);
                                  if (l15 == 0) *(LAS f32x4*)(nPart + (i & 1) * 128 + (2 * lw + 1) * 16 + 4 * g4) = pm; }
                                SB();
                                ML_LOADX(i, cnx, i, 3, rowq, colq);
                                if (i == 0) ML_LOADS_S(cnx);
                                SB();
                                { const unsigned qro = (unsigned)(b * MQ_BUF + (lw * 16 + l15) * ST128 + 16 * g4), nbo = (unsigned)(MNB_OFF + (i * 128 + 8 * g4) * 2);
                                  bf16x8 qf[4], nf[4];
#pragma unroll
                                  for (int kk = 0; kk < 4; ++kk) { qf[kk] = LDSV(bf16x8, qro + kk * 64); nf[kk] = LDSV(bf16x8, nbo + kk * 64); }
                                  SB();
#pragma unroll
                                  for (int kk = 0; kk < 4; ++kk) qn_acc = __builtin_amdgcn_mfma_f32_16x16x32_bf16(qf[kk], nf[kk], qn_acc, 0, 0, 0); }
                                SB();
                                ML_WRITES(b ^ 1, (i + 1) & 3);
                                if (i == 3) { ML_WRITES_S(cnx); if (l15 == 0) *(LAS f32x4*)(qnP + lw * 16 + 4 * g4) = qn_acc; qn_acc = (f32x4){0.f, 0.f, 0.f, 0.f}; }
                            }
                            __syncthreads();
                        }
                        if (true) {
                            const int lnf = lnu; const int l15 = ul15, g4 = ug4;
                            float qn4[4], gt4[4], em4[4], dn4[4]; f32x4 ib4[4];
#pragma unroll
                            for (int tt = 0; tt < 4; ++tt) { const int t = tt * 16 + l15; qn4[tt] = qnP[t]; gt4[tt] = scc[t]; em4[tt] = scc[64 + t]; dn4[tt] = scc[128 + t]; ib4[tt] = Ib[(v16 * 4 + tt) * 64 + lnf]; }
                            SB();
#pragma unroll
                            for (int tt = 0; tt < 4; ++tt) { const int t = tt * 16 + l15;
                                const float den = dn4[tt] + gt4[tt] * qn4[tt];
                                const float rd = __builtin_amdgcn_rcpf(fmaxf(fabsf(den), em4[tt]));
                                const f32x4 hv = (ib4[tt] + accQ[tt] * gt4[tt]) * rd;
                                if (t < Lv) { v2u o; o.x = pk2(hv[0], hv[1]); o.y = pk2(hv[2], hv[3]); *(v2u*)(H + (size_t)(r0 + t) * ML_INNER + hd * 512 + vs * 64 + v16 * 16 + 4 * g4) = o; } }
                        }
                    }
                    if (!true && ltid < 128) { const int kr = 3 * 128 + ltid; nS[kr] = decS[(nch - 1) & 1] * nS[kr] + nPart[128 + ltid]; }
                    __syncthreads();
                    {
                        const size_t sbo = s < NB_P ? (size_t)(j * NB_P + s) * ML_NH + hd : sbi;
                        int t2_ = tid; asm volatile("" : "+v"(t2_));
                        const unsigned stio = (unsigned)((t2_ >> 4) * 256 + (t2_ & 15) * 16);
                        const unsigned stld = (unsigned)((4 * ((t2_ >> 4) & 3)) * 256 + (((t2_ >> 6) & 3) * 16 + (t2_ & 15)) * 4);
                        if (vs == 0) { out[(s < NB_P ? O_P_MN : O_S_MN) + sbo * ML_HD + tid] = nS[tid]; if (tid == 0) out[(s < NB_P ? O_P_MM : O_S_MM) + sbo] = CHK[((ci0 + nch - 1) * 8 + hd) * 2 + 1]; }
                        __syncthreads();
#pragma unroll
                        for (int h = 0; h < 2; ++h) {
                            if (true) {
#pragma unroll
                                for (int i2 = 0; i2 < 2; ++i2)
#pragma unroll
                                    for (int kt = 0; kt < 8; ++kt)
#pragma unroll
                                        for (int r = 0; r < 4; ++r) LDSV(float, (i2 * 128 + kt * 16 + r) * 256 + stld) = R[(2 * h + i2) * 8 + kt][r];
                            }
                            __syncthreads();
                            float* gp = out + (s < NB_P ? O_P_MC : O_S_MC) + sbo * ML_HD * ML_HD + (size_t)(h * 256 + (t2_ >> 4)) * ML_HD + vs * 64 + (t2_ & 15) * 4;
#pragma unroll 1
                            for (int p = 0; p < 8; ++p) *(f32x4*)(gp + (size_t)p * 32 * ML_HD) = LDSV(f32x4, p * 8192 + stio);
                            __syncthreads();
                        }
                    }
                    __syncthreads();
#undef ML_LOADS
#undef ML_LOADS_S
#undef ML_WRITES
#undef ML_WRITES_S
                }
                } else {
                for (int u = bx; u < 2304; u += G) {
                    int s, hd, vs;
                    if (u < 256) { const int pr = (u & 7) + 8 * (u >> 6); vs = (u >> 3) & 7; s = pr >> 3; hd = pr & 7; }
                    else { const int up = u - 256, pr = (up & 7) + 8 * (up >> 6); vs = (up >> 3) & 7; s = NB_P + (pr >> 3); hd = pr & 7; }
                    const int T = stream_T(s), row0 = stream_row0(s), Lv = T < 64 ? T : 64, nch = T < 64 ? 1 : T / 64;
                    const int ci0 = s < NB_P ? s * 128 : 512 + (s - NB_P);
                    const size_t sbi = s < NB_P ? 0 : (size_t)(j * NB_S + (s - NB_P)) * ML_NH + hd;
                    f32x4 R[32];
                    if (s < NB_P) {
                        if (false) {
#pragma unroll
                            for (int i = 0; i < 32; ++i) R[i] = (f32x4){0.f, 0.f, 0.f, 0.f};
                        }
                        nS[tid] = 0.f; nB[tid] = 0;
                    } else {
                        int t2_ = tid; asm volatile("" : "+v"(t2_));
                        const unsigned stio = (unsigned)((t2_ >> 4) * 256 + (t2_ & 15) * 16);
                        const unsigned stld = (unsigned)((4 * ((t2_ >> 4) & 3)) * 256 + (((t2_ >> 6) & 3) * 16 + (t2_ & 15)) * 4);
#pragma unroll
                        for (int h = 0; h < 2; ++h) {
                            const float* gp = st_mC + sbi * ML_HD * ML_HD + (size_t)(h * 256 + (t2_ >> 4)) * ML_HD + vs * 64 + (t2_ & 15) * 4;
#pragma unroll
                            for (int pp = 0; pp < 2; ++pp) { f32x4 tmp[4];
#pragma unroll
                                for (int p = 0; p < 4; ++p) tmp[p] = *(const f32x4*)(gp + (size_t)(pp * 4 + p) * 32 * ML_HD);
#pragma unroll
                                for (int p = 0; p < 4; ++p) LDSV(f32x4, (pp * 4 + p) * 8192 + stio) = tmp[p]; SB(); }
                            __syncthreads();
                            if (false) {
#pragma unroll
                                for (int i2 = 0; i2 < 2; ++i2)
#pragma unroll
                                    for (int kt = 0; kt < 8; ++kt)
#pragma unroll
                                        for (int r = 0; r < 4; ++r) R[(2 * h + i2) * 8 + kt][r] = LDSV(float, (i2 * 128 + kt * 16 + r) * 256 + stld);
                            }
                            __syncthreads();
                        }
                        { const float n0_ = st_mn[sbi * ML_HD + tid]; nS[tid] = n0_; nB[tid] = (unsigned short)f2bf(n0_); }
                    }
                    const int ltid_u = FRESHI(ltid), lane_u = FRESHI(lane);
                    const int lnu = FRESHI(lane); const int ug4 = lnu >> 4, ul15 = lnu & 15;
                    const unsigned m_rowQ = (unsigned)(ul15 * ST128 + 8 * ug4); unsigned m_rowQh = m_rowQ + 32; asm volatile("" : "+v"(m_rowQh));
                    const unsigned m_trK0 = (unsigned)((4 * ug4 + (ul15 >> 2)) * STK + 8 * (lnu & 3) + MQ_K);
                    const unsigned m_trVT0 = (unsigned)((4 * ug4 + (ul15 >> 2)) * STV + 8 * (lnu & 3) + v16 * 32 + MVT_OFF);
                    v4u sa[2], va[2]; float tlv[2]; f32x4 tk; float dcv;
                    const char* Qu = (const char*)(Q + (size_t)row0 * ML_INNER + hd * 512); const char* Ku = (const char*)(Kb + (size_t)row0 * ML_INNER + hd * 512);
#define ML_LOADX(set, cn, qi, x_, rowq_, colq_) do { const size_t go_ = ((size_t)(cn) * 64 * ML_INNER + (qi) * 128) * 2; const int rr_ = (rowq_) + 16 * (x_), rc_ = rr_ < Lv ? rr_ : Lv - 1; const unsigned qk_ = (unsigned)(rc_ * (ML_INNER * 2)) + (colq_); \
    R[(set) * 8 + (x_)] = *(const f32x4*)(Qu + go_ + qk_); R[(set) * 8 + 4 + (x_)] = *(const f32x4*)(Ku + go_ + qk_); } while (0)
#define ML_LOADS(set, cn, qi) do { const int tl_ = FRESHI(ltid); const int rq_ = tl_ >> 4; const unsigned cq_ = (unsigned)(tl_ & 15) * 16u; \
    ML_LOADX(set, cn, qi, 0, rq_, cq_); ML_LOADX(set, cn, qi, 1, rq_, cq_); ML_LOADX(set, cn, qi, 2, rq_, cq_); ML_LOADX(set, cn, qi, 3, rq_, cq_); } while (0)
#define ML_LOADS_S(cn) do { const int rn0_ = row0 + (cn) * 64; const int tl_ = FRESHI(ltid); \
    _Pragma("unroll") for (int x_ = 0; x_ < 2; ++x_) { const int tq_ = (tl_ >> 3) + 32 * x_, tc_ = tq_ < Lv ? tq_ : Lv - 1; \
        sa[x_] = *(const v4u*)(Sg + (size_t)((ci0 + (cn)) * 8 + hd) * 4096 + (tl_ + 256 * x_) * 8); \
        va[x_] = *(const v4u*)(Vb + (size_t)(rn0_ + tc_) * ML_INNER + hd * 512 + vs * 64 + (tl_ & 7) * 8); tlv[x_] = TOK[((size_t)(rn0_ + tc_) * 8 + hd) * 4 + 3]; } \
    { const int t6_ = tl_ & 63, t6c_ = t6_ < Lv ? t6_ : Lv - 1; tk = *(const f32x4*)(TOK + ((size_t)(rn0_ + t6c_) * 8 + hd) * 4); } \
    dcv = CHK[((ci0 + (cn)) * 8 + hd) * 2]; } while (0)
#define ML_WRITES(bufi, set) do { const int tw_ = ltid_u; const unsigned stq_ = (unsigned)((tw_ >> 4) * ST128 + (tw_ & 15) * 16), stk_ = (unsigned)((tw_ >> 4) * STK + (tw_ & 15) * 16 + MQ_K); \
    _Pragma("unroll") for (int x_ = 0; x_ < 4; ++x_) { LDSV(f32x4, (bufi) * MQ_BUF + x_ * 16 * ST128 + stq_) = R[(set) * 8 + x_]; LDSV(f32x4, (bufi) * MQ_BUF + x_ * 16 * STK + stk_) = R[(set) * 8 + 4 + x_]; } } while (0)
#define ML_WRITES_S(cn) do { const int tw_ = FRESHI(ltid); const unsigned sts_ = (unsigned)((tw_ >> 3) * ST64 + (tw_ & 7) * 16 + MS_OFF), stv_ = (unsigned)((tw_ >> 3) * STV + (tw_ & 7) * 16 + MV_OFF); \
    _Pragma("unroll") for (int x_ = 0; x_ < 2; ++x_) { if ((tw_ >> 3) + 32 * x_ >= Lv) { va[x_] = (v4u){0u, 0u, 0u, 0u}; tlv[x_] = 0.f; } \
        LDSV(v4u, x_ * 32 * ST64 + sts_) = sa[x_]; LDSV(v4u, x_ * 32 * STV + stv_) = va[x_]; const float tl2_ = tlv[x_]; \
        v4u o_; o_.x = pk2(bflo(va[x_].x) * tl2_, bfhi(va[x_].x) * tl2_); o_.y = pk2(bflo(va[x_].y) * tl2_, bfhi(va[x_].y) * tl2_); o_.z = pk2(bflo(va[x_].z) * tl2_, bfhi(va[x_].z) * tl2_); o_.w = pk2(bflo(va[x_].w) * tl2_, bfhi(va[x_].w) * tl2_); \
        LDSV(v4u, (MVT_OFF - MV_OFF) + ((cn) & 1) * MV_IMG + x_ * 32 * STV + stv_) = o_; } \
    if ((tw_ & 63) >= Lv) tk = (f32x4){0.f, 1.f, 1.f, 0.f}; \
    if (tw_ < 64) { LAS float* sc_ = scal + ((cn) & 1) * 256; sc_[tw_] = tk[0]; sc_[64 + tw_] = tk[1]; sc_[128 + tw_] = tk[2]; sc_[192 + tw_] = tk[3]; tailB[((cn) & 1) * 64 + tw_] = (unsigned short)f2bf(tk[3]); } \
    if (tw_ == 64) decS[(cn) & 1] = dcv; } while (0)
                    if (!false) {
                        ML_LOADS(0, 0, 0); ML_LOADS_S(0); ML_LOADS(1, 0, 1); ML_LOADS(2, 0, 2); ML_LOADS(3, 0, 3);
                        ML_WRITES(0, 0); ML_WRITES_S(0);
                    }
                    __syncthreads();
                    f32x4 qn_acc = (f32x4){0.f, 0.f, 0.f, 0.f};
                    for (int c = 0; c < nch; ++c) {
                        const int r0 = row0 + c * 64;
                        const int cnx = c + 1 < nch ? c + 1 : nch - 1;
                        f32x4 accQ[4];
#pragma unroll
                        for (int tt = 0; tt < 4; ++tt) accQ[tt] = (f32x4){0.f, 0.f, 0.f, 0.f};
                        const LAS float* scc = scal + (c & 1) * 256;
                        const float dec = decS[c & 1];
#pragma unroll
                        for (int i = 0; i < 4; ++i) {
                            const int b = i & 1;
                            if (false) {
                                const unsigned rowQ = m_rowQ + b * MQ_BUF, rowQh = m_rowQh + b * MQ_BUF;
                                const unsigned trK = m_trK0 + b * MQ_BUF;
                                const unsigned trVT = m_trVT0 + (c & 1) * MV_IMG;
                                if (i == 0) {
                                    const unsigned trV = m_trVT0 - (MVT_OFF - MV_OFF), rowS = (unsigned)(ul15 * ST64 + 8 * ug4 + MS_OFF);
                                    f32x4 accI[4];
#pragma unroll
                                    for (int tt = 0; tt < 4; ++tt) accI[tt] = (f32x4){0.f, 0.f, 0.f, 0.f};
                                    bf16x8 vf2[2]; v2u sl2[2][4], sh2[2][4];
#pragma unroll
                                    for (int ks = 0; ks < 2; ++ks) { vf2[ks] = TRFRAG(ks * 32 * STV + trV, STV);
#pragma unroll
                                        for (int tt = 0; tt < 4; ++tt) { sl2[ks][tt] = LDSV(v2u, tt * 16 * ST64 + ks * 64 + rowS); sh2[ks][tt] = LDSV(v2u, tt * 16 * ST64 + ks * 64 + 32 + rowS); } }
                                    SB();
#pragma unroll
                                    for (int ks = 0; ks < 2; ++ks) {
#pragma unroll
                                        for (int tt = 0; tt < 4; ++tt) { pg8::u32x4 sw; sw.x = sl2[ks][tt].x; sw.y = sl2[ks][tt].y; sw.z = sh2[ks][tt].x; sw.w = sh2[ks][tt].y;
                                            accI[tt] = __builtin_amdgcn_mfma_f32_16x16x32_bf16(vf2[ks], __builtin_bit_cast(bf16x8, sw), accI[tt], 0, 0, 0); } }
#pragma unroll
                                    for (int tt = 0; tt < 4; ++tt) Ib[(v16 * 4 + tt) * 64 + lnu] = accI[tt];
                                    SB();
                                }
                                v2u ql[8], qh[8]; bf16x8 k0w[4], k1w[4], afr[2];
#define QRD(n) do { ql[(n) & 7] = LDSV(v2u, ((n) & 3) * 16 * ST128 + ((n) >> 2) * 64 + rowQ); qh[(n) & 7] = LDSV(v2u, ((n) & 3) * 16 * ST128 + ((n) >> 2) * 64 + rowQh); asm volatile("" ::: "memory"); } while (0)
#define AFQ(kk) do { const f32x4 sa0 = R[i * 8 + 2 * (kk)], sb0 = R[i * 8 + 2 * (kk) + 1]; pg8::u32x4 aw; aw.x = cvt_pk_bf16(sa0[0], sa0[1]); aw.y = cvt_pk_bf16(sa0[2], sa0[3]); aw.z = cvt_pk_bf16(sb0[0], sb0[1]); aw.w = cvt_pk_bf16(sb0[2], sb0[3]); afr[(kk) & 1] = __builtin_bit_cast(bf16x8, aw); } while (0)
#define QMF(n) do { pg8::u32x4 bw; bw.x = ql[(n) & 7].x; bw.y = ql[(n) & 7].y; bw.z = qh[(n) & 7].x; bw.w = qh[(n) & 7].y; accQ[(n) & 3] = __builtin_amdgcn_mfma_f32_16x16x32_bf16(afr[((n) >> 2) & 1], __builtin_bit_cast(bf16x8, bw), accQ[(n) & 3], 0, 0, 0); } while (0)
#define KRD(t) do { k0w[(t) & 3] = TRFRAG((t) * 32 + trK, STK); k1w[(t) & 3] = TRFRAG(32 * STK + (t) * 32 + trK, STK); } while (0)
#define KDEC(dst, t) do { const f32x4 r_ = R[i * 8 + (t)]; _Pragma("unroll") for (int e_ = 0; e_ < 4; ++e_) { float t_; asm("v_mul_f32 %0, %1, %2" : "=v"(t_) : "v"(r_[e_]), "v"(dec)); dst[e_] = t_; } } while (0)
#define KMF(sv, t) do { sv = __builtin_amdgcn_mfma_f32_16x16x32_bf16(k0w[(t) & 3], vt0, sv, 0, 0, 0); sv = __builtin_amdgcn_mfma_f32_16x16x32_bf16(k1w[(t) & 3], vt1, sv, 0, 0, 0); R[i * 8 + (t)] = sv; } while (0)
                                QRD(0); QRD(1); QRD(2); QRD(3); QRD(4); QRD(5); QRD(6); QRD(7); AFQ(0); SB();
                                const bf16x8 vt0 = TRFRAG(trVT, STV), vt1 = TRFRAG(trVT + 32 * STV, STV);
                                QMF(0); QRD(8); SB();
                                AFQ(1); QMF(1); QRD(9); SB();
                                QMF(2); QRD(10); SB();
                                QMF(3); QRD(11); SB();
                                QMF(4); QRD(12); SB();
                                AFQ(2); QMF(5); QRD(13); SB();
                                QMF(6); QRD(14); SB();
                                QMF(7); QRD(15); SB();
                                QMF(8); KRD(0); SB();
                                AFQ(3); QMF(9); SB();
                                QMF(10); KRD(1); SB();
                                QMF(11); SB();
                                QMF(12); KRD(2); SB();
                                QMF(13); SB();
                                QMF(14); KRD(3); SB();
                                QMF(15); SB();
                                f32x4 svA, svB; KDEC(svA, 0); SB();
                                KDEC(svB, 1); KMF(svA, 0); KRD(4); SB();
                                KDEC(svA, 2); KMF(svB, 1); KRD(5); SB();
                                KDEC(svB, 3); KMF(svA, 2); KRD(6); SB();
                                KDEC(svA, 4); KMF(svB, 3); KRD(7); SB();
                                KDEC(svB, 5); KMF(svA, 4); SB();
                                KDEC(svA, 6); KMF(svB, 5); SB();
                                KDEC(svB, 7); KMF(svA, 6); SB();
                                KMF(svB, 7); SB();
#undef QRD
#undef AFQ
#undef QMF
#undef KRD
#undef KDEC
#undef KMF
                            } else {
                                const int tlq = ltid_u; const int rowq = tlq >> 4; const unsigned colq = (unsigned)(tlq & 15) * 16u;
                                ML_LOADX(i, cnx, i, 0, rowq, colq);
                                SB();
                                const int lnd = FRESHI(lane); const int g4 = lnd >> 4, l15 = lnd & 15;
                                const bool dofold = (ltid < 128) && !(i == 0 && c == 0);
                                const int kr = ((i + 3) & 3) * 128 + (ltid & 127);
                                const float fo_n = nS[kr], fo_p = nPart[((i + 1) & 1) * 128 + (ltid & 127)];
                                const unsigned tbo = MTB_OFF + (c & 1) * 128 + 8 * g4;
                                const v2u t0l = LDSV(v2u, tbo), t0h = LDSV(v2u, tbo + 32), t1l = LDSV(v2u, tbo + 64), t1h = LDSV(v2u, tbo + 96);
                                const unsigned trK = (unsigned)((4 * g4 + (l15 >> 2)) * STK + 8 * (lnd & 3) + MQ_K + b * MQ_BUF + lw * 64);
                                const bf16x8 kfa0 = TRFRAG(trK, STK), kfa1 = TRFRAG(32 * STK + trK, STK);
                                SB();
                                ML_LOADX(i, cnx, i, 1, rowq, colq);
                                SB();
                                if (dofold) { const float dc = i == 0 ? decS[(c + 1) & 1] : dec; const float nn = dc * fo_n + fo_p; nS[kr] = nn; nB[kr] = (unsigned short)f2bf(nn); }
                                { pg8::u32x4 w0, w1; w0.x = t0l.x; w0.y = t0l.y; w0.z = t0h.x; w0.w = t0h.y; w1.x = t1l.x; w1.y = t1l.y; w1.z = t1h.x; w1.w = t1h.y;
                                  const bf16x8 tf0 = __builtin_bit_cast(bf16x8, w0), tf1 = __builtin_bit_cast(bf16x8, w1);
                                  const bf16x8 kfb0 = TRFRAG(32 + trK, STK), kfb1 = TRFRAG(32 * STK + 32 + trK, STK);
                                  f32x4 pn = (f32x4){0.f, 0.f, 0.f, 0.f}; pn = __builtin_amdgcn_mfma_f32_16x16x32_bf16(kfa0, tf0, pn, 0, 0, 0); pn = __builtin_amdgcn_mfma_f32_16x16x32_bf16(kfa1, tf1, pn, 0, 0, 0);
                                  if (l15 == 0) *(LAS f32x4*)(nPart + (i & 1) * 128 + (2 * lw) * 16 + 4 * g4) = pn;
                                  SB(); ML_LOADX(i, cnx, i, 2, rowq, colq); SB();
                                  f32x4 pm = (f32x4){0.f, 0.f, 0.f, 0.f}; pm = __builtin_amdgcn_mfma_f32_16x16x32_bf16(kfb0, tf0, pm, 0, 0, 0); pm = __builtin_amdgcn_mfma_f32_16x16x32_bf16(kfb1, tf1, pm, 0, 0, 0);
                                  if (l15 == 0) *(LAS f32x4*)(nPart + (i & 1) * 128 + (2 * lw + 1) * 16 + 4 * g4) = pm; }
                                SB();
                                ML_LOADX(i, cnx, i, 3, rowq, colq);
                                if (i == 0) ML_LOADS_S(cnx);
                                SB();
                                { const unsigned qro = (unsigned)(b * MQ_BUF + (lw * 16 + l15) * ST128 + 16 * g4), nbo = (unsigned)(MNB_OFF + (i * 128 + 8 * g4) * 2);
                                  bf16x8 qf[4], nf[4];
#pragma unroll
                                  for (int kk = 0; kk < 4; ++kk) { qf[kk] = LDSV(bf16x8, qro + kk * 64); nf[kk] = LDSV(bf16x8, nbo + kk * 64); }
                                  SB();
#pragma unroll
                                  for (int kk = 0; kk < 4; ++kk) qn_acc = __builtin_amdgcn_mfma_f32_16x16x32_bf16(qf[kk], nf[kk], qn_acc, 0, 0, 0); }
                                SB();
                                ML_WRITES(b ^ 1, (i + 1) & 3);
                                if (i == 3) { ML_WRITES_S(cnx); if (l15 == 0) *(LAS f32x4*)(qnP + lw * 16 + 4 * g4) = qn_acc; qn_acc = (f32x4){0.f, 0.f, 0.f, 0.f}; }
                            }
                            __syncthreads();
                        }
                        if (false) {
                            const int lnf = lnu; const int l15 = ul15, g4 = ug4;
                            float qn4[4], gt4[4], em4[4], dn4[4]; f32x4 ib4[4];
#pragma unroll
                            for (int tt = 0; tt < 4; ++tt) { const int t = tt * 16 + l15; qn4[tt] = qnP[t]; gt4[tt] = scc[t]; em4[tt] = scc[64 + t]; dn4[tt] = scc[128 + t]; ib4[tt] = Ib[(v16 * 4 + tt) * 64 + lnf]; }
                            SB();
#pragma unroll
                            for (int tt = 0; tt < 4; ++tt) { const int t = tt * 16 + l15;
                                const float den = dn4[tt] + gt4[tt] * qn4[tt];
                                const float rd = __builtin_amdgcn_rcpf(fmaxf(fabsf(den), em4[tt]));
                                const f32x4 hv = (ib4[tt] + accQ[tt] * gt4[tt]) * rd;
                                if (t < Lv) { v2u o; o.x = pk2(hv[0], hv[1]); o.y = pk2(hv[2], hv[3]); *(v2u*)(H + (size_t)(r0 + t) * ML_INNER + hd * 512 + vs * 64 + v16 * 16 + 4 * g4) = o; } }
                        }
                    }
                    if (!false && ltid < 128) { const int kr = 3 * 128 + ltid; nS[kr] = decS[(nch - 1) & 1] * nS[kr] + nPart[128 + ltid]; }
                    __syncthreads();
                    {
                        const size_t sbo = s < NB_P ? (size_t)(j * NB_P + s) * ML_NH + hd : sbi;
                        int t2_ = tid; asm volatile("" : "+v"(t2_));
                        const unsigned stio = (unsigned)((t2_ >> 4) * 256 + (t2_ & 15) * 16);
                        const unsigned stld = (unsigned)((4 * ((t2_ >> 4) & 3)) * 256 + (((t2_ >> 6) & 3) * 16 + (t2_ & 15)) * 4);
                        if (vs == 0) { out[(s < NB_P ? O_P_MN : O_S_MN) + sbo * ML_HD + tid] = nS[tid]; if (tid == 0) out[(s < NB_P ? O_P_MM : O_S_MM) + sbo] = CHK[((ci0 + nch - 1) * 8 + hd) * 2 + 1]; }
                        __syncthreads();
#pragma unroll
                        for (int h = 0; h < 2; ++h) {
                            if (false) {
#pragma unroll
                                for (int i2 = 0; i2 < 2; ++i2)
#pragma unroll
                                    for (int kt = 0; kt < 8; ++kt)
#pragma unroll
                                        for (int r = 0; r < 4; ++r) LDSV(float, (i2 * 128 + kt * 16 + r) * 256 + stld) = R[(2 * h + i2) * 8 + kt][r];
                            }
                            __syncthreads();
                            float* gp = out + (s < NB_P ? O_P_MC : O_S_MC) + sbo * ML_HD * ML_HD + (size_t)(h * 256 + (t2_ >> 4)) * ML_HD + vs * 64 + (t2_ & 15) * 4;
#pragma unroll 1
                            for (int p = 0; p < 8; ++p) *(f32x4*)(gp + (size_t)p * 32 * ML_HD) = LDSV(f32x4, p * 8192 + stio);
                            __syncthreads();
                        }
                    }
                    __syncthreads();
#undef ML_LOADS
#undef ML_LOADS_S
#undef ML_WRITES
#undef ML_WRITES_S
                }
                }
#undef LDSV
#undef TRFRAG
#undef FRESHI
#undef SB
            }
            SEAM(pb + 4, pb + 5);
            if (IN(pb + 5)) {
                SITE_VARS();
                const float* norm_w = args.in[24] + (size_t)j * ML_INNER; const float* skip = args.in[25] + (size_t)j * ML_INNER;
                for (int it = gw; it < M * 2; it += NGW) {
                    const int row = it >> 1, hh = (it & 1) * 4; const size_t off0 = (size_t)row * ML_INNER + hh * 512 + lane * 8;
                    v4u hw4[4], ow4[4], xw4[4], zw4[4];
#pragma unroll
                    for (int q = 0; q < 4; ++q) { hw4[q] = *(const v4u*)(H + off0 + q * 512); ow4[q] = *(const v4u*)(O + off0 + q * 512); xw4[q] = *(const v4u*)(XC + off0 + q * 512); zw4[q] = *(const v4u*)(Z + off0 + q * 512); }
#pragma unroll
                    for (int q = 0; q < 4; ++q) {
                        const int hd = hh + q; const v4u hw = hw4[q], ow = ow4[q], xw = xw4[q], zw = zw4[q];
                        float h[8] = {bflo(hw.x), bfhi(hw.x), bflo(hw.y), bfhi(hw.y), bflo(hw.z), bfhi(hw.z), bflo(hw.w), bfhi(hw.w)};
                        const float og[8] = {bflo(ow.x), bfhi(ow.x), bflo(ow.y), bfhi(ow.y), bflo(ow.z), bfhi(ow.z), bflo(ow.w), bfhi(ow.w)};
                        const float xc[8] = {bflo(xw.x), bfhi(xw.x), bflo(xw.y), bfhi(xw.y), bflo(xw.z), bfhi(xw.z), bflo(xw.w), bfhi(xw.w)};
                        const float zz[8] = {bflo(zw.x), bfhi(zw.x), bflo(zw.y), bfhi(zw.y), bflo(zw.z), bfhi(zw.z), bflo(zw.w), bfhi(zw.w)};
                        float sm = 0.f;
#pragma unroll
                        for (int i = 0; i < 8; ++i) sm += h[i];
                        const float mu = wave_sum(sm) * (1.f / 512.f); float s2 = 0.f;
#pragma unroll
                        for (int i = 0; i < 8; ++i) { h[i] -= mu; s2 += h[i] * h[i]; }
                        const float rstd = rsqrtf(wave_sum(s2) * (1.f / 512.f) + LN_EPS);
                        const float* nw = norm_w + hd * 512 + lane * 8; const float* sk = skip + hd * 512 + lane * 8;
                        const f32x4 n0 = *(const f32x4*)nw, n1 = *(const f32x4*)(nw + 4), k0 = *(const f32x4*)sk, k1 = *(const f32x4*)(sk + 4);
                        const float nwv[8] = {n0[0], n0[1], n0[2], n0[3], n1[0], n1[1], n1[2], n1[3]}, skv[8] = {k0[0], k0[1], k0[2], k0[3], k1[0], k1[1], k1[2], k1[3]};
                        float y[8];
#pragma unroll
                        for (int i = 0; i < 8; ++i) y[i] = (sigmoid_f(og[i]) * (h[i] * rstd * nwv[i]) + skv[i] * xc[i]) * silu_f(zz[i]);
                        v4u o; o.x = pk2(y[0], y[1]); o.y = pk2(y[2], y[3]); o.z = pk2(y[4], y[5]); o.w = pk2(y[6], y[7]);
                        *(v4u*)(YG + off0 + q * 512) = o;
                    }
                }
            }
            SEAM(pb + 5, pb + 6);
            if (IN(pb + 6)) {
                SITE_VARS();
                pg8::Gemm g{YG, (const bf16*)(ws + WS_WML_OUT) + (size_t)j * DM * ML_INNER, ML_INNER, ML_INNER, -1};
                pg8::SplitTailOrder S; S.init(M_P / 256, DM / 256, M_S / 256, G, bx, WGM_OUT);
                EpiResid E{XB, VPRE, DN_ALPHA, SLAB};
                pg8::gemm_phase<EpiResid, pg8::SplitTailOrder, PG8_ALIGN, PG8_SP2, true>(lds, g, S, E, tid);
            }
            SEAM(pb + 6, pb + 7);
            if (IN(pb + 7)) {
                SITE_VARS();
                const float* lg = args.in[27] + (size_t)li * DM; const float* lb = args.in[28] + (size_t)li * DM;
                const bool lastl = (li == 3);
                for (int row = gw; row < M; row += NGW) {
                    const v4u* vr = (const v4u*)(VPRE + (size_t)row * DM) + lane;
                    const v4u* XBV = (const v4u*)XB;
                    float v[32]; float sm = 0.f;
#pragma unroll
                    for (int q = 0; q < 4; ++q) { v4u w = vr[64 * q]; if (row >= M_P) w = (XBV + (size_t)row * (DM / 8) + lane)[64 * q]; v[8 * q + 0] = bflo(w.x); v[8 * q + 1] = bfhi(w.x); v[8 * q + 2] = bflo(w.y); v[8 * q + 3] = bfhi(w.y); v[8 * q + 4] = bflo(w.z); v[8 * q + 5] = bfhi(w.z); v[8 * q + 6] = bflo(w.w); v[8 * q + 7] = bfhi(w.w); }
                    if (row >= M_P) {
#pragma unroll
                        for (int i = 0; i < 32; ++i) v[i] *= DN_ALPHA;
#pragma unroll
                        for (int kq = 0; kq < 4; ++kq)
#pragma unroll
                            for (int q = 0; q < 4; ++q) { const float* sp = SLAB + ((size_t)kq * M_S + (row - M_P)) * DM + 8 * (lane + 64 * q); const f32x4 s0 = *(const f32x4*)sp, s1 = *(const f32x4*)(sp + 4);
                                v[8 * q + 0] += s0[0]; v[8 * q + 1] += s0[1]; v[8 * q + 2] += s0[2]; v[8 * q + 3] += s0[3]; v[8 * q + 4] += s1[0]; v[8 * q + 5] += s1[1]; v[8 * q + 6] += s1[2]; v[8 * q + 7] += s1[3]; }
                    }
#pragma unroll
                    for (int i = 0; i < 32; ++i) sm += v[i];
                    const float mean = wave_sum(sm) * (1.f / DM); float s2 = 0.f;
#pragma unroll
                    for (int i = 0; i < 32; ++i) { v[i] -= mean; s2 += v[i] * v[i]; }
                    const float rstd = rsqrtf(wave_sum(s2) * (1.f / DM) + LN_EPS);
#pragma unroll
                    for (int q = 0; q < 4; ++q) { const int c = 8 * (lane + 64 * q); const f32x4 g0 = *(const f32x4*)(lg + c), g1 = *(const f32x4*)(lg + c + 4), b0 = *(const f32x4*)(lb + c), b1 = *(const f32x4*)(lb + c + 4);
                        f32x4 o0, o1;
#pragma unroll
                        for (int e = 0; e < 4; ++e) { o0[e] = v[8 * q + e] * rstd * g0[e] + b0[e]; o1[e] = v[8 * q + 4 + e] * rstd * g1[e] + b1[e]; }
                        if (lastl) { float* orow = out + (size_t)row * DM + c; *(f32x4*)orow = o0; *(f32x4*)(orow + 4) = o1; } else { v4u w; w.x = pk2(o0[0], o0[1]); w.y = pk2(o0[2], o0[3]); w.z = pk2(o1[0], o1[1]); w.w = pk2(o1[2], o1[3]); *(v4u*)(XB + (size_t)row * DM + c) = w; } }
                }
            }
            SEAM(pb + 7, pb + 8);
        }
    }
#undef IN
#undef SEAM
}

static bool phase_used(int ph) { if (ph == 0) return true; const int i = (ph - 1) / 8, k = (ph - 1) % 8; return (i & 1) ? (k < 8) : (k < 6); }
constexpr int N_PHASE_IDS = 33;

extern "C" void kernel_launch(void* const* d_in, const int* in_sizes, int n_in, void* d_out, int out_size, void* d_ws, size_t ws_size, hipStream_t stream) {
    static int grid = 0;
    if (grid == 0) {
        if (n_in != 29 || (size_t)out_size != O_END || ws_size < WS_END) { fprintf(stderr, "kernel_launch: shape mismatch: n_in %d out %d (want %zu) ws %zu (want %zu)\n", n_in, out_size, (size_t)O_END, ws_size, (size_t)WS_END); grid = -1; return; }
        int dev = 0, cus = 0;
        if (hipGetDevice(&dev) != hipSuccess || hipDeviceGetAttribute(&cus, hipDeviceAttributeMultiprocessorCount, dev) != hipSuccess) { grid = -1; return; }
        if (hipFuncSetAttribute((const void*)mk_fwd, hipFuncAttributeMaxDynamicSharedMemorySize, LDS_BYTES) != hipSuccess) { fprintf(stderr, "kernel_launch: hipFuncSetAttribute failed\n"); grid = -1; return; }
        int per_cu = 0;
        (void)hipOccupancyMaxActiveBlocksPerMultiprocessor(&per_cu, (const void*)mk_fwd, NWAVES * 64, LDS_BYTES);
        (void)hipGetLastError();
        grid = cus;
    }
    if (grid < 0) return;
    if (hipMemsetAsync((char*)d_ws + WS_CTL, 0, CTL_ZERO_BYTES, stream) != hipSuccess) return;
    Args a{};
    for (int i = 0; i < 29; ++i) a.in[i] = (const float*)d_in[i];
    a.out = (float*)d_out; a.ws = (unsigned char*)d_ws;
#if MK_ONE_LAUNCH
    a.ph_lo = 0; a.ph_hi = N_PHASE_IDS;
    hipLaunchKernelGGL(mk_fwd, dim3(grid), dim3(NWAVES * 64), LDS_BYTES, stream, a);
#else
    for (int ph = 0; ph < N_PHASE_IDS; ++ph) {
        if (!phase_used(ph)) continue;
        a.ph_lo = ph; a.ph_hi = ph + 1;
        hipLaunchKernelGGL(mk_fwd, dim3(grid), dim3(NWAVES * 64), LDS_BYTES, stream, a);
    }
#endif
}
```

```cpp
#include <hip/hip_runtime.h>
#include <cstdio>
#include <cstdint>

#ifndef MK_ONE_LAUNCH
#define MK_ONE_LAUNCH 1
#endif

namespace pg8 {
#define PG8_LAS __attribute__((address_space(3)))
typedef unsigned short bf16_t;
typedef short bf16x8 __attribute__((ext_vector_type(8)));
typedef float f32x4 __attribute__((ext_vector_type(4)));
typedef unsigned u32x4 __attribute__((ext_vector_type(4)));
typedef unsigned u32x2 __attribute__((ext_vector_type(2)));
constexpr int BM = 256, BK = 64, HALF = 128, HTB = HALF * BK * 2  , STAGE_BYTES = 8 * HTB, NXCD = 8, WGM = 8;

__host__ __device__ __forceinline__ int lds_byte(int r, int c) { const int st = (r >> 4) * 2 + (c >> 5), rr = r & 15, cc = c & 31, ob = rr * 64 + cc * 2; return st * 1024 + (ob ^ (((ob >> 9) & 1) << 5)); }
__host__ __device__ __forceinline__ void stage_rc(int b, int& R, int& C) { const int st = b / 1024, sb = b % 1024, swz = sb ^ (((sb >> 9) & 1) << 5); R = (st >> 1) * 16 + swz / 64; C = (st & 1) * 32 + (swz % 64) / 2; }
__host__ __device__ __forceinline__ int perm32(int rho) { const int n = rho >> 4, i = rho & 15; return 8 * (i >> 2) + 4 * n + (i & 3); }

struct Unit { int pm, pn, kq; };
struct Gemm { const bf16_t* A; const bf16_t* Bt; int lda; int K; int hshift; };

struct StaticOrder {
    int nM, nN, nwg, G, c, wgm;
    __host__ __device__ void init(int nM_, int nN_, int G_, int c_, int wgm_ = 4) { nM = nM_; nN = nN_; nwg = nM * nN; G = G_; c = c_; wgm = wgm_; }
    __host__ __device__ bool next(int i, Unit& u) const {
        const long L = (long)i * G + c; if (L >= nwg) return false;
        int wgid = (int)L; { const int q = nwg / NXCD, r = nwg % NXCD, xcd = wgid % NXCD, off = wgid / NXCD; wgid = (xcd < r ? xcd * (q + 1) : r * (q + 1) + (xcd - r) * q) + off; }
        const int nig = wgm * nN, gid = wgid / nig, fm = gid * wgm, gsz = (nM - fm) < wgm ? (nM - fm) : wgm;
        u.pm = fm + ((wgid % nig) % gsz); u.pn = (wgid % nig) / gsz; u.kq = -1; return true;
    }
    __device__ __forceinline__ void a_ready(const Unit&) const {}
    __device__ __forceinline__ void done(const Unit&) const {}
};

struct SplitTailOrder {
    StaticOrder base; int nMf, nN, ntail, G, c;
    __host__ __device__ void init(int nMf_, int nN_, int ntail_, int G_, int c_, int wgm_ = 4) { nMf = nMf_; nN = nN_; ntail = ntail_; G = G_; c = c_; base.init(nMf_, nN_, G_, c_, wgm_); }
    __host__ __device__ bool next(int i, Unit& u) const {
        const long L = (long)i * G + c; const int nfull = nMf * nN;
        if (L < nfull) return base.next(i, u);
        const int x = (int)(L - nfull); if (x >= ntail * nN * 4) return false;
        u.pm = nMf + x / (nN * 4); u.pn = (x >> 2) % nN; u.kq = x & 3; return true;
    }
    __device__ __forceinline__ void a_ready(const Unit&) const {}
    __device__ __forceinline__ void done(const Unit&) const {}
};
__device__ __forceinline__ u32x4 xw_a(const u32x4 w0, const u32x4 w1) { u32x4 r;
    r.x = (unsigned)__builtin_amdgcn_update_dpp((int)w0.x, (int)w1.x, 0x128, 0xf, 0xc, false); r.y = (unsigned)__builtin_amdgcn_update_dpp((int)w0.y, (int)w1.y, 0x128, 0xf, 0xc, false);
    r.z = (unsigned)__builtin_amdgcn_update_dpp((int)w0.z, (int)w1.z, 0x128, 0xf, 0xc, false); r.w = (unsigned)__builtin_amdgcn_update_dpp((int)w0.w, (int)w1.w, 0x128, 0xf, 0xc, false); return r; }
__device__ __forceinline__ u32x4 xw_b(const u32x4 w0, const u32x4 w1) { u32x4 r;
    r.x = (unsigned)__builtin_amdgcn_update_dpp((int)w1.x, (int)w0.x, 0x128, 0xf, 0x3, false); r.y = (unsigned)__builtin_amdgcn_update_dpp((int)w1.y, (int)w0.y, 0x128, 0xf, 0x3, false);
    r.z = (unsigned)__builtin_amdgcn_update_dpp((int)w1.z, (int)w0.z, 0x128, 0xf, 0x3, false); r.w = (unsigned)__builtin_amdgcn_update_dpp((int)w1.w, (int)w0.w, 0x128, 0xf, 0x3, false); return r; }
__device__ __forceinline__ unsigned cvt_pk_bf16(float lo, float hi) { unsigned r; asm volatile("v_cvt_pk_bf16_f32 %0, %1, %2" : "=v"(r) : "v"(lo), "v"(hi)); return r; }

template <class Epi, class Sched, bool ALIGN_EPI = false, bool SP2 = false, bool SPLITK = false>
__device__ __forceinline__ void gemm_phase(PG8_LAS unsigned char* lds, const Gemm g, const Sched& S, const Epi& E, const int tid_in) {
    int tid_ = tid_in; asm volatile("" : "+v"(tid_));
    const int tid = tid_, wid = __builtin_amdgcn_readfirstlane(tid >> 6), lane = tid & 63, wr = wid >> 2, wc = wid & 3, fr = lane & 15, fq = lane >> 4;
    const int K = g.K, nt = K / BK, lda = g.lda;
    unsigned voffA[2], voffB[2];
#pragma unroll
    for (int i = 0; i < 2; ++i) { int R, C; stage_rc(tid * 16 + i * 8192, R, C); const int Rb = Epi::PERM ? (64 * (R >> 5) + perm32(R & 31)) : R;
        voffA[i] = (unsigned)(R * lda + C) * 2u; voffB[i] = (unsigned)(Rb * K + C) * 2u; }
    const size_t kstep = (size_t)(BK * 2);
    const size_t hstepA = (size_t)HALF * lda * 2, hstepB = (size_t)(Epi::PERM ? 32 : HALF) * K * 2;
    const unsigned ldsw = (unsigned)wid * 1024u;
    const int aoff = lds_byte(wr * 64 + fr, fq * 8), boff = lds_byte(wc * 32 + fr, fq * 8);
#define PG8_KOFF(u) ((SPLITK && (u).kq > 0) ? (size_t)(u).kq * (size_t)(K / 4) * 2 : (size_t)0)
#define PG8_ABASE(u) ((const char*)g.A + ((size_t)(u).pm * 256 * lda + (g.hshift >= 0 ? (size_t)((u).pn >> g.hshift) * 512 : (size_t)0)) * 2 + PG8_KOFF(u))
#define PG8_BBASE(u) ((const char*)g.Bt + (size_t)(u).pn * 256 * K * 2 + PG8_KOFF(u))
#define PG8_SA(b, h) (((b) * 2 + (h)) * HTB)
#define PG8_SB(b, h) ((4 + (b) * 2 + (h)) * HTB)
#define PG8_STAGE(bufoff, gbase, voff) do { _Pragma("unroll") for (int _i = 0; _i < 2; ++_i) \
        __builtin_amdgcn_global_load_lds((const unsigned*)((const char*)(gbase) + (voff)[_i]), (PG8_LAS unsigned*)(lds + (bufoff) + ldsw + _i * 8192), 16, 0, 0); } while (0)
#define PG8_LDA(dst, b, h) do { _Pragma("unroll") for (int m = 0; m < 4; ++m) _Pragma("unroll") for (int k = 0; k < 2; ++k) dst[m][k] = *(const PG8_LAS bf16x8*)(lds + PG8_SA(b, h) + aoff + m * 2048 + k * 1024); } while (0)
#define PG8_LDB(dst, b, h) do { _Pragma("unroll") for (int n = 0; n < 2; ++n) _Pragma("unroll") for (int k = 0; k < 2; ++k) dst[n][k] = *(const PG8_LAS bf16x8*)(lds + PG8_SB(b, h) + boff + n * 2048 + k * 1024); } while (0)
#define PG8_MMA(ai, bj, At, Bt) do { __builtin_amdgcn_s_setprio(1); _Pragma("unroll") for (int m = 0; m < 4; ++m) _Pragma("unroll") for (int n = 0; n < 2; ++n) _Pragma("unroll") for (int k = 0; k < 2; ++k) \
        acc[ai][bj][m][n] = __builtin_amdgcn_mfma_f32_16x16x32_bf16(Bt[n][k], At[m][k], acc[ai][bj][m][n], 0, 0, 0); __builtin_amdgcn_s_setprio(0); } while (0)
#define PG8_WAIT_V(n) asm volatile("s_waitcnt vmcnt(" #n ")" ::: "memory")
#define PG8_WAIT_L(n) asm volatile("s_waitcnt lgkmcnt(" #n ")" ::: "memory")
#define PG8_BAR __builtin_amdgcn_s_barrier()
#define PG8_SCHED __builtin_amdgcn_sched_barrier(0)
    Unit cur, nxt; int ui = 0;
    if (!S.next(0, cur)) return;
    int ntc = (SPLITK && cur.kq >= 0) ? nt / 4 : nt;
    f32x4 acc[2][2][4][2];
#pragma unroll
    for (int a = 0; a < 2; ++a)
#pragma unroll
        for (int b = 0; b < 2; ++b)
#pragma unroll
            for (int m = 0; m < 4; ++m)
#pragma unroll
                for (int n = 0; n < 2; ++n) acc[a][b][m][n] = (f32x4){0.f, 0.f, 0.f, 0.f};
    bf16x8 At[4][2], B0[2][2], B1[2][2];
    const char* cA = PG8_ABASE(cur); const char* cB = PG8_BBASE(cur);
    S.a_ready(cur);
    if constexpr (SP2) {
        PG8_STAGE(PG8_SB(0, 0), cB, voffB); PG8_STAGE(PG8_SB(0, 1), cB + hstepB, voffB); PG8_STAGE(PG8_SA(0, 0), cA, voffA); PG8_STAGE(PG8_SA(0, 1), cA + hstepA, voffA);
        if (wr == 1) PG8_BAR;
        PG8_WAIT_V(2); PG8_BAR;
        PG8_STAGE(PG8_SB(1, 0), cB + kstep, voffB); PG8_STAGE(PG8_SA(1, 0), cA + kstep, voffA); PG8_STAGE(PG8_SB(1, 1), cB + hstepB + kstep, voffB);
        PG8_WAIT_V(6); PG8_BAR;
    } else {
        PG8_STAGE(PG8_SB(0, 0), cB, voffB); PG8_STAGE(PG8_SA(0, 0), cA, voffA); PG8_STAGE(PG8_SB(0, 1), cB + hstepB, voffB); PG8_STAGE(PG8_SA(0, 1), cA + hstepA, voffA);
        if (wr == 1) PG8_BAR;
        PG8_WAIT_V(4); PG8_BAR;
        PG8_STAGE(PG8_SB(1, 0), cB + kstep, voffB); PG8_STAGE(PG8_SA(1, 0), cA + kstep, voffA); PG8_STAGE(PG8_SB(1, 1), cB + hstepB + kstep, voffB);
        PG8_WAIT_V(6); PG8_BAR;
    }
    for (;;) {
        const bool has_next = S.next(ui + 1, nxt);
        const char* nA = has_next ? PG8_ABASE(nxt) : cA; const char* nB = has_next ? PG8_BBASE(nxt) : cB;
        for (int t = 0; t < ntc; t += 2) {
            const bool last = (t == ntc - 2);
            const char* a1 = cA + (size_t)(t + 1) * kstep;
            const char* a2 = last ? nA : cA + (size_t)(t + 2) * kstep; const char* b2 = last ? nB : cB + (size_t)(t + 2) * kstep;
            const char* a3 = a2 + kstep; const char* b3 = b2 + kstep;
            if (last && has_next) S.a_ready(nxt);
            if constexpr (SP2) {
            PG8_LDB(B0, 0, 0); PG8_LDB(B1, 0, 1); PG8_SCHED; PG8_LDA(At, 0, 0); PG8_STAGE(PG8_SA(1, 1), a1 + hstepA, voffA);
            PG8_WAIT_V(8); PG8_WAIT_L(0); PG8_BAR; PG8_MMA(0, 0, At, B0); PG8_MMA(0, 1, At, B1); PG8_BAR; PG8_SCHED;
            PG8_LDA(At, 0, 1); PG8_STAGE(PG8_SB(0, 0), b2, voffB); PG8_STAGE(PG8_SB(0, 1), b2 + hstepB, voffB); PG8_STAGE(PG8_SA(0, 0), a2, voffA);
            PG8_WAIT_V(8); PG8_WAIT_L(0); PG8_BAR; PG8_MMA(1, 0, At, B0); PG8_MMA(1, 1, At, B1); PG8_BAR; PG8_SCHED;
            PG8_LDB(B0, 1, 0); PG8_LDB(B1, 1, 1); PG8_SCHED; PG8_LDA(At, 1, 0); PG8_STAGE(PG8_SA(0, 1), a2 + hstepA, voffA);
            PG8_WAIT_V(8); PG8_WAIT_L(0); PG8_BAR; PG8_MMA(0, 0, At, B0); PG8_MMA(0, 1, At, B1); PG8_BAR; PG8_SCHED;
            PG8_LDA(At, 1, 1); PG8_STAGE(PG8_SB(1, 0), b3, voffB); PG8_STAGE(PG8_SB(1, 1), b3 + hstepB, voffB); PG8_STAGE(PG8_SA(1, 0), a3, voffA);
            PG8_WAIT_V(8); PG8_WAIT_L(0); PG8_BAR; PG8_MMA(1, 0, At, B0); PG8_MMA(1, 1, At, B1); PG8_BAR; PG8_SCHED;
            } else {
            PG8_LDB(B0, 0, 0); PG8_SCHED; PG8_LDA(At, 0, 0); PG8_STAGE(PG8_SA(1, 1), a1 + hstepA, voffA);
            PG8_WAIT_L(8); PG8_BAR; PG8_WAIT_L(0); PG8_MMA(0, 0, At, B0); PG8_BAR; PG8_SCHED;
            PG8_LDB(B1, 0, 1); PG8_STAGE(PG8_SB(0, 0), b2, voffB);
            PG8_BAR; PG8_WAIT_L(0); PG8_MMA(0, 1, At, B1); PG8_BAR;
            PG8_LDA(At, 0, 1); PG8_STAGE(PG8_SA(0, 0), a2, voffA);
            PG8_BAR; PG8_WAIT_L(0); PG8_MMA(1, 0, At, B0); PG8_BAR; PG8_SCHED;
            PG8_STAGE(PG8_SB(0, 1), b2 + hstepB, voffB);
            PG8_WAIT_V(6); PG8_BAR; PG8_MMA(1, 1, At, B1); PG8_BAR;
            PG8_LDB(B0, 1, 0); PG8_SCHED; PG8_LDA(At, 1, 0); PG8_STAGE(PG8_SA(0, 1), a2 + hstepA, voffA);
            PG8_WAIT_L(8); PG8_BAR; PG8_WAIT_L(0); PG8_MMA(0, 0, At, B0); PG8_BAR; PG8_SCHED;
            PG8_LDB(B1, 1, 1); PG8_STAGE(PG8_SB(1, 0), b3, voffB);
            PG8_BAR; PG8_WAIT_L(0); PG8_MMA(0, 1, At, B1); PG8_BAR;
            PG8_LDA(At, 1, 1); PG8_STAGE(PG8_SA(1, 0), a3, voffA);
            PG8_BAR; PG8_WAIT_L(0); PG8_MMA(1, 0, At, B0); PG8_BAR; PG8_SCHED;
            PG8_STAGE(PG8_SB(1, 1), b3 + hstepB, voffB);
            PG8_WAIT_V(6); PG8_BAR; PG8_MMA(1, 1, At, B1); PG8_BAR;
            }
        }
        if constexpr (ALIGN_EPI) { if (wr == 0) PG8_BAR; }
        E(acc, cur, wr, wc, fr, fq); S.done(cur);
        if (!has_next) break;
#pragma unroll
        for (int a = 0; a < 2; ++a)
#pragma unroll
            for (int b = 0; b < 2; ++b)
#pragma unroll
                for (int m = 0; m < 4; ++m)
#pragma unroll
                    for (int n = 0; n < 2; ++n) acc[a][b][m][n] = (f32x4){0.f, 0.f, 0.f, 0.f};
        cur = nxt; cA = nA; cB = nB; ++ui; ntc = (SPLITK && cur.kq >= 0) ? nt / 4 : nt;
        if constexpr (ALIGN_EPI) { if (wr == 1) PG8_BAR; }
    }
    PG8_WAIT_V(0);
    if constexpr (!ALIGN_EPI) { if (wr == 0) PG8_BAR; }
    PG8_BAR;
#undef PG8_KOFF
#undef PG8_ABASE
#undef PG8_BBASE
#undef PG8_SA
#undef PG8_SB
#undef PG8_STAGE
#undef PG8_LDA
#undef PG8_LDB
#undef PG8_MMA
#undef PG8_WAIT_V
#undef PG8_WAIT_L
#undef PG8_BAR
#undef PG8_SCHED
}
}

#ifndef WGM_OUT
#define WGM_OUT 2
#endif
#ifndef WGM_HEAD
#define WGM_HEAD 4
#endif
#define PG8_SP2 true
#define PG8_ALIGN true

constexpr int DM = 2048;
constexpr int NB_P = 4, T_P = 8192, NB_S = 32, T_S = 16;
constexpr int M_P = NB_P * T_P, M_S = NB_S * T_S, M = M_P + M_S;
constexpr int NSTREAM = NB_P + NB_S;
constexpr int NPANEL = M / 256;
constexpr int SSD_INNER = 4096, SSD_HD = 64, SSD_NH = 64, SSD_NG = 8, SSD_DS = 128, SSD_CONVD = 6144, SSD_PROJ = 10304, SSD_NPAD = 10496;
constexpr int ML_INNER = 4096, ML_NH = 8, ML_HD = 512, ML_PROJ = 12304, ML_NPAD = 12544;
constexpr float DN_ALPHA = 1.6817928305074290f;
constexpr float LN_EPS = 1e-5f, RMS_EPS = 1e-6f;
constexpr float ML_QSCALE = 0.04419417382415922f;

constexpr size_t O_YP = 0;
constexpr size_t O_YS = O_YP + (size_t)M_P * DM;
constexpr size_t O_P_SCONV = O_YS + (size_t)M_S * DM;
constexpr size_t O_P_SH = O_P_SCONV + (size_t)2 * NB_P * 3 * SSD_CONVD;
constexpr size_t O_P_MCONV = O_P_SH + (size_t)2 * NB_P * SSD_NH * SSD_HD * SSD_DS;
constexpr size_t O_P_MC = O_P_MCONV + (size_t)2 * NB_P * 3 * ML_INNER;
constexpr size_t O_P_MN = O_P_MC + (size_t)2 * NB_P * ML_NH * ML_HD * ML_HD;
constexpr size_t O_P_MM = O_P_MN + (size_t)2 * NB_P * ML_NH * ML_HD;
constexpr size_t O_S_SCONV = O_P_MM + (size_t)2 * NB_P * ML_NH;
constexpr size_t O_S_SH = O_S_SCONV + (size_t)2 * NB_S * 3 * SSD_CONVD;
constexpr size_t O_S_MCONV = O_S_SH + (size_t)2 * NB_S * SSD_NH * SSD_HD * SSD_DS;
constexpr size_t O_S_MC = O_S_MCONV + (size_t)2 * NB_S * 3 * ML_INNER;
constexpr size_t O_S_MN = O_S_MC + (size_t)2 * NB_S * ML_NH * ML_HD * ML_HD;
constexpr size_t O_S_MM = O_S_MN + (size_t)2 * NB_S * ML_NH * ML_HD;
constexpr size_t O_END = O_S_MM + (size_t)2 * NB_S * ML_NH;

constexpr size_t MiB = 1u << 20;
constexpr size_t WS_CTL = 0, CTL_ZERO_BYTES = 1 * MiB;
constexpr size_t WS_WSSD_IN = 1 * MiB;
constexpr size_t WS_WSSD_OUT = 83 * MiB;
constexpr size_t WS_WML_IN = 115 * MiB;
constexpr size_t WS_WML_QK = 213 * MiB;
constexpr size_t WS_WML_V = 229 * MiB;
constexpr size_t WS_WML_OUT = 237 * MiB;
constexpr size_t WS_XB = 269 * MiB;
constexpr size_t WS_ACT = 399 * MiB;
constexpr size_t ACT_U = (size_t)M * 4096 * 2;
static_assert(ACT_U == 260 * MiB, "unit");
constexpr size_t WS_S_XBCC = WS_ACT + 920 * MiB;
constexpr size_t WS_S_Z = WS_ACT, WS_S_XBC = WS_ACT + 260 * MiB, WS_S_Y = WS_ACT + 650 * MiB, WS_S_DT = WS_ACT + 910 * MiB, WS_S_VPRE = WS_S_XBC;
constexpr size_t WS_M_XM = WS_ACT, WS_M_Q = WS_ACT, WS_M_YG = WS_ACT, WS_M_Z = WS_ACT + 260 * MiB, WS_M_O = WS_ACT + 520 * MiB, WS_M_XC = WS_ACT + 780 * MiB,
                 WS_M_K = WS_ACT + 1040 * MiB, WS_M_VPRE = WS_M_K, WS_M_V = WS_ACT + 1300 * MiB, WS_M_H = WS_M_V, WS_M_GATES = WS_ACT + 1560 * MiB;
constexpr size_t WS_M_S = WS_ACT + 1564 * MiB, WS_M_TOK = WS_ACT + 1600 * MiB, WS_M_CHK = WS_ACT + 1605 * MiB, WS_M_CHP = WS_M_CHK + 512 * 1024;
constexpr size_t WS_END = WS_ACT + 1606 * MiB;
constexpr int ML_NCHUNK = 512 + NB_S;
constexpr int CW_BAR = 4096;

constexpr int NWAVES = 8;
constexpr int ST64 = 144, ST128 = 272;
constexpr int SX_OFF = 0, SXS_OFF = 9216, SB_OFF = 18432, SC_OFF = 35840, SH_OFF = 53248, SW_OFF = 70656, SS_OFF = 79872;
constexpr int RING_BYTES = 131072;
constexpr int LDS_BYTES = 163840;
constexpr int MISC_OFF = LDS_BYTES - 256;
constexpr int STK = 288, STV = 160, MQ_K = 17408, MQ_BUF = 35840, MV_IMG = 10240;
constexpr int MS_OFF = 71680, MV_OFF = 80896, MVT_OFF = 91136, MP_OFF = 111616, MSC_OFF = 128000, MN_OFF = 130048, MNP_OFF = 132096, MQN_OFF = 133120, MNB_OFF = 133376, MTB_OFF = 134400, MDEC_OFF = 135168, MI_OFF = 135424;

#define GAS __attribute__((address_space(1)))
#define LAS __attribute__((address_space(3)))
typedef unsigned short bf16;
typedef unsigned v4u __attribute__((ext_vector_type(4)));
typedef unsigned v2u __attribute__((ext_vector_type(2)));
typedef float f32x4 __attribute__((ext_vector_type(4)));
#define LDS_WAIT() asm volatile("s_waitcnt lgkmcnt(0)" ::: "memory")
#define VM_WAIT() asm volatile("s_waitcnt vmcnt(0)" ::: "memory")
typedef __bf16 bf16x2n __attribute__((ext_vector_type(2)));
__device__ __forceinline__ unsigned f2bf(float f) { return (unsigned)__builtin_bit_cast(unsigned short, (__bf16)f); }
__device__ __forceinline__ unsigned pk2(float lo, float hi) { bf16x2n v; v[0] = (__bf16)lo; v[1] = (__bf16)hi; return __builtin_bit_cast(unsigned, v); }
__device__ __forceinline__ float bf2f(unsigned b) { return __builtin_bit_cast(float, b << 16); }
__device__ __forceinline__ float bflo(unsigned w) { return __builtin_bit_cast(float, w << 16); }
__device__ __forceinline__ float bfhi(unsigned w) { return __builtin_bit_cast(float, w & 0xffff0000u); }
__device__ __forceinline__ float silu_f(float x) { return x * __builtin_amdgcn_rcpf(1.f + __expf(-x)); }
__device__ __forceinline__ float sigmoid_f(float x) { return __builtin_amdgcn_rcpf(1.f + __expf(-x)); }
__device__ __forceinline__ float softplus_f(float x) { return fmaxf(x, 0.f) + __logf(1.f + __expf(-fabsf(x))); }
__device__ __forceinline__ float logsigmoid_f(float x) { return fminf(x, 0.f) - __logf(1.f + __expf(-fabsf(x))); }
#define RDLANE(v, l) __builtin_bit_cast(float, __builtin_amdgcn_readlane(__builtin_bit_cast(int, (float)(v)), (l)))
#define BPERM(v, srclane) __builtin_bit_cast(float, __builtin_amdgcn_ds_bpermute((srclane) << 2, __builtin_bit_cast(int, (float)(v))))
#define DPPF(oldv, srcv, ctrl, rmask) __builtin_bit_cast(float, __builtin_amdgcn_update_dpp(__builtin_bit_cast(int, (float)(oldv)), __builtin_bit_cast(int, (float)(srcv)), (ctrl), (rmask), 0xf, false))
__device__ __forceinline__ float wave_scan_add(float v) {
    v += DPPF(0.f, v, 0x111, 0xf); v += DPPF(0.f, v, 0x112, 0xf); v += DPPF(0.f, v, 0x114, 0xf); v += DPPF(0.f, v, 0x118, 0xf);
    v += DPPF(0.f, v, 0x142, 0xa); v += DPPF(0.f, v, 0x143, 0xc);
    return v;
}
__device__ __forceinline__ float wave_scan_max(float v) {
    const float ni = -3.0e38f;
    v = fmaxf(v, DPPF(ni, v, 0x111, 0xf)); v = fmaxf(v, DPPF(ni, v, 0x112, 0xf)); v = fmaxf(v, DPPF(ni, v, 0x114, 0xf)); v = fmaxf(v, DPPF(ni, v, 0x118, 0xf));
    v = fmaxf(v, DPPF(ni, v, 0x142, 0xa)); v = fmaxf(v, DPPF(ni, v, 0x143, 0xc));
    return v;
}
__device__ __forceinline__ float wave_sum(float v) { return __builtin_bit_cast(float, __builtin_amdgcn_readlane(__builtin_bit_cast(int, wave_scan_add(v)), 63)); }

#define XB_TMO      128
#define XB_XCNT(j)  (256  + 64 * (j))
#define XB_XSUB(j)  (1280 + 64 * (j))
#define XB_XGEN(j)  (2304 + 64 * (j))
#define XB_TOP      3328
#define XB_TOPGEN   3392
#define XCD_BAR_WORDS 3456
#define XB_SPIN_CAP (1u << 21)

__device__ __forceinline__ unsigned xb_ld(unsigned* p)              { return __hip_atomic_load(p, __ATOMIC_RELAXED, __HIP_MEMORY_SCOPE_AGENT); }
__device__ __forceinline__ unsigned xb_add(unsigned* p, unsigned v) { return __hip_atomic_fetch_add(p, v, __ATOMIC_RELAXED, __HIP_MEMORY_SCOPE_AGENT); }
__device__ __forceinline__ unsigned xb_xcc_id() { return (unsigned)__builtin_amdgcn_s_getreg((3 << 11) | 20) & 0xFu; }
#define XB_SPIN(cond, bar) do { unsigned _sp = 0; while (cond) { __builtin_amdgcn_s_sleep(1); \
    if ((++_sp & 255u) == 0u) { if (xb_ld(&(bar)[XB_TMO])) break; if (_sp > XB_SPIN_CAP) { atomicAdd(&(bar)[XB_TMO], 1u); break; } } } } while (0)

struct XcdBarrier {
    unsigned* bar; unsigned x;
    volatile LAS unsigned* st;
};
__device__ __forceinline__ XcdBarrier xcd_barrier_post(unsigned* bar, volatile LAS unsigned* st) {
    XcdBarrier b; b.bar = bar; b.x = xb_xcc_id(); b.st = st;
    if (threadIdx.x == 0) (void)xb_add(&bar[XB_XCNT(b.x)], 1u);
    return b;
}
__device__ __forceinline__ void xcd_barrier_complete(unsigned* bar, unsigned x, unsigned& nloc, unsigned& nx) {
    const unsigned G = gridDim.x * gridDim.y * gridDim.z;
    unsigned sum, cnt, mine, sp = 0u;
    for (;;) {
        sum = 0u; cnt = 0u; mine = 0u;
#pragma unroll
        for (unsigned j = 0; j < 16; ++j) { const unsigned c = xb_ld(&bar[XB_XCNT(j)]); sum += c; cnt += (c > 0u) ? 1u : 0u; mine = (j == x) ? c : mine; }
        if (sum == G) break;
        __builtin_amdgcn_s_sleep(1);
        if ((++sp & 255u) == 0u) { if (xb_ld(&bar[XB_TMO])) break; if (sp > XB_SPIN_CAP) { atomicAdd(&bar[XB_TMO], 1u); break; } }
    }
    nloc = mine > 0u ? mine : 1u; nx = cnt > 0u ? cnt : 1u;
}
__device__ __forceinline__ void xcd_barrier(const XcdBarrier& b, const bool leader) {
    asm volatile("s_waitcnt vmcnt(0)" ::: "memory");
    __syncthreads();
    if (leader) {
        size_t bo_ = 0; asm volatile("" : "+s"(bo_)); unsigned* bar = b.bar + bo_;
        __builtin_amdgcn_s_waitcnt(0);
        unsigned nloc = b.st[0], nx = b.st[1];
        if (nloc == 0u) { xcd_barrier_complete(bar, b.x, nloc, nx); b.st[0] = nloc; b.st[1] = nx; }
        const unsigned old = xb_add(&bar[XB_XSUB(b.x)], 1u);
        const unsigned gen = old / nloc;
        if (old + 1u == (gen + 1u) * nloc) {
            __builtin_amdgcn_fence(__ATOMIC_RELEASE, "agent");
            asm volatile("s_waitcnt vmcnt(0)" ::: "memory");
            const unsigned og = xb_add(&bar[XB_TOP], 1u);
            const unsigned tg = og / nx;
            if (og + 1u == (tg + 1u) * nx) xb_add(&bar[XB_TOPGEN], 1u);
            else XB_SPIN(xb_ld(&bar[XB_TOPGEN]) == tg, bar);
            __builtin_amdgcn_fence(__ATOMIC_ACQUIRE, "agent");
            xb_add(&bar[XB_XGEN(b.x)], 1u);
            asm volatile("s_waitcnt vmcnt(0)" ::: "memory");
        } else {
            XB_SPIN(xb_ld(&bar[XB_XGEN(b.x)]) == gen, bar);
            __builtin_amdgcn_fence(__ATOMIC_ACQUIRE, "agent");
            asm volatile("s_waitcnt vmcnt(0)" ::: "memory");
        }
    }
    __syncthreads();
}

using pg8::Unit; using pg8::u32x4; using pg8::cvt_pk_bf16; using pg8::xw_a; using pg8::xw_b;
struct EpiSsdIn {
    static constexpr bool PERM = true, AFTER_DRAIN = false;
    bf16* Z; bf16* XBC; float* DT;
    __device__ __forceinline__ void operator()(const f32x4 (&acc)[2][2][4][2], const Unit& u, int wr, int wc, int fr, int fq) const {
        if (u.pn < 40) {
            bf16* base; int ldc, colt;
            if (u.pn < 16) { base = Z; ldc = 4096; colt = u.pn * 256; } else { base = XBC; ldc = 6144; colt = (u.pn - 16) * 256; }
            const int rowx = u.pm * 256 + wr * 64 + (fr & 7), colx = colt + wc * 64 + 8 * fq + 32 * (fr >> 3);
#pragma unroll
            for (int ai = 0; ai < 2; ++ai)
#pragma unroll
                for (int m = 0; m < 4; ++m) { bf16* rowp = base + (size_t)(rowx + ai * 128 + m * 16) * ldc + colx; u32x4 w[2];
#pragma unroll
                    for (int bj = 0; bj < 2; ++bj) { const f32x4 v0 = acc[ai][bj][m][0], v1 = acc[ai][bj][m][1];
                        w[bj].x = cvt_pk_bf16(v0[0], v0[1]); w[bj].y = cvt_pk_bf16(v0[2], v0[3]); w[bj].z = cvt_pk_bf16(v1[0], v1[1]); w[bj].w = cvt_pk_bf16(v1[2], v1[3]); }
                    *(u32x4*)(rowp) = xw_a(w[0], w[1]); *(u32x4*)(rowp + (size_t)8 * ldc) = xw_b(w[0], w[1]); }
        } else if (wc == 0) {
            const int row0 = u.pm * 256 + wr * 64 + fr;
#pragma unroll
            for (int ai = 0; ai < 2; ++ai)
#pragma unroll
                for (int m = 0; m < 4; ++m) { float* rowp = DT + (size_t)(row0 + ai * 128 + m * 16) * 64 + 8 * fq;
#pragma unroll
                    for (int bj = 0; bj < 2; ++bj) { *(f32x4*)(rowp + 32 * bj) = acc[ai][bj][m][0]; *(f32x4*)(rowp + 32 * bj + 4) = acc[ai][bj][m][1]; } }
        }
    }
};
struct EpiMlIn {
    static constexpr bool PERM = true, AFTER_DRAIN = false;
    bf16* XM; size_t tstride; float* GATES;
    __device__ __forceinline__ void operator()(const f32x4 (&acc)[2][2][4][2], const Unit& u, int wr, int wc, int fr, int fq) const {
        const int row0 = u.pm * 256 + wr * 64 + fr;
        if (u.pn < 48) {
            bf16* base = XM + (size_t)(u.pn >> 4) * tstride;
            const int rowx = u.pm * 256 + wr * 64 + (fr & 7), colx = (u.pn & 15) * 256 + wc * 64 + 8 * fq + 32 * (fr >> 3);
#pragma unroll
            for (int ai = 0; ai < 2; ++ai)
#pragma unroll
                for (int m = 0; m < 4; ++m) { bf16* rowp = base + (size_t)(rowx + ai * 128 + m * 16) * 4096 + colx; u32x4 w[2];
#pragma unroll
                    for (int bj = 0; bj < 2; ++bj) { const f32x4 v0 = acc[ai][bj][m][0], v1 = acc[ai][bj][m][1];
                        w[bj].x = cvt_pk_bf16(v0[0], v0[1]); w[bj].y = cvt_pk_bf16(v0[2], v0[3]); w[bj].z = cvt_pk_bf16(v1[0], v1[1]); w[bj].w = cvt_pk_bf16(v1[2], v1[3]); }
                    *(u32x4*)(rowp) = xw_a(w[0], w[1]); *(u32x4*)(rowp + 8 * 4096) = xw_b(w[0], w[1]); }
        } else if (wc == 0 && fq < 2) {
#pragma unroll
            for (int ai = 0; ai < 2; ++ai)
#pragma unroll
                for (int m = 0; m < 4; ++m) { float* rowp = GATES + (size_t)(row0 + ai * 128 + m * 16) * 16 + 8 * fq;
                    *(f32x4*)(rowp) = acc[ai][0][m][0]; *(f32x4*)(rowp + 4) = acc[ai][0][m][1]; }
        }
    }
};
template <int MODE> struct EpiHead {
    static constexpr bool PERM = true, AFTER_DRAIN = false;
    bf16* O0; bf16* O1; float scale0;
    __device__ __forceinline__ void operator()(const f32x4 (&acc)[2][2][4][2], const Unit& u, int wr, int wc, int fr, int fq) const {
        bf16* base; int colt; float sc = 1.f;
        if (MODE == 0) { base = O0; colt = u.pn * 256; }
        else { const int head = u.pn >> 2, sub = u.pn & 3; if (sub < 2) { base = O0; colt = head * 512 + sub * 256; sc = scale0; } else { base = O1; colt = head * 512 + (sub - 2) * 256; } }
        const int rowx = u.pm * 256 + wr * 64 + (fr & 7), colx = colt + wc * 64 + 8 * fq + 32 * (fr >> 3);
#pragma unroll
        for (int ai = 0; ai < 2; ++ai)
#pragma unroll
            for (int m = 0; m < 4; ++m) { bf16* rowp = base + (size_t)(rowx + ai * 128 + m * 16) * 4096 + colx; u32x4 w[2];
#pragma unroll
                for (int bj = 0; bj < 2; ++bj) { const f32x4 v0 = acc[ai][bj][m][0] * sc, v1 = acc[ai][bj][m][1] * sc;
                    w[bj].x = cvt_pk_bf16(v0[0], v0[1]); w[bj].y = cvt_pk_bf16(v0[2], v0[3]); w[bj].z = cvt_pk_bf16(v1[0], v1[1]); w[bj].w = cvt_pk_bf16(v1[2], v1[3]); }
                *(u32x4*)(rowp) = xw_a(w[0], w[1]); *(u32x4*)(rowp + 8 * 4096) = xw_b(w[0], w[1]); }
    }
};
struct EpiResid {
    static constexpr bool PERM = true, AFTER_DRAIN = false;
    const bf16* XB; bf16* V; float alpha; float* SLAB;
    __device__ __forceinline__ void operator()(const f32x4 (&acc)[2][2][4][2], const Unit& u, int wr, int wc, int fr, int fq) const {
        const int row0 = u.pm * 256 + wr * 64 + fr, col0 = u.pn * 256 + wc * 64 + 8 * fq;
        if (u.kq >= 0) {
#pragma unroll
            for (int ai = 0; ai < 2; ++ai)
#pragma unroll
                for (int m = 0; m < 4; ++m) { float* sp = SLAB + ((size_t)u.kq * M_S + (row0 + ai * 128 + m * 16 - M_P)) * DM + col0;
#pragma unroll
                    for (int bj = 0; bj < 2; ++bj) { *(f32x4*)(sp + bj * 32) = acc[ai][bj][m][0]; *(f32x4*)(sp + bj * 32 + 4) = acc[ai][bj][m][1]; } }
            return;
        }
#pragma unroll
        for (int ai = 0; ai < 2; ++ai)
#pragma unroll
            for (int m = 0; m < 4; ++m) { const size_t off = (size_t)(row0 + ai * 128 + m * 16) * DM + col0; u32x4 w[2];
#pragma unroll
                for (int bj = 0; bj < 2; ++bj) { const v4u xw = *(const v4u*)(XB + off + bj * 32); const f32x4 v0 = acc[ai][bj][m][0], v1 = acc[ai][bj][m][1];
                    w[bj].x = cvt_pk_bf16(alpha * bflo(xw.x) + v0[0], alpha * bfhi(xw.x) + v0[1]); w[bj].y = cvt_pk_bf16(alpha * bflo(xw.y) + v0[2], alpha * bfhi(xw.y) + v0[3]);
                    w[bj].z = cvt_pk_bf16(alpha * bflo(xw.z) + v1[0], alpha * bfhi(xw.z) + v1[1]); w[bj].w = cvt_pk_bf16(alpha * bflo(xw.w) + v1[2], alpha * bfhi(xw.w) + v1[3]); }
                bf16* vp = V + (size_t)(u.pm * 256 + wr * 64 + (fr & 7) + ai * 128 + m * 16) * DM + col0 + 32 * (fr >> 3);
                *(u32x4*)(vp) = xw_a(w[0], w[1]); *(u32x4*)(vp + 8 * DM) = xw_b(w[0], w[1]); }
    }
};

__device__ __forceinline__ void transpose_item(const float* W, int ldw, int nvalid, int K, bf16* WT, int kb, int nb, LAS float* scr, int lane) {
    const int k0 = 64 * kb, n0 = 32 * nb;
    const int n4 = (lane & 7) * 4, nn = n0 + n4;
    f32x4 wv[8];
#pragma unroll
    for (int i = 0; i < 8; ++i) { const int kk = (lane >> 3) + 8 * i; wv[i] = nn < nvalid ? *(const f32x4*)(W + (size_t)(k0 + kk) * ldw + nn) : (f32x4){0.f, 0.f, 0.f, 0.f}; }
#pragma unroll
    for (int i = 0; i < 8; ++i) { const int kk = (lane >> 3) + 8 * i; LAS float* d = scr + kk * 33 + n4; d[0] = wv[i][0]; d[1] = wv[i][1]; d[2] = wv[i][2]; d[3] = wv[i][3]; }
    LDS_WAIT(); asm volatile("" ::: "memory");
    const int c = lane & 7;
#pragma unroll
    for (int j = 0; j < 4; ++j) { const int n = (lane >> 3) + 8 * j; const LAS float* s = scr + (8 * c) * 33 + n;
        v4u o; o.x = pk2(s[0 * 33], s[1 * 33]); o.y = pk2(s[2 * 33], s[3 * 33]); o.z = pk2(s[4 * 33], s[5 * 33]); o.w = pk2(s[6 * 33], s[7 * 33]);
        *(v4u*)(WT + (size_t)(n0 + n) * K + k0 + 8 * c) = o; }
    LDS_WAIT(); asm volatile("" ::: "memory");
}

typedef short bf16x8 __attribute__((ext_vector_type(8)));
typedef short v4s __attribute__((ext_vector_type(4)));
__device__ __forceinline__ bf16x8 lds_tr_frag(LAS unsigned char* img, int stride, int krow0, int q, int colbyte) {
    const v4s lo = __builtin_amdgcn_ds_read_tr16_b64_v4i16((LAS v4s*)(img + (krow0 + q) * stride + colbyte));
    const v4s hi = __builtin_amdgcn_ds_read_tr16_b64_v4i16((LAS v4s*)(img + (krow0 + 4 + q) * stride + colbyte));
    return (bf16x8){lo[0], lo[1], lo[2], lo[3], hi[0], hi[1], hi[2], hi[3]};
}
__device__ __forceinline__ void ml_gate_scalars(const float* GATES, int r0, int Lv, int hd, float bi, float bfv, int lane, float& b, float& a, float& pm) {
    float lf = 0.f, li = -1e30f;
    if (lane < Lv) { const float* gp = GATES + (size_t)(r0 + lane) * 16; li = gp[hd] + bi; lf = logsigmoid_f(gp[8 + hd] + bfv); }
    b = wave_scan_add(lf);
    a = li - b; pm = wave_scan_max(a);
}
template <int C> __device__ __forceinline__ void conv_pass(const bf16* raw, bf16* outp, const float* cw, const float* cb, const float* st_in, float* so_p, float* so_s, size_t gtid, size_t NGT) {
    constexpr int NCH = C / 8, NBLK = M / 16;
    for (size_t it = gtid; it < (size_t)NBLK * NCH; it += NGT) {
        const int rb = (int)(it / NCH), c0 = (int)(it % NCH) * 8;
        int s, t0; if (rb < M_P / 16) { s = rb >> 9; t0 = (rb & 511) * 16; } else { s = NB_P + (rb - M_P / 16); t0 = 0; }
        const int row0 = rb * 16;
        const bool lastblk = (s >= NB_P) || ((rb & 511) == 511);
        v4u rw[16];
#pragma unroll
        for (int r = 0; r < 16; ++r) rw[r] = *(const v4u*)(raw + (size_t)(row0 + r) * C + c0);
        float h0[8], h1[8], h2[8];
        if (t0 > 0) { const v4u a = *(const v4u*)(raw + (size_t)(row0 - 3) * C + c0), b = *(const v4u*)(raw + (size_t)(row0 - 2) * C + c0), c = *(const v4u*)(raw + (size_t)(row0 - 1) * C + c0);
            h0[0] = bflo(a.x); h0[1] = bfhi(a.x); h0[2] = bflo(a.y); h0[3] = bfhi(a.y); h0[4] = bflo(a.z); h0[5] = bfhi(a.z); h0[6] = bflo(a.w); h0[7] = bfhi(a.w);
            h1[0] = bflo(b.x); h1[1] = bfhi(b.x); h1[2] = bflo(b.y); h1[3] = bfhi(b.y); h1[4] = bflo(b.z); h1[5] = bfhi(b.z); h1[6] = bflo(b.w); h1[7] = bfhi(b.w);
            h2[0] = bflo(c.x); h2[1] = bfhi(c.x); h2[2] = bflo(c.y); h2[3] = bfhi(c.y); h2[4] = bflo(c.z); h2[5] = bfhi(c.z); h2[6] = bflo(c.w); h2[7] = bfhi(c.w);
        } else if (s >= NB_P) { const float* sp = st_in + (size_t)(s - NB_P) * 3 * C + c0;
#pragma unroll
            for (int e = 0; e < 8; ++e) { h0[e] = sp[e]; h1[e] = sp[C + e]; h2[e] = sp[2 * C + e]; }
        } else {
#pragma unroll
            for (int e = 0; e < 8; ++e) { h0[e] = 0.f; h1[e] = 0.f; h2[e] = 0.f; } }
        float w0[8], w1[8], w2[8], w3[8], bb[8];
#pragma unroll
        for (int e = 0; e < 8; ++e) { w0[e] = cw[c0 + e]; w1[e] = cw[C + c0 + e]; w2[e] = cw[2 * C + c0 + e]; w3[e] = cw[3 * C + c0 + e]; bb[e] = cb[c0 + e]; }
#pragma unroll
        for (int r = 0; r < 16; ++r) {
            const v4u w = rw[r]; const float x[8] = {bflo(w.x), bfhi(w.x), bflo(w.y), bfhi(w.y), bflo(w.z), bfhi(w.z), bflo(w.w), bfhi(w.w)};
            float y[8];
#pragma unroll
            for (int e = 0; e < 8; ++e) { y[e] = silu_f(bb[e] + w0[e] * h0[e] + w1[e] * h1[e] + w2[e] * h2[e] + w3[e] * x[e]); h0[e] = h1[e]; h1[e] = h2[e]; h2[e] = x[e]; }
            v4u o; o.x = pk2(y[0], y[1]); o.y = pk2(y[2], y[3]); o.z = pk2(y[4], y[5]); o.w = pk2(y[6], y[7]);
            *(v4u*)(outp + (size_t)(row0 + r) * C + c0) = o;
        }
        if (lastblk) { float* so = (s < NB_P ? so_p + (size_t)s * 3 * C : so_s + (size_t)(s - NB_P) * 3 * C) + c0;
#pragma unroll
            for (int e = 0; e < 8; ++e) { so[e] = h0[e]; so[C + e] = h1[e]; so[2 * C + e] = h2[e]; } }
    }
}
struct Args { const float* in[29]; float* out; unsigned char* ws; int ph_lo, ph_hi; };

__device__ __forceinline__ int stream_T(int s) { return s < NB_P ? T_P : T_S; }
__device__ __forceinline__ int stream_row0(int s) { return s < NB_P ? s * T_P : M_P + (s - NB_P) * T_S; }

__global__ void __launch_bounds__(NWAVES * 64, 2) mk_fwd(Args args) {
    extern __shared__ __attribute__((aligned(16))) unsigned char lds_raw[];
    LAS unsigned char* lds = (LAS unsigned char*)lds_raw;
    volatile LAS unsigned* MISC = (volatile LAS unsigned*)(lds + MISC_OFF);
    const int G = gridDim.x, bx = blockIdx.x;
    const int wave0 = __builtin_amdgcn_readfirstlane((int)threadIdx.x >> 6);
    const int NGW = G * NWAVES; const size_t NGT = (size_t)G * (NWAVES * 64);
#define SITE_VARS() int lane__; asm volatile("v_mbcnt_lo_u32_b32 %0, -1, 0\n\tv_mbcnt_hi_u32_b32 %0, -1, %0" : "=v"(lane__)); int tid_ = wave0 * 64 + lane__; asm volatile("" : "+v"(tid_)); const int tid = tid_, lane = tid & 63, wave = __builtin_amdgcn_readfirstlane(tid >> 6); \
    const int gw = bx * NWAVES + wave; const size_t gtid = (size_t)bx * (NWAVES * 64) + tid; (void)lane; (void)gw; (void)gtid
    unsigned char* ws0 = args.ws; unsigned char* ws = ws0;
    unsigned* ctl = (unsigned*)(ws + WS_CTL);
    float* out0 = args.out; float* out = out0; (void)out;

    for (int u = threadIdx.x; u < (LDS_BYTES - RING_BYTES) / 4; u += NWAVES * 64) ((LAS unsigned*)(lds + RING_BYTES))[u] = 0u;
    __syncthreads();
#if MK_ONE_LAUNCH
    XcdBarrier bar = xcd_barrier_post(ctl + CW_BAR, MISC + 8);
#define GRID_BAR() do { int lane__; asm volatile("v_mbcnt_lo_u32_b32 %0, -1, 0\n\tv_mbcnt_hi_u32_b32 %0, -1, %0" : "=v"(lane__)); xcd_barrier(bar, wave0 == 0 && lane__ == 0); } while (0)
#else
#define GRID_BAR() do { } while (0)
#endif
    const int lo = args.ph_lo, hi = args.ph_hi;
#define IN(k) (lo <= (k) && (k) < hi)
#define SEAM(a, b) do { if (IN(a) && IN(b)) GRID_BAR(); } while (0)

    const float* x_prompt = args.in[0]; const float* x_sample = args.in[1];
    const float* st_sconv = args.in[2]; const float* st_sh = args.in[3]; const float* st_mconv = args.in[4];
    const float* st_mC = args.in[5]; const float* st_mn = args.in[6]; const float* st_mm = args.in[7];
    bf16* XB = (bf16*)(ws + WS_XB);

    if (IN(0)) {
        SITE_VARS();
        LAS float* scr = (LAS float*)(lds + wave * 16384);
        constexpr int I_SIN = 32 * (SSD_NPAD / 32), I_SOUT = 64 * 64, I_MIN = 32 * (ML_NPAD / 32), I_H = 8 * 16, I_MOUT = 64 * 64;
        constexpr int PER_L = I_SIN + I_SOUT + I_MIN + 3 * 8 * I_H + I_MOUT;
        for (int it = gw; it < 2 * PER_L; it += NGW) {
            const int j = it / PER_L; int r = it % PER_L;
            if (r < I_SIN) { const int nbn = SSD_NPAD / 32; transpose_item(args.in[8] + (size_t)j * DM * SSD_PROJ, SSD_PROJ, SSD_PROJ, DM, (bf16*)(ws + WS_WSSD_IN) + (size_t)j * SSD_NPAD * DM, r / nbn, r % nbn, scr, lane); continue; } r -= I_SIN;
            if (r < I_SOUT) { transpose_item(args.in[15] + (size_t)j * SSD_INNER * DM, DM, DM, SSD_INNER, (bf16*)(ws + WS_WSSD_OUT) + (size_t)j * DM * SSD_INNER, r / 64, r % 64, scr, lane); continue; } r -= I_SOUT;
            if (r < I_MIN) { const int nbn = ML_NPAD / 32; transpose_item(args.in[16] + (size_t)j * DM * ML_PROJ, ML_PROJ, ML_PROJ, DM, (bf16*)(ws + WS_WML_IN) + (size_t)j * ML_NPAD * DM, r / nbn, r % nbn, scr, lane); continue; } r -= I_MIN;
            if (r < 3 * 8 * I_H) { const int which = r / (8 * I_H), rr = r % (8 * I_H), head = rr / I_H, it2 = rr % I_H;
                const float* W = args.in[19 + which] + ((size_t)(j * 8 + head) * 512) * 512;
                bf16* WT = which == 2 ? (bf16*)(ws + WS_WML_V) + ((size_t)j * 4096 + head * 512) * 512
                                      : (bf16*)(ws + WS_WML_QK) + ((size_t)j * 8192 + head * 1024 + which * 512) * 512;
                transpose_item(W, 512, 512, 512, WT, it2 / 16, it2 % 16, scr, lane); continue; } r -= 3 * 8 * I_H;
            transpose_item(args.in[26] + (size_t)j * ML_INNER * DM, DM, DM, ML_INNER, (bf16*)(ws + WS_WML_OUT) + (size_t)j * DM * ML_INNER, r / 64, r % 64, scr, lane);
        }
        for (size_t i = gtid; i < (size_t)M * DM / 8; i += NGT) {
            const size_t e = i * 8;
            const float* src = e < (size_t)M_P * DM ? x_prompt + e : x_sample + (e - (size_t)M_P * DM);
            const f32x4 a = *(const f32x4*)src, b = *(const f32x4*)(src + 4);
            v4u o; o.x = pk2(a[0], a[1]); o.y = pk2(a[2], a[3]); o.z = pk2(b[0], b[1]); o.w = pk2(b[2], b[3]);
            *(v4u*)(XB + e) = o;
        }
    }
    SEAM(0, 1);

    for (int jp = 0; jp < 2; ++jp) {
        {
            const int li = 2 * jp, pb = 1 + 8 * li, j = jp;
            size_t lo_ = 0; asm volatile("" : "+s"(lo_)); unsigned char* ws = ws0 + lo_; float* out = out0 + lo_;
            bf16* Z = (bf16*)(ws + WS_S_Z); bf16* XBC = (bf16*)(ws + WS_S_XBC); bf16* Y = (bf16*)(ws + WS_S_Y); bf16* XBCC = (bf16*)(ws + WS_S_XBCC); float* DT = (float*)(ws + WS_S_DT); bf16* VPRE = (bf16*)(ws + WS_S_VPRE); float* SLAB = (float*)(ws + WS_S_VPRE + 136 * MiB);
            const float* conv_w = args.in[9] + (size_t)j * 4 * SSD_CONVD; const float* conv_b = args.in[10] + (size_t)j * SSD_CONVD;
            if (IN(pb + 0)) {
                SITE_VARS();
                pg8::Gemm g{XB, (const bf16*)(ws + WS_WSSD_IN) + (size_t)j * SSD_NPAD * DM, DM, DM, -1};
                pg8::StaticOrder S; S.init(NPANEL, SSD_NPAD / 256, G, bx);
                EpiSsdIn E{Z, XBC, DT};
                pg8::gemm_phase<EpiSsdIn, pg8::StaticOrder, PG8_ALIGN, PG8_SP2>(lds, g, S, E, tid);
            }
            SEAM(pb + 0, pb + 1);
            if (IN(pb + 1)) {
                SITE_VARS();
                conv_pass<SSD_CONVD>(XBC, XBCC, conv_w, conv_b, st_sconv + (size_t)j * NB_S * 3 * SSD_CONVD, out + O_P_SCONV + (size_t)j * NB_P * 3 * SSD_CONVD, out + O_S_SCONV + (size_t)j * NB_S * 3 * SSD_CONVD, gtid, NGT);
            }
            SEAM(pb + 1, pb + 2);
            if (IN(pb + 2)) {
                SITE_VARS();
                const float* dt_bias = args.in[11] + j * 64; const float* A_log = args.in[12] + j * 64; const float* Dp = args.in[13] + j * 64;
                const int g4 = lane >> 4, l15 = lane & 15, q4 = l15 >> 2, p4 = lane & 3;
                LAS unsigned char* Xi = lds + SX_OFF; LAS unsigned char* XSi = lds + SXS_OFF; LAS unsigned char* Bi = lds + SB_OFF; LAS unsigned char* Ci = lds + SC_OFF;
                LAS unsigned char* Hi = lds + SH_OFF; LAS unsigned char* Wi = lds + SW_OFF;
                LAS float* cumS = (LAS float*)(lds + SS_OFF); LAS float* dtS = cumS + 64; LAS float* tailS = cumS + 128; LAS float* ecumS = cumS + 192;
                for (int u = bx; u < NSTREAM * SSD_NH; u += G) {
                    const int s = u >> 6, hd = u & 63, grp = hd >> 3;
                    const int T = stream_T(s), row0 = stream_row0(s), Lv = T < 64 ? T : 64, nch = T < 64 ? 1 : T / 64;
                    const float Aneg = -__expf(A_log[hd]), dtb = dt_bias[hd], Dh = Dp[hd];
                    f32x4 st[4];
                    if (s < NB_P) {
#pragma unroll
                        for (int pt = 0; pt < 4; ++pt) st[pt] = (f32x4){0.f, 0.f, 0.f, 0.f};
                    } else {
#pragma unroll
                        for (int pt = 0; pt < 4; ++pt) st[pt] = *(const f32x4*)(st_sh + (((size_t)(j * NB_S + (s - NB_P)) * SSD_NH + hd) * SSD_HD + pt * 16 + l15) * SSD_DS + wave * 16 + 4 * g4);
                    }
                    v4u xr, br[2], cr[2];
#define SSD_LOADS(cn) do { const char* xb_ = (const char*)(XBCC + ((size_t)row0 + (size_t)(cn) * 64) * SSD_CONVD + hd * 64); \
    xr = *(const v4u*)(xb_ + xo_u); if ((tid >> 3) >= Lv) xr = (v4u){0u, 0u, 0u, 0u}; \
    br[0] = *(const v4u*)(xb_ + bo_u0); cr[0] = *(const v4u*)(xb_ + bo_u0 + 2048); br[1] = *(const v4u*)(xb_ + bo_u1); cr[1] = *(const v4u*)(xb_ + bo_u1 + 2048); \
    if ((tid >> 4) >= Lv) { br[0] = (v4u){0u, 0u, 0u, 0u}; cr[0] = (v4u){0u, 0u, 0u, 0u}; } if ((tid >> 4) + 32 >= Lv) { br[1] = (v4u){0u, 0u, 0u, 0u}; cr[1] = (v4u){0u, 0u, 0u, 0u}; } \
    } while (0)
#define SSD_DTLOAD(cn) (*(const float*)((const char*)(DT + ((size_t)row0 + (size_t)(cn) * 64) * 64 + hd) + do_u))
#define SSD_SCALARS(bufp, dtrv) do { float dtv_ = 0.f; if (lane < Lv) dtv_ = softplus_f((dtrv) + dtb); const float cs_ = wave_scan_add(dtv_ * Aneg); const float c63_ = RDLANE(cs_, 63); LAS float* sb_ = (bufp); \
    sb_[lane] = cs_ * 1.44269504f; sb_[64 + lane] = cs_ * 1.44269504f - __builtin_amdgcn_logf(dtv_); sb_[128 + lane] = __expf(c63_ - cs_) * dtv_; sb_[192 + lane] = __expf(cs_); if (lane == 0) sb_[256] = __expf(c63_); } while (0)
                    const unsigned xo_u = (unsigned)(((tid >> 3) < Lv ? (tid >> 3) : Lv - 1) * SSD_CONVD + (tid & 7) * 8) * 2u;
                    const unsigned bo_u0 = (unsigned)(((tid >> 4) < Lv ? (tid >> 4) : Lv - 1) * SSD_CONVD + 4096 - hd * 64 + grp * 128 + (tid & 15) * 8) * 2u;
                    const unsigned bo_u1 = (unsigned)(((tid >> 4) + 32 < Lv ? (tid >> 4) + 32 : Lv - 1) * SSD_CONVD + 4096 - hd * 64 + grp * 128 + (tid & 15) * 8) * 2u;
                    const unsigned do_u = (unsigned)((lane < Lv ? lane : Lv - 1) * 64) * 4u;
                    SSD_LOADS(0);
                    { asm volatile("" ::: "memory"); bf16* dp_ = (bf16*)(ws + WS_CTL + 512 * 1024) + tid * 4; const v2u z_ = {0u, 0u}; *(v2u*)dp_ = z_; *(v2u*)(dp_ + 4096) = z_; asm volatile("" ::: "memory"); }
                    float dtn = 0.f;
                    if (wave == 4) { const float dt0_ = SSD_DTLOAD(0); dtn = SSD_DTLOAD(nch > 1 ? 1 : 0); SSD_SCALARS(cumS, dt0_); }
                    __syncthreads();
                    for (int c = 0; c < nch; ++c) {
                        const int r0 = row0 + c * 64;
                        LAS float* cumC = cumS + (c & 1) * 320; LAS float* dtC = cumC + 64; LAS float* tailC = cumC + 128; LAS float* ecumC = cumC + 192;
                        { const int t = tid >> 3, c8 = (tid & 7) * 8; *(LAS v4u*)(Xi + t * ST64 + c8 * 2) = xr;
                          const float tl = tailC[t]; v4u o;
                          o.x = pk2(bflo(xr.x) * tl, bfhi(xr.x) * tl); o.y = pk2(bflo(xr.y) * tl, bfhi(xr.y) * tl); o.z = pk2(bflo(xr.z) * tl, bfhi(xr.z) * tl); o.w = pk2(bflo(xr.w) * tl, bfhi(xr.w) * tl);
                          *(LAS v4u*)(XSi + t * ST64 + c8 * 2) = o; }
#pragma unroll
                        for (int i = 0; i < 2; ++i) { const int e = tid + 512 * i, t = e >> 4, c8 = (e & 15) * 8; *(LAS v4u*)(Bi + t * ST128 + c8 * 2) = br[i]; *(LAS v4u*)(Ci + t * ST128 + c8 * 2) = cr[i]; }
#pragma unroll
                        for (int pt = 0; pt < 4; ++pt) { v2u w; w.x = pk2(st[pt][0], st[pt][1]); w.y = pk2(st[pt][2], st[pt][3]); *(LAS v2u*)(Hi + (pt * 16 + l15) * ST128 + (wave * 16 + 4 * g4) * 2) = w; }
                        __syncthreads();
                        SSD_LOADS(c + 1 < nch ? c + 1 : nch - 1);
                        if (wave == 4) { SSD_SCALARS(cumS + ((c + 1) & 1) * 320, dtn); dtn = SSD_DTLOAD(c + 2 < nch ? c + 2 : nch - 1); }
                        {
                            const int si = wave >> 1;
                            bf16x8 af[4];
#pragma unroll
                            for (int kk = 0; kk < 4; ++kk) af[kk] = *(const LAS bf16x8*)(Bi + (si * 16 + l15) * ST128 + (kk * 32 + 8 * g4) * 2);
                            const f32x4 g_s = *(const LAS f32x4*)(dtC + si * 16 + 4 * g4);
#pragma unroll
                            for (int tj = 0; tj < 2; ++tj) {
                                const int ti = 2 * (wave & 1) + tj, t = ti * 16 + l15;
                                v2u w; w.x = 0u; w.y = 0u;
                                if (si <= ti) {
                                    f32x4 d = (f32x4){0.f, 0.f, 0.f, 0.f};
#pragma unroll
                                    for (int kk = 0; kk < 4; ++kk) { const bf16x8 bfr = *(const LAS bf16x8*)(Ci + t * ST128 + (kk * 32 + 8 * g4) * 2); d = __builtin_amdgcn_mfma_f32_16x16x32_bf16(af[kk], bfr, d, 0, 0, 0); }
                                    const float cum_t = cumC[t]; float wv[4];
#pragma unroll
                                    for (int r = 0; r < 4; ++r) wv[r] = d[r] * __builtin_amdgcn_exp2f(cum_t - g_s[r]);
                                    if (si == ti) {
#pragma unroll
                                        for (int r = 0; r < 4; ++r) { float w_ = wv[r]; asm volatile("" : "+v"(w_)); wv[r] = (4 * g4 + r <= l15) ? w_ : 0.f; } }
                                    w.x = pk2(wv[0], wv[1]); w.y = pk2(wv[2], wv[3]);
                                }
                                *(LAS v2u*)(Wi + t * ST64 + (si * 16 + 4 * g4) * 2) = w;
                            }
                        }
                        __syncthreads();
                        {
                            const int ti = wave >> 1, t = ti * 16 + l15;
                            bf16x8 cf[4], wf[2];
#pragma unroll
                            for (int kk = 0; kk < 4; ++kk) cf[kk] = *(const LAS bf16x8*)(Ci + t * ST128 + (kk * 32 + 8 * g4) * 2);
#pragma unroll
                            for (int ks = 0; ks < 2; ++ks) wf[ks] = *(const LAS bf16x8*)(Wi + t * ST64 + (ks * 32 + 8 * g4) * 2);
                            const float ec = ecumC[t];
#pragma unroll
                            for (int pj = 0; pj < 2; ++pj) {
                                const int pt = 2 * (wave & 1) + pj;
                                f32x4 d = (f32x4){0.f, 0.f, 0.f, 0.f};
#pragma unroll
                                for (int kk = 0; kk < 4; ++kk) { const bf16x8 hf = *(const LAS bf16x8*)(Hi + (pt * 16 + l15) * ST128 + (kk * 32 + 8 * g4) * 2); d = __builtin_amdgcn_mfma_f32_16x16x32_bf16(hf, cf[kk], d, 0, 0, 0); }
                                d = d * ec;
#pragma unroll
                                for (int ks = 0; ks < 2; ++ks) { if (ks == 0 || ti >= 2) { const bf16x8 xf = lds_tr_frag(Xi, ST64, ks * 32 + 8 * g4, q4, (pt * 16 + 4 * p4) * 2); d = __builtin_amdgcn_mfma_f32_16x16x32_bf16(xf, wf[ks], d, 0, 0, 0); } }
                                const v2u xw = *(const LAS v2u*)(Xi + t * ST64 + (pt * 16 + 4 * g4) * 2);
                                d[0] += Dh * bflo(xw.x); d[1] += Dh * bfhi(xw.x); d[2] += Dh * bflo(xw.y); d[3] += Dh * bfhi(xw.y);
                                { v2u o; o.x = pk2(d[0], d[1]); o.y = pk2(d[2], d[3]); bf16* yp = Y + (size_t)(r0 + t) * SSD_INNER + hd * 64 + pt * 16 + 4 * g4; if (t >= Lv) yp = (bf16*)(ws + WS_CTL + 512 * 1024) + tid * 4; *(v2u*)yp = o; }
                            }
                        }
                        {
                            const float dec = cumC[256];
                            bf16x8 bf2[2];
#pragma unroll
                            for (int ks = 0; ks < 2; ++ks) bf2[ks] = lds_tr_frag(Bi, ST128, ks * 32 + 8 * g4, q4, (wave * 16 + 4 * p4) * 2);
#pragma unroll
                            for (int pt = 0; pt < 4; ++pt) { st[pt] = st[pt] * dec;
#pragma unroll
                                for (int ks = 0; ks < 2; ++ks) { const bf16x8 xf = lds_tr_frag(XSi, ST64, ks * 32 + 8 * g4, q4, (pt * 16 + 4 * p4) * 2); st[pt] = __builtin_amdgcn_mfma_f32_16x16x32_bf16(bf2[ks], xf, st[pt], 0, 0, 0); } }
                        }
                        __syncthreads();
                    }
                    {
                        float* ho = s < NB_P ? out + O_P_SH + ((size_t)(j * NB_P + s) * SSD_NH + hd) * SSD_HD * SSD_DS : out + O_S_SH + ((size_t)(j * NB_S + (s - NB_P)) * SSD_NH + hd) * SSD_HD * SSD_DS;
#pragma unroll
                        for (int pt = 0; pt < 4; ++pt) *(f32x4*)(ho + (size_t)(pt * 16 + l15) * SSD_DS + wave * 16 + 4 * g4) = st[pt];
                    }
                }
            }
            SEAM(pb + 2, pb + 3);
            if (IN(pb + 3)) {
                SITE_VARS();
                const float* norm_w = args.in[14] + (size_t)j * SSD_INNER;
                for (int row = gw; row < M; row += NGW) {
                    const size_t off0 = (size_t)row * SSD_INNER + lane * 8;
                    v4u yw[8], zw[8];
#pragma unroll
                    for (int grp = 0; grp < 8; ++grp) { yw[grp] = *(const v4u*)(Y + off0 + grp * 512); zw[grp] = *(const v4u*)(Z + off0 + grp * 512); }
#pragma unroll
                    for (int grp = 0; grp < 8; ++grp) {
                        float v[8];
                        v[0] = bflo(yw[grp].x) * silu_f(bflo(zw[grp].x)); v[1] = bfhi(yw[grp].x) * silu_f(bfhi(zw[grp].x)); v[2] = bflo(yw[grp].y) * silu_f(bflo(zw[grp].y)); v[3] = bfhi(yw[grp].y) * silu_f(bfhi(zw[grp].y));
                        v[4] = bflo(yw[grp].z) * silu_f(bflo(zw[grp].z)); v[5] = bfhi(yw[grp].z) * silu_f(bfhi(zw[grp].z)); v[6] = bflo(yw[grp].w) * silu_f(bflo(zw[grp].w)); v[7] = bfhi(yw[grp].w) * silu_f(bfhi(zw[grp].w));
                        float ss = 0.f;
#pragma unroll
                        for (int i = 0; i < 8; ++i) ss += v[i] * v[i];
                        const float r = rsqrtf(wave_sum(ss) * (1.f / 512.f) + RMS_EPS);
                        const f32x4 n0 = *(const f32x4*)(norm_w + grp * 512 + lane * 8), n1 = *(const f32x4*)(norm_w + grp * 512 + lane * 8 + 4);
                        v4u o; o.x = pk2(v[0] * r * n0[0], v[1] * r * n0[1]); o.y = pk2(v[2] * r * n0[2], v[3] * r * n0[3]); o.z = pk2(v[4] * r * n1[0], v[5] * r * n1[1]); o.w = pk2(v[6] * r * n1[2], v[7] * r * n1[3]);
                        *(v4u*)(Y + off0 + grp * 512) = o;
                    }
                }
            }
            SEAM(pb + 3, pb + 4);
            if (IN(pb + 4)) {
                SITE_VARS();
                pg8::Gemm g{Y, (const bf16*)(ws + WS_WSSD_OUT) + (size_t)j * DM * SSD_INNER, SSD_INNER, SSD_INNER, -1};
                pg8::SplitTailOrder S; S.init(M_P / 256, DM / 256, M_S / 256, G, bx, WGM_OUT);
                EpiResid E{XB, VPRE, DN_ALPHA, SLAB};
                pg8::gemm_phase<EpiResid, pg8::SplitTailOrder, PG8_ALIGN, PG8_SP2, true>(lds, g, S, E, tid);
            }
            SEAM(pb + 4, pb + 5);
            if (IN(pb + 5)) {
                SITE_VARS();
                const float* lg = args.in[27] + (size_t)li * DM; const float* lb = args.in[28] + (size_t)li * DM;
                for (int row = gw; row < M; row += NGW) {
                    const v4u* vr = (const v4u*)(VPRE + (size_t)row * DM) + lane;
                    const v4u* XBV = (const v4u*)XB;
                    float v[32]; float sm = 0.f;
#pragma unroll
                    for (int q = 0; q < 4; ++q) { v4u w = vr[64 * q]; if (row >= M_P) w = (XBV + (size_t)row * (DM / 8) + lane)[64 * q]; v[8 * q + 0] = bflo(w.x); v[8 * q + 1] = bfhi(w.x); v[8 * q + 2] = bflo(w.y); v[8 * q + 3] = bfhi(w.y); v[8 * q + 4] = bflo(w.z); v[8 * q + 5] = bfhi(w.z); v[8 * q + 6] = bflo(w.w); v[8 * q + 7] = bfhi(w.w); }
                    if (row >= M_P) {
#pragma unroll
                        for (int i = 0; i < 32; ++i) v[i] *= DN_ALPHA;
#pragma unroll
                        for (int kq = 0; kq < 4; ++kq)
#pragma unroll
                            for (int q = 0; q < 4; ++q) { const float* sp = SLAB + ((size_t)kq * M_S + (row - M_P)) * DM + 8 * (lane + 64 * q); const f32x4 s0 = *(const f32x4*)sp, s1 = *(const f32x4*)(sp + 4);
                                v[8 * q + 0] += s0[0]; v[8 * q + 1] += s0[1]; v[8 * q + 2] += s0[2]; v[8 * q + 3] += s0[3]; v[8 * q + 4] += s1[0]; v[8 * q + 5] += s1[1]; v[8 * q + 6] += s1[2]; v[8 * q + 7] += s1[3]; }
                    }
#pragma unroll
                    for (int i = 0; i < 32; ++i) sm += v[i];
                    const float mean = wave_sum(sm) * (1.f / DM); float s2 = 0.f;
#pragma unroll
                    for (int i = 0; i < 32; ++i) { v[i] -= mean; s2 += v[i] * v[i]; }
                    const float rstd = rsqrtf(wave_sum(s2) * (1.f / DM) + LN_EPS);
#pragma unroll
                    for (int q = 0; q < 4; ++q) { const int c = 8 * (lane + 64 * q); const f32x4 g0 = *(const f32x4*)(lg + c), g1 = *(const f32x4*)(lg + c + 4), b0 = *(const f32x4*)(lb + c), b1 = *(const f32x4*)(lb + c + 4);
                        f32x4 o0, o1;
#pragma unroll
                        for (int e = 0; e < 4; ++e) { o0[e] = v[8 * q + e] * rstd * g0[e] + b0[e]; o1[e] = v[8 * q + 4 + e] * rstd * g1[e] + b1[e]; }
                        v4u w; w.x = pk2(o0[0], o0[1]); w.y = pk2(o0[2], o0[3]); w.z = pk2(o1[0], o1[1]); w.w = pk2(o1[2], o1[3]); *(v4u*)(XB + (size_t)row * DM + c) = w; }
                }
            }
            SEAM(pb + 5, pb + 8);
        }
        {
            const int li = 2 * jp + 1, pb = 1 + 8 * li, j = jp;
            size_t lo_ = 0; asm volatile("" : "+s"(lo_)); unsigned char* ws = ws0 + lo_; float* out = out0 + lo_;
            bf16* XM = (bf16*)(ws + WS_M_XM); bf16* Q = (bf16*)(ws + WS_M_Q); bf16* YG = (bf16*)(ws + WS_M_YG); bf16* Z = (bf16*)(ws + WS_M_Z); bf16* O = (bf16*)(ws + WS_M_O);
            bf16* XC = (bf16*)(ws + WS_M_XC); bf16* Kb = (bf16*)(ws + WS_M_K); bf16* Vb = (bf16*)(ws + WS_M_V); bf16* H = (bf16*)(ws + WS_M_H);
            float* GATES = (float*)(ws + WS_M_GATES); bf16* VPRE = (bf16*)(ws + WS_M_VPRE); float* SLAB = (float*)(ws + WS_M_VPRE + 136 * MiB);
            bf16* Sg = (bf16*)(ws + WS_M_S); float* TOK = (float*)(ws + WS_M_TOK); float* CHK = (float*)(ws + WS_M_CHK); float* CHP = (float*)(ws + WS_M_CHP); float* MPREV = (float*)(ws + WS_M_CHK + 768 * 1024);
            if (IN(pb + 0)) {
                SITE_VARS();
                pg8::Gemm g{XB, (const bf16*)(ws + WS_WML_IN) + (size_t)j * ML_NPAD * DM, DM, DM, -1};
                pg8::StaticOrder S; S.init(NPANEL, ML_NPAD / 256, G, bx);
                static_assert(WS_M_Z - WS_M_XM == ACT_U && WS_M_O - WS_M_Z == ACT_U, "XM | Z | O equally spaced");
                EpiMlIn E{XM, ACT_U / 2, GATES};
                pg8::gemm_phase<EpiMlIn, pg8::StaticOrder, PG8_ALIGN, PG8_SP2>(lds, g, S, E, tid);
            }
            SEAM(pb + 0, pb + 1);
            if (IN(pb + 1)) {
                SITE_VARS();
                const float* conv_w = args.in[17] + (size_t)j * 4 * ML_INNER; const float* conv_b = args.in[18] + (size_t)j * ML_INNER;
                conv_pass<ML_INNER>(XM, XC, conv_w, conv_b, st_mconv + (size_t)j * NB_S * 3 * ML_INNER, out + O_P_MCONV + (size_t)j * NB_P * 3 * ML_INNER, out + O_S_MCONV + (size_t)j * NB_S * 3 * ML_INNER, gtid, NGT);
                { const float* b_i = args.in[22] + j * 8; const float* b_f = args.in[23] + j * 8;
                  for (int it = gw; it < ML_NCHUNK * ML_NH; it += NGW) { const int ci = it >> 3, hd = it & 7; const int r0 = ci < 512 ? ci * 64 : M_P + (ci - 512) * 16, Lv = ci < 512 ? 64 : 16;
                      float b, a, pm; ml_gate_scalars(GATES, r0, Lv, hd, b_i[hd], b_f[hd], lane, b, a, pm);
                      if (lane == 63) { CHP[(ci * 8 + hd) * 2] = b; CHP[(ci * 8 + hd) * 2 + 1] = pm; } } }
                __syncthreads();
                pg8::Gemm g{XM, (const bf16*)(ws + WS_WML_V) + (size_t)j * 4096 * 512, ML_INNER, 512, 1};
                pg8::StaticOrder S; S.init(NPANEL, 16, G, bx, WGM_HEAD);
                EpiHead<0> E{Vb, nullptr, 1.f};
                pg8::gemm_phase<EpiHead<0>, pg8::StaticOrder, PG8_ALIGN, PG8_SP2>(lds, g, S, E, tid);
            }
            SEAM(pb + 1, pb + 2);
            if (IN(pb + 2)) {
                SITE_VARS();
                if (gw < NB_P * ML_NH) {
                    const int s = gw >> 3, hd = gw & 7;
                    const float blo = CHP[((s * 128 + lane) * 8 + hd) * 2], plo = CHP[((s * 128 + lane) * 8 + hd) * 2 + 1], bhi = CHP[((s * 128 + 64 + lane) * 8 + hd) * 2], phi = CHP[((s * 128 + 64 + lane) * 8 + hd) * 2 + 1];
                    float m = 0.f, mlo = 0.f, mhi = 0.f;
                    for (int cc = 0; cc < 128; ++cc) { if (cc < 64) { if (lane == cc) mlo = m; } else { if (lane == cc - 64) mhi = m; }
                        const float bb = RDLANE(cc < 64 ? blo : bhi, cc & 63), pp = RDLANE(cc < 64 ? plo : phi, cc & 63); m = bb + fmaxf(m, pp); }
                    MPREV[(s * 128 + lane) * 8 + hd] = mlo; MPREV[(s * 128 + 64 + lane) * 8 + hd] = mhi;
                }
                pg8::Gemm g{XC, (const bf16*)(ws + WS_WML_QK) + (size_t)j * 8192 * 512, ML_INNER, 512, 2};
                pg8::StaticOrder S; S.init(NPANEL, 32, G, bx, WGM_HEAD);
                EpiHead<1> E{Q, Kb, ML_QSCALE};
                pg8::gemm_phase<EpiHead<1>, pg8::StaticOrder, PG8_ALIGN, PG8_SP2>(lds, g, S, E, tid);
            }
            SEAM(pb + 2, pb + 3);
            if (IN(pb + 3)) {
                SITE_VARS();
                const int g4 = lane >> 4, l15 = lane & 15;
                const float* b_i = args.in[22] + j * 8; const float* b_f = args.in[23] + j * 8;
                LAS unsigned char* Qi = lds; LAS unsigned char* Ki = lds + 66560;
                LAS float* eS = (LAS float*)(lds + 133120); LAS float* aS = eS + 64; LAS float* denP = eS + 128;
                for (int u = bx; u < ML_NCHUNK * ML_NH; u += G) {
                    const int ci = u >> 3, hd = u & 7;
                    const int r0 = ci < 512 ? ci * 64 : M_P + (ci - 512) * 16, Lv = ci < 512 ? 64 : 16;
#pragma unroll
                    for (int i = 0; i < 8; ++i) { const int e = tid + 512 * i, t = e >> 6, c8 = (e & 63) * 8; v4u qv = (v4u){0u, 0u, 0u, 0u}, kv = (v4u){0u, 0u, 0u, 0u};
                        if (t < Lv) { qv = *(const v4u*)(Q + (size_t)(r0 + t) * ML_INNER + hd * 512 + c8); kv = *(const v4u*)(Kb + (size_t)(r0 + t) * ML_INNER + hd * 512 + c8); }
                        *(LAS v4u*)(Qi + t * 1040 + c8 * 2) = qv; *(LAS v4u*)(Ki + t * 1040 + c8 * 2) = kv; }
                    float gT = 0.f, emT = 1.f, tailT = 0.f;
                    if (wave == 0) {
                        float b, a, pm; ml_gate_scalars(GATES, r0, Lv, hd, b_i[hd], b_f[hd], lane, b, a, pm);
                        float mprev;
                        if (ci < 512) { mprev = MPREV[ci * 8 + hd];
                        } else mprev = st_mm[(size_t)(j * NB_S + (ci - 512)) * ML_NH + hd];
                        const float mt = b + fmaxf(mprev, pm);
                        const float b63 = RDLANE(b, 63), mnew = RDLANE(mt, 63);
                        eS[lane] = b - mt; aS[lane] = a;
                        gT = __expf(b + mprev - mt); emT = __expf(-mt); tailT = __expf(fminf(a + b63 - mnew, 0.f));
                        if (lane == 0) { CHK[(ci * 8 + hd) * 2] = __expf(b63 + mprev - mnew); CHK[(ci * 8 + hd) * 2 + 1] = mnew; }
                    }
                    __syncthreads();
                    {
                        const int ti = wave >> 1, t = ti * 16 + l15; const float et = eS[t]; float dsum = 0.f;
#pragma unroll
                        for (int sjj = 0; sjj < 2; ++sjj) {
                            const int sj = 2 * (wave & 1) + sjj; v2u w; w.x = 0u; w.y = 0u;
                            if (sj <= ti) {
                                f32x4 d = (f32x4){0.f, 0.f, 0.f, 0.f};
#pragma unroll
                                for (int kk = 0; kk < 16; ++kk) { const bf16x8 af = *(const LAS bf16x8*)(Ki + (sj * 16 + l15) * 1040 + (kk * 32 + 8 * g4) * 2), bfr = *(const LAS bf16x8*)(Qi + t * 1040 + (kk * 32 + 8 * g4) * 2);
                                    d = __builtin_amdgcn_mfma_f32_16x16x32_bf16(af, bfr, d, 0, 0, 0); }
                                const f32x4 as4 = *(const LAS f32x4*)(aS + sj * 16 + 4 * g4); float sv[4];
#pragma unroll
                                for (int r = 0; r < 4; ++r) { const int sidx = sj * 16 + 4 * g4 + r; sv[r] = sidx <= t ? d[r] * __expf(fminf(et + as4[r], 0.f)) : 0.f; dsum += sv[r]; }
                                w.x = pk2(sv[0], sv[1]); w.y = pk2(sv[2], sv[3]);
                            }
                            *(v2u*)(Sg + ((size_t)(ci * 8 + hd) * 64 + t) * 64 + sj * 16 + 4 * g4) = w;
                        }
                        dsum += BPERM(dsum, lane ^ 16); dsum += BPERM(dsum, lane ^ 32);
                        if (g4 == 0) denP[(wave & 1) * 64 + t] = dsum;
                    }
                    __syncthreads();
                    if (wave == 0 && lane < Lv) *(f32x4*)(TOK + ((size_t)(r0 + lane) * 8 + hd) * 4) = (f32x4){gT, emT, denP[lane] + denP[64 + lane], tailT};
                    __syncthreads();
                }
            }
            SEAM(pb + 3, pb + 4);
            if (IN(pb + 4)) {
                SITE_VARS();
                const int v16 = wave & 3, lw = wave & 3, ltid = tid & 255;
#define FRESHI(x) ({ int x__ = (x); asm volatile("" : "+v"(x__)); x__; })
#define LDSV(T, off) (*(LAS T*)(lds + (off)))
#define TRFRAG(off, stride) ({ const v4s lo_ = __builtin_amdgcn_ds_read_tr16_b64_v4i16((LAS v4s*)(lds + (off))); const v4s hi_ = __builtin_amdgcn_ds_read_tr16_b64_v4i16((LAS v4s*)(lds + (off) + 16 * (stride))); \
    (bf16x8){lo_[0], lo_[1], lo_[2], lo_[3], hi_[0], hi_[1], hi_[2], hi_[3]}; })
#define SB() __builtin_amdgcn_sched_barrier(0)
                LAS f32x4* Ib = (LAS f32x4*)(lds + MI_OFF);
                LAS float* scal = (LAS float*)(lds + MSC_OFF);
                LAS float* nS = (LAS float*)(lds + MN_OFF); LAS float* nPart = (LAS float*)(lds + MNP_OFF); LAS float* qnP = (LAS float*)(lds + MQN_OFF); LAS float* decS = (LAS float*)(lds + MDEC_OFF);
                LAS unsigned short* nB = (LAS unsigned short*)(lds + MNB_OFF); LAS unsigned short* tailB = (LAS unsigned short*)(lds + MTB_OFF);
                if (wave < 4) {
                for (int u = bx; u < 2304; u += G) {
                    int s, hd, vs;
                    if (u < 256) { const int pr = (u & 7) + 8 * (u >> 6); vs = (u >> 3) & 7; s = pr >> 3; hd = pr & 7; }
                    else { const int up = u - 256, pr = (up & 7) + 8 * (up >> 6); vs = (up >> 3) & 7; s = NB_P + (pr >> 3); hd = pr & 7; }
                    const int T = stream_T(s), row0 = stream_row0(s), Lv = T < 64 ? T : 64, nch = T < 64 ? 1 : T / 64;
                    const int ci0 = s < NB_P ? s * 128 : 512 + (s - NB_P);
                    const size_t sbi = s < NB_P ? 0 : (size_t)(j * NB_S + (s - NB_P)) * ML_NH + hd;
                    f32x4 R[32];
                    if (s < NB_P) {
                        if (true) {
#pragma unroll
                            for (int i = 0; i < 32; ++i) R[i] = (f32x4){0.f, 0.f, 0.f, 0.f};
                        }
                        nS[tid] = 0.f; nB[tid] = 0;
                    } else {
                        int t2_ = tid; asm volatile("" : "+v"(t2_));
                        const unsigned stio = (unsigned)((t2_ >> 4) * 256 + (t2_ & 15) * 16);
                        const unsigned stld = (unsigned)((4 * ((t2_ >> 4) & 3)) * 256 + (((t2_ >> 6) & 3) * 16 + (t2_ & 15)) * 4);
#pragma unroll
                        for (int h = 0; h < 2; ++h) {
                            const float* gp = st_mC + sbi * ML_HD * ML_HD + (size_t)(h * 256 + (t2_ >> 4)) * ML_HD + vs * 64 + (t2_ & 15) * 4;
#pragma unroll
                            for (int pp = 0; pp < 2; ++pp) { f32x4 tmp[4];
#pragma unroll
                                for (int p = 0; p < 4; ++p) tmp[p] = *(const f32x4*)(gp + (size_t)(pp * 4 + p) * 32 * ML_HD);
#pragma unroll
                                for (int p = 0; p < 4; ++p) LDSV(f32x4, (pp * 4 + p) * 8192 + stio) = tmp[p]; SB(); }
                            __syncthreads();
                            if (true) {
#pragma unroll
                                for (int i2 = 0; i2 < 2; ++i2)
#pragma unroll
                                    for (int kt = 0; kt < 8; ++kt)
#pragma unroll
                                        for (int r = 0; r < 4; ++r) R[(2 * h + i2) * 8 + kt][r] = LDSV(float, (i2 * 128 + kt * 16 + r) * 256 + stld);
                            }
                            __syncthreads();
                        }
                        { const float n0_ = st_mn[sbi * ML_HD + tid]; nS[tid] = n0_; nB[tid] = (unsigned short)f2bf(n0_); }
                    }
                    const int ltid_u = FRESHI(ltid), lane_u = FRESHI(lane);
                    const int lnu = FRESHI(lane); const int ug4 = lnu >> 4, ul15 = lnu & 15;
                    const unsigned m_rowQ = (unsigned)(ul15 * ST128 + 8 * ug4); unsigned m_rowQh = m_rowQ + 32; asm volatile("" : "+v"(m_rowQh));
                    const unsigned m_trK0 = (unsigned)((4 * ug4 + (ul15 >> 2)) * STK + 8 * (lnu & 3) + MQ_K);
                    const unsigned m_trVT0 = (unsigned)((4 * ug4 + (ul15 >> 2)) * STV + 8 * (lnu & 3) + v16 * 32 + MVT_OFF);
                    v4u sa[2], va[2]; float tlv[2]; f32x4 tk; float dcv;
                    const char* Qu = (const char*)(Q + (size_t)row0 * ML_INNER + hd * 512); const char* Ku = (const char*)(Kb + (size_t)row0 * ML_INNER + hd * 512);
#define ML_LOADX(set, cn, qi, x_, rowq_, colq_) do { const size_t go_ = ((size_t)(cn) * 64 * ML_INNER + (qi) * 128) * 2; const int rr_ = (rowq_) + 16 * (x_), rc_ = rr_ < Lv ? rr_ : Lv - 1; const unsigned qk_ = (unsigned)(rc_ * (ML_INNER * 2)) + (colq_); \
    R[(set) * 8 + (x_)] = *(const f32x4*)(Qu + go_ + qk_); R[(set) * 8 + 4 + (x_)] = *(const f32x4*)(Ku + go_ + qk_); } while (0)
#define ML_LOADS(set, cn, qi) do { const int tl_ = FRESHI(ltid); const int rq_ = tl_ >> 4; const unsigned cq_ = (unsigned)(tl_ & 15) * 16u; \
    ML_LOADX(set, cn, qi, 0, rq_, cq_); ML_LOADX(set, cn, qi, 1, rq_, cq_); ML_LOADX(set, cn, qi, 2, rq_, cq_); ML_LOADX(set, cn, qi, 3, rq_, cq_); } while (0)
#define ML_LOADS_S(cn) do { const int rn0_ = row0 + (cn) * 64; const int tl_ = FRESHI(ltid); \
    _Pragma("unroll") for (int x_ = 0; x_ < 2; ++x_) { const int tq_ = (tl_ >> 3) + 32 * x_, tc_ = tq_ < Lv ? tq_ : Lv - 1; \
        sa[x_] = *(const v4u*)(Sg + (size_t)((ci0 + (cn)) * 8 + hd) * 4096 + (tl_ + 256 * x_) * 8); \
        va[x_] = *(const v4u*)(Vb + (size_t)(rn0_ + tc_) * ML_INNER + hd * 512 + vs * 64 + (tl_ & 7) * 8); tlv[x_] = TOK[((size_t)(rn0_ + tc_) * 8 + hd) * 4 + 3]; } \
    { const int t6_ = tl_ & 63, t6c_ = t6_ < Lv ? t6_ : Lv - 1; tk = *(const f32x4*)(TOK + ((size_t)(rn0_ + t6c_) * 8 + hd) * 4); } \
    dcv = CHK[((ci0 + (cn)) * 8 + hd) * 2]; } while (0)
#define ML_WRITES(bufi, set) do { const int tw_ = ltid_u; const unsigned stq_ = (unsigned)((tw_ >> 4) * ST128 + (tw_ & 15) * 16), stk_ = (unsigned)((tw_ >> 4) * STK + (tw_ & 15) * 16 + MQ_K); \
    _Pragma("unroll") for (int x_ = 0; x_ < 4; ++x_) { LDSV(f32x4, (bufi) * MQ_BUF + x_ * 16 * ST128 + stq_) = R[(set) * 8 + x_]; LDSV(f32x4, (bufi) * MQ_BUF + x_ * 16 * STK + stk_) = R[(set) * 8 + 4 + x_]; } } while (0)
#define ML_WRITES_S(cn) do { const int tw_ = FRESHI(ltid); const unsigned sts_ = (unsigned)((tw_ >> 3) * ST64 + (tw_ & 7) * 16 + MS_OFF), stv_ = (unsigned)((tw_ >> 3) * STV + (tw_ & 7) * 16 + MV_OFF); \
    _Pragma("unroll") for (int x_ = 0; x_ < 2; ++x_) { if ((tw_ >> 3) + 32 * x_ >= Lv) { va[x_] = (v4u){0u, 0u, 0u, 0u}; tlv[x_] = 0.f; } \
        LDSV(v4u, x_ * 32 * ST64 + sts_) = sa[x_]; LDSV(v4u, x_ * 32 * STV + stv_) = va[x_]; const float tl2_ = tlv[x_]; \
        v4u o_; o_.x = pk2(bflo(va[x_].x) * tl2_, bfhi(va[x_].x) * tl2_); o_.y = pk2(bflo(va[x_].y) * tl2_, bfhi(va[x_].y) * tl2_); o_.z = pk2(bflo(va[x_].z) * tl2_, bfhi(va[x_].z) * tl2_); o_.w = pk2(bflo(va[x_].w) * tl2_, bfhi(va[x_].w) * tl2_); \
        LDSV(v4u, (MVT_OFF - MV_OFF) + ((cn) & 1) * MV_IMG + x_ * 32 * STV + stv_) = o_; } \
    if ((tw_ & 63) >= Lv) tk = (f32x4){0.f, 1.f, 1.f, 0.f}; \
    if (tw_ < 64) { LAS float* sc_ = scal + ((cn) & 1) * 256; sc_[tw_] = tk[0]; sc_[64 + tw_] = tk[1]; sc_[128 + tw_] = tk[2]; sc_[192 + tw_] = tk[3]; tailB[((cn) & 1) * 64 + tw_] = (unsigned short)f2bf(tk[3]); } \
    if (tw_ == 64) decS[(cn) & 1] = dcv; } while (0)
                    if (!true) {
                        ML_LOADS(0, 0, 0); ML_LOADS_S(0); ML_LOADS(1, 0, 1); ML_LOADS(2, 0, 2); ML_LOADS(3, 0, 3);
                        ML_WRITES(0, 0); ML_WRITES_S(0);
                    }
                    __syncthreads();
                    f32x4 qn_acc = (f32x4){0.f, 0.f, 0.f, 0.f};
                    for (int c = 0; c < nch; ++c) {
                        const int r0 = row0 + c * 64;
                        const int cnx = c + 1 < nch ? c + 1 : nch - 1;
                        f32x4 accQ[4];
#pragma unroll
                        for (int tt = 0; tt < 4; ++tt) accQ[tt] = (f32x4){0.f, 0.f, 0.f, 0.f};
                        const LAS float* scc = scal + (c & 1) * 256;
                        const float dec = decS[c & 1];
#pragma unroll
                        for (int i = 0; i < 4; ++i) {
                            const int b = i & 1;
                            if (true) {
                                const unsigned rowQ = m_rowQ + b * MQ_BUF, rowQh = m_rowQh + b * MQ_BUF;
                                const unsigned trK = m_trK0 + b * MQ_BUF;
                                const unsigned trVT = m_trVT0 + (c & 1) * MV_IMG;
                                if (i == 0) {
                                    const unsigned trV = m_trVT0 - (MVT_OFF - MV_OFF), rowS = (unsigned)(ul15 * ST64 + 8 * ug4 + MS_OFF);
                                    f32x4 accI[4];
#pragma unroll
                                    for (int tt = 0; tt < 4; ++tt) accI[tt] = (f32x4){0.f, 0.f, 0.f, 0.f};
                                    bf16x8 vf2[2]; v2u sl2[2][4], sh2[2][4];
#pragma unroll
                                    for (int ks = 0; ks < 2; ++ks) { vf2[ks] = TRFRAG(ks * 32 * STV + trV, STV);
#pragma unroll
                                        for (int tt = 0; tt < 4; ++tt) { sl2[ks][tt] = LDSV(v2u, tt * 16 * ST64 + ks * 64 + rowS); sh2[ks][tt] = LDSV(v2u, tt * 16 * ST64 + ks * 64 + 32 + rowS); } }
                                    SB();
#pragma unroll
                                    for (int ks = 0; ks < 2; ++ks) {
#pragma unroll
                                        for (int tt = 0; tt < 4; ++tt) { pg8::u32x4 sw; sw.x = sl2[ks][tt].x; sw.y = sl2[ks][tt].y; sw.z = sh2[ks][tt].x; sw.w = sh2[ks][tt].y;
                                            accI[tt] = __builtin_amdgcn_mfma_f32_16x16x32_bf16(vf2[ks], __builtin_bit_cast(bf16x8, sw), accI[tt], 0, 0, 0); } }
#pragma unroll
                                    for (int tt = 0; tt < 4; ++tt) Ib[(v16 * 4 + tt) * 64 + lnu] = accI[tt];
                                    SB();
                                }
                                v2u ql[8], qh[8]; bf16x8 k0w[4], k1w[4], afr[2];
#define QRD(n) do { ql[(n) & 7] = LDSV(v2u, ((n) & 3) * 16 * ST128 + ((n) >> 2) * 64 + rowQ); qh[(n) & 7] = LDSV(v2u, ((n) & 3) * 16 * ST128 + ((n) >> 2) * 64 + rowQh); asm volatile("" ::: "memory"); } while (0)
#define AFQ(kk) do { const f32x4 sa0 = R[i * 8 + 2 * (kk)], sb0 = R[i * 8 + 2 * (kk) + 1]; pg8::u32x4 aw; aw.x = cvt_pk_bf16(sa0[0], sa0[1]); aw.y = cvt_pk_bf16(sa0[2], sa0[3]); aw.z = cvt_pk_bf16(sb0[0], sb0[1]); aw.w = cvt_pk_bf16(sb0[2], sb0[3]); afr[(kk) & 1] = __builtin_bit_cast(bf16x8, aw); } while (0)
#define QMF(n) do { pg8::u32x4 bw; bw.x = ql[(n) & 7].x; bw.y = ql[(n) & 7].y; bw.z = qh[(n) & 7].x; bw.w = qh[(n) & 7].y; accQ[(n) & 3] = __builtin_amdgcn_mfma_f32_16x16x32_bf16(afr[((n) >> 2) & 1], __builtin_bit_cast(bf16x8, bw), accQ[(n) & 3], 0, 0, 0); } while (0)
#define KRD(t) do { k0w[(t) & 3] = TRFRAG((t) * 32 + trK, STK); k1w[(t) & 3] = TRFRAG(32 * STK + (t) * 32 + trK, STK); } while (0)
#define KDEC(dst, t) do { const f32x4 r_ = R[i * 8 + (t)]; _Pragma("unroll") for (int e_ = 0; e_ < 4; ++e_) { float t_; asm("v_mul_f32 %0, %1, %2" : "=v"(t_) : "v"(r_[e_]), "v"(dec)); dst[e_] = t_; } } while (0)
#define KMF(sv, t) do { sv = __builtin_amdgcn_mfma_f32_16x16x32_bf16(k0w[(t) & 3], vt0, sv, 0, 0, 0); sv = __builtin_amdgcn_mfma_f32_16x16x32_bf16(k1w[(t) & 3], vt1, sv, 0, 0, 0); R[i * 8 + (t)] = sv; } while (0)
                                QRD(0); QRD(1); QRD(2); QRD(3); QRD(4); QRD(5); QRD(6); QRD(7); AFQ(0); SB();
                                const bf16x8 vt0 = TRFRAG(trVT, STV), vt1 = TRFRAG(trVT + 32 * STV, STV);
                                QMF(0); QRD(8); SB();
                                AFQ(1); QMF(1); QRD(9); SB();
                                QMF(2); QRD(10); SB();
                                QMF(3); QRD(11); SB();
                                QMF(4); QRD(12); SB();
                                AFQ(2); QMF(5); QRD(13); SB();
                                QMF(6); QRD(14); SB();
                                QMF(7); QRD(15); SB();
                                QMF(8); KRD(0); SB();
                                AFQ(3); QMF(9); SB();
                                QMF(10); KRD(1); SB();
                                QMF(11); SB();
                                QMF(12); KRD(2); SB();
                                QMF(13); SB();
                                QMF(14); KRD(3); SB();
                                QMF(15); SB();
                                f32x4 svA, svB; KDEC(svA, 0); SB();
                                KDEC(svB, 1); KMF(svA, 0); KRD(4); SB();
                                KDEC(svA, 2); KMF(svB, 1); KRD(5); SB();
                                KDEC(svB, 3); KMF(svA, 2); KRD(6); SB();
                                KDEC(svA, 4); KMF(svB, 3); KRD(7); SB();
                                KDEC(svB, 5); KMF(svA, 4); SB();
                                KDEC(svA, 6); KMF(svB, 5); SB();
                                KDEC(svB, 7); KMF(svA, 6); SB();
                                KMF(svB, 7); SB();
#undef QRD
#undef AFQ
#undef QMF
#undef KRD
#undef KDEC
#undef KMF
                            } else {
                                const int tlq = ltid_u; const int rowq = tlq >> 4; const unsigned colq = (unsigned)(tlq & 15) * 16u;
                                ML_LOADX(i, cnx, i, 0, rowq, colq);
                                SB();
                                const int lnd = FRESHI(lane); const int g4 = lnd >> 4, l15 = lnd & 15;
                                const bool dofold = (ltid < 128) && !(i == 0 && c == 0);
                                const int kr = ((i + 3) & 3) * 128 + (ltid & 127);
                                const float fo_n = nS[kr], fo_p = nPart[((i + 1) & 1) * 128 + (ltid & 127)];
                                const unsigned tbo = MTB_OFF + (c & 1) * 128 + 8 * g4;
                                const v2u t0l = LDSV(v2u, tbo), t0h = LDSV(v2u, tbo + 32), t1l = LDSV(v2u, tbo + 64), t1h = LDSV(v2u, tbo + 96);
                                const unsigned trK = (unsigned)((4 * g4 + (l15 >> 2)) * STK + 8 * (lnd & 3) + MQ_K + b * MQ_BUF + lw * 64);
                                const bf16x8 kfa0 = TRFRAG(trK, STK), kfa1 = TRFRAG(32 * STK + trK, STK);
                                SB();
                                ML_LOADX(i, cnx, i, 1, rowq, colq);
                                SB();
                                if (dofold) { const float dc = i == 0 ? decS[(c + 1) & 1] : dec; const float nn = dc * fo_n + fo_p; nS[kr] = nn; nB[kr] = (unsigned short)f2bf(nn); }
                                { pg8::u32x4 w0, w1; w0.x = t0l.x; w0.y = t0l.y; w0.z = t0h.x; w0.w = t0h.y; w1.x = t1l.x; w1.y = t1l.y; w1.z = t1h.x; w1.w = t1h.y;
                                  const bf16x8 tf0 = __builtin_bit_cast(bf16x8, w0), tf1 = __builtin_bit_cast(bf16x8, w1);
                                  const bf16x8 kfb0 = TRFRAG(32 + trK, STK), kfb1 = TRFRAG(32 * STK + 32 + trK, STK);
                                  f32x4 pn = (f32x4){0.f, 0.f, 0.f, 0.f}; pn = __builtin_amdgcn_mfma_f32_16x16x32_bf16(kfa0, tf0, pn, 0, 0, 0); pn = __builtin_amdgcn_mfma_f32_16x16x32_bf16(kfa1, tf1, pn, 0, 0, 0);
                                  if (l15 == 0) *(LAS f32x4*)(nPart + (i & 1) * 128 + (2 * lw) * 16 + 4 * g4) = pn;
                                  SB(); ML_LOADX(i, cnx, i, 2, rowq, colq); SB();
                                  f32x4 pm = (f32x4){0.f, 0.f, 0.f, 0.f}; pm = __builtin_amdgcn_mfma_f32_16x16x32_bf16(kfb0, tf0, pm, 0, 0, 0); pm = __builtin_amdgcn_mfma_f32_16x16x32_bf16(kfb1, tf1, pm, 0, 0, 0);
                                  if (l15 == 0) *(LAS f32x4*)(nPart + (i & 1) * 128 + (2 * lw + 1) * 16 + 4 * g4) = pm; }
                                SB();
                                ML_LOADX(i, cnx, i, 3, rowq, colq);
                                if (i == 0) ML_LOADS_S(cnx);
                                SB();
                                { const unsigned qro = (unsigned)(b * MQ_BUF + (lw * 16 + l15) * ST128 + 16 * g4), nbo = (unsigned)(MNB_OFF + (i * 128 + 8 * g4) * 2);
                                  bf16x8 qf[4], nf[4];
#pragma unroll
                                  for (int kk = 0; kk < 4; ++kk) { qf[kk] = LDSV(bf16x8, qro + kk * 64); nf[kk] = LDSV(bf16x8, nbo + kk * 64); }
                                  SB();
#pragma unroll
                                  for (int kk = 0; kk < 4; ++kk) qn_acc = __builtin_amdgcn_mfma_f32_16x16x32_bf16(qf[kk], nf[kk], qn_acc, 0, 0, 0); }
                                SB();
                                ML_WRITES(b ^ 1, (i + 1) & 3);
                                if (i == 3) { ML_WRITES_S(cnx); if (l15 == 0) *(LAS f32x4*)(qnP + lw * 16 + 4 * g4) = qn_acc; qn_acc = (f32x4){0.f, 0.f, 0.f, 0.f}; }
                            }
                            __syncthreads();
                        }
                        if (true) {
                            const int lnf = lnu; const int l15 = ul15, g4 = ug4;
                            float qn4[4], gt4[4], em4[4], dn4[4]; f32x4 ib4[4];
#pragma unroll
                            for (int tt = 0; tt < 4; ++tt) { const int t = tt * 16 + l15; qn4[tt] = qnP[t]; gt4[tt] = scc[t]; em4[tt] = scc[64 + t]; dn4[tt] = scc[128 + t]; ib4[tt] = Ib[(v16 * 4 + tt) * 64 + lnf]; }
                            SB();
#pragma unroll
                            for (int tt = 0; tt < 4; ++tt) { const int t = tt * 16 + l15;
                                const float den = dn4[tt] + gt4[tt] * qn4[tt];
                                const float rd = __builtin_amdgcn_rcpf(fmaxf(fabsf(den), em4[tt]));
                                const f32x4 hv = (ib4[tt] + accQ[tt] * gt4[tt]) * rd;
                                if (t < Lv) { v2u o; o.x = pk2(hv[0], hv[1]); o.y = pk2(hv[2], hv[3]); *(v2u*)(H + (size_t)(r0 + t) * ML_INNER + hd * 512 + vs * 64 + v16 * 16 + 4 * g4) = o; } }
                        }
                    }
                    if (!true && ltid < 128) { const int kr = 3 * 128 + ltid; nS[kr] = decS[(nch - 1) & 1] * nS[kr] + nPart[128 + ltid]; }
                    __syncthreads();
                    {
                        const size_t sbo = s < NB_P ? (size_t)(j * NB_P + s) * ML_NH + hd : sbi;
                        int t2_ = tid; asm volatile("" : "+v"(t2_));
                        const unsigned stio = (unsigned)((t2_ >> 4) * 256 + (t2_ & 15) * 16);
                        const unsigned stld = (unsigned)((4 * ((t2_ >> 4) & 3)) * 256 + (((t2_ >> 6) & 3) * 16 + (t2_ & 15)) * 4);
                        if (vs == 0) { out[(s < NB_P ? O_P_MN : O_S_MN) + sbo * ML_HD + tid] = nS[tid]; if (tid == 0) out[(s < NB_P ? O_P_MM : O_S_MM) + sbo] = CHK[((ci0 + nch - 1) * 8 + hd) * 2 + 1]; }
                        __syncthreads();
#pragma unroll
                        for (int h = 0; h < 2; ++h) {
                            if (true) {
#pragma unroll
                                for (int i2 = 0; i2 < 2; ++i2)
#pragma unroll
                                    for (int kt = 0; kt < 8; ++kt)
#pragma unroll
                                        for (int r = 0; r < 4; ++r) LDSV(float, (i2 * 128 + kt * 16 + r) * 256 + stld) = R[(2 * h + i2) * 8 + kt][r];
                            }
                            __syncthreads();
                            float* gp = out + (s < NB_P ? O_P_MC : O_S_MC) + sbo * ML_HD * ML_HD + (size_t)(h * 256 + (t2_ >> 4)) * ML_HD + vs * 64 + (t2_ & 15) * 4;
#pragma unroll 1
                            for (int p = 0; p < 8; ++p) *(f32x4*)(gp + (size_t)p * 32 * ML_HD) = LDSV(f32x4, p * 8192 + stio);
                            __syncthreads();
                        }
                    }
                    __syncthreads();
#undef ML_LOADS
#undef ML_LOADS_S
#undef ML_WRITES
#undef ML_WRITES_S
                }
                } else {
                for (int u = bx; u < 2304; u += G) {
                    int s, hd, vs;
                    if (u < 256) { const int pr = (u & 7) + 8 * (u >> 6); vs = (u >> 3) & 7; s = pr >> 3; hd = pr & 7; }
                    else { const int up = u - 256, pr = (up & 7) + 8 * (up >> 6); vs = (up >> 3) & 7; s = NB_P + (pr >> 3); hd = pr & 7; }
                    const int T = stream_T(s), row0 = stream_row0(s), Lv = T < 64 ? T : 64, nch = T < 64 ? 1 : T / 64;
                    const int ci0 = s < NB_P ? s * 128 : 512 + (s - NB_P);
                    const size_t sbi = s < NB_P ? 0 : (size_t)(j * NB_S + (s - NB_P)) * ML_NH + hd;
                    f32x4 R[32];
                    if (s < NB_P) {
                        if (false) {
#pragma unroll
                            for (int i = 0; i < 32; ++i) R[i] = (f32x4){0.f, 0.f, 0.f, 0.f};
                        }
                        nS[tid] = 0.f; nB[tid] = 0;
                    } else {
                        int t2_ = tid; asm volatile("" : "+v"(t2_));
                        const unsigned stio = (unsigned)((t2_ >> 4) * 256 + (t2_ & 15) * 16);
                        const unsigned stld = (unsigned)((4 * ((t2_ >> 4) & 3)) * 256 + (((t2_ >> 6) & 3) * 16 + (t2_ & 15)) * 4);
#pragma unroll
                        for (int h = 0; h < 2; ++h) {
                            const float* gp = st_mC + sbi * ML_HD * ML_HD + (size_t)(h * 256 + (t2_ >> 4)) * ML_HD + vs * 64 + (t2_ & 15) * 4;
#pragma unroll
                            for (int pp = 0; pp < 2; ++pp) { f32x4 tmp[4];
#pragma unroll
                                for (int p = 0; p < 4; ++p) tmp[p] = *(const f32x4*)(gp + (size_t)(pp * 4 + p) * 32 * ML_HD);
#pragma unroll
                                for (int p = 0; p < 4; ++p) LDSV(f32x4, (pp * 4 + p) * 8192 + stio) = tmp[p]; SB(); }
                            __syncthreads();
                            if (false) {
#pragma unroll
                                for (int i2 = 0; i2 < 2; ++i2)
#pragma unroll
                                    for (int kt = 0; kt < 8; ++kt)
#pragma unroll
                                        for (int r = 0; r < 4; ++r) R[(2 * h + i2) * 8 + kt][r] = LDSV(float, (i2 * 128 + kt * 16 + r) * 256 + stld);
                            }
                            __syncthreads();
                        }
                        { const float n0_ = st_mn[sbi * ML_HD + tid]; nS[tid] = n0_; nB[tid] = (unsigned short)f2bf(n0_); }
                    }
                    const int ltid_u = FRESHI(ltid), lane_u = FRESHI(lane);
                    const int lnu = FRESHI(lane); const int ug4 = lnu >> 4, ul15 = lnu & 15;
                    const unsigned m_rowQ = (unsigned)(ul15 * ST128 + 8 * ug4); unsigned m_rowQh = m_rowQ + 32; asm volatile("" : "+v"(m_rowQh));
                    const unsigned m_trK0 = (unsigned)((4 * ug4 + (ul15 >> 2)) * STK + 8 * (lnu & 3) + MQ_K);
                    const unsigned m_trVT0 = (unsigned)((4 * ug4 + (ul15 >> 2)) * STV + 8 * (lnu & 3) + v16 * 32 + MVT_OFF);
                    v4u sa[2], va[2]; float tlv[2]; f32x4 tk; float dcv;
                    const char* Qu = (const char*)(Q + (size_t)row0 * ML_INNER + hd * 512); const char* Ku = (const char*)(Kb + (size_t)row0 * ML_INNER + hd * 512);
#define ML_LOADX(set, cn, qi, x_, rowq_, colq_) do { const size_t go_ = ((size_t)(cn) * 64 * ML_INNER + (qi) * 128) * 2; const int rr_ = (rowq_) + 16 * (x_), rc_ = rr_ < Lv ? rr_ : Lv - 1; const unsigned qk_ = (unsigned)(rc_ * (ML_INNER * 2)) + (colq_); \
    R[(set) * 8 + (x_)] = *(const f32x4*)(Qu + go_ + qk_); R[(set) * 8 + 4 + (x_)] = *(const f32x4*)(Ku + go_ + qk_); } while (0)
#define ML_LOADS(set, cn, qi) do { const int tl_ = FRESHI(ltid); const int rq_ = tl_ >> 4; const unsigned cq_ = (unsigned)(tl_ & 15) * 16u; \
    ML_LOADX(set, cn, qi, 0, rq_, cq_); ML_LOADX(set, cn, qi, 1, rq_, cq_); ML_LOADX(set, cn, qi, 2, rq_, cq_); ML_LOADX(set, cn, qi, 3, rq_, cq_); } while (0)
#define ML_LOADS_S(cn) do { const int rn0_ = row0 + (cn) * 64; const int tl_ = FRESHI(ltid); \
    _Pragma("unroll") for (int x_ = 0; x_ < 2; ++x_) { const int tq_ = (tl_ >> 3) + 32 * x_, tc_ = tq_ < Lv ? tq_ : Lv - 1; \
        sa[x_] = *(const v4u*)(Sg + (size_t)((ci0 + (cn)) * 8 + hd) * 4096 + (tl_ + 256 * x_) * 8); \
        va[x_] = *(const v4u*)(Vb + (size_t)(rn0_ + tc_) * ML_INNER + hd * 512 + vs * 64 + (tl_ & 7) * 8); tlv[x_] = TOK[((size_t)(rn0_ + tc_) * 8 + hd) * 4 + 3]; } \
    { const int t6_ = tl_ & 63, t6c_ = t6_ < Lv ? t6_ : Lv - 1; tk = *(const f32x4*)(TOK + ((size_t)(rn0_ + t6c_) * 8 + hd) * 4); } \
    dcv = CHK[((ci0 + (cn)) * 8 + hd) * 2]; } while (0)
#define ML_WRITES(bufi, set) do { const int tw_ = ltid_u; const unsigned stq_ = (unsigned)((tw_ >> 4) * ST128 + (tw_ & 15) * 16), stk_ = (unsigned)((tw_ >> 4) * STK + (tw_ & 15) * 16 + MQ_K); \
    _Pragma("unroll") for (int x_ = 0; x_ < 4; ++x_) { LDSV(f32x4, (bufi) * MQ_BUF + x_ * 16 * ST128 + stq_) = R[(set) * 8 + x_]; LDSV(f32x4, (bufi) * MQ_BUF + x_ * 16 * STK + stk_) = R[(set) * 8 + 4 + x_]; } } while (0)
#define ML_WRITES_S(cn) do { const int tw_ = FRESHI(ltid); const unsigned sts_ = (unsigned)((tw_ >> 3) * ST64 + (tw_ & 7) * 16 + MS_OFF), stv_ = (unsigned)((tw_ >> 3) * STV + (tw_ & 7) * 16 + MV_OFF); \
    _Pragma("unroll") for (int x_ = 0; x_ < 2; ++x_) { if ((tw_ >> 3) + 32 * x_ >= Lv) { va[x_] = (v4u){0u, 0u, 0u, 0u}; tlv[x_] = 0.f; } \
        LDSV(v4u, x_ * 32 * ST64 + sts_) = sa[x_]; LDSV(v4u, x_ * 32 * STV + stv_) = va[x_]; const float tl2_ = tlv[x_]; \
        v4u o_; o_.x = pk2(bflo(va[x_].x) * tl2_, bfhi(va[x_].x) * tl2_); o_.y = pk2(bflo(va[x_].y) * tl2_, bfhi(va[x_].y) * tl2_); o_.z = pk2(bflo(va[x_].z) * tl2_, bfhi(va[x_].z) * tl2_); o_.w = pk2(bflo(va[x_].w) * tl2_, bfhi(va[x_].w) * tl2_); \
        LDSV(v4u, (MVT_OFF - MV_OFF) + ((cn) & 1) * MV_IMG + x_ * 32 * STV + stv_) = o_; } \
    if ((tw_ & 63) >= Lv) tk = (f32x4){0.f, 1.f, 1.f, 0.f}; \
    if (tw_ < 64) { LAS float* sc_ = scal + ((cn) & 1) * 256; sc_[tw_] = tk[0]; sc_[64 + tw_] = tk[1]; sc_[128 + tw_] = tk[2]; sc_[192 + tw_] = tk[3]; tailB[((cn) & 1) * 64 + tw_] = (unsigned short)f2bf(tk[3]); } \
    if (tw_ == 64) decS[(cn) & 1] = dcv; } while (0)
                    if (!false) {
                        ML_LOADS(0, 0, 0); ML_LOADS_S(0); ML_LOADS(1, 0, 1); ML_LOADS(2, 0, 2); ML_LOADS(3, 0, 3);
                        ML_WRITES(0, 0); ML_WRITES_S(0);
                    }
                    __syncthreads();
                    f32x4 qn_acc = (f32x4){0.f, 0.f, 0.f, 0.f};
                    for (int c = 0; c < nch; ++c) {
                        const int r0 = row0 + c * 64;
                        const int cnx = c + 1 < nch ? c + 1 : nch - 1;
                        f32x4 accQ[4];
#pragma unroll
                        for (int tt = 0; tt < 4; ++tt) accQ[tt] = (f32x4){0.f, 0.f, 0.f, 0.f};
                        const LAS float* scc = scal + (c & 1) * 256;
                        const float dec = decS[c & 1];
#pragma unroll
                        for (int i = 0; i < 4; ++i) {
                            const int b = i & 1;
                            if (false) {
                                const unsigned rowQ = m_rowQ + b * MQ_BUF, rowQh = m_rowQh + b * MQ_BUF;
                                const unsigned trK = m_trK0 + b * MQ_BUF;
                                const unsigned trVT = m_trVT0 + (c & 1) * MV_IMG;
                                if (i == 0) {
                                    const unsigned trV = m_trVT0 - (MVT_OFF - MV_OFF), rowS = (unsigned)(ul15 * ST64 + 8 * ug4 + MS_OFF);
                                    f32x4 accI[4];
#pragma unroll
                                    for (int tt = 0; tt < 4; ++tt) accI[tt] = (f32x4){0.f, 0.f, 0.f, 0.f};
                                    bf16x8 vf2[2]; v2u sl2[2][4], sh2[2][4];
#pragma unroll
                                    for (int ks = 0; ks < 2; ++ks) { vf2[ks] = TRFRAG(ks * 32 * STV + trV, STV);
#pragma unroll
                                        for (int tt = 0; tt < 4; ++tt) { sl2[ks][tt] = LDSV(v2u, tt * 16 * ST64 + ks * 64 + rowS); sh2[ks][tt] = LDSV(v2u, tt * 16 * ST64 + ks * 64 + 32 + rowS); } }
                                    SB();
#pragma unroll
                                    for (int ks = 0; ks < 2; ++ks) {
#pragma unroll
                                        for (int tt = 0; tt < 4; ++tt) { pg8::u32x4 sw; sw.x = sl2[ks][tt].x; sw.y = sl2[ks][tt].y; sw.z = sh2[ks][tt].x; sw.w = sh2[ks][tt].y;
                                            accI[tt] = __builtin_amdgcn_mfma_f32_16x16x32_bf16(vf2[ks], __builtin_bit_cast(bf16x8, sw), accI[tt], 0, 0, 0); } }
#pragma unroll
                                    for (int tt = 0; tt < 4; ++tt) Ib[(v16 * 4 + tt) * 64 + lnu] = accI[tt];
                                    SB();
                                }
                                v2u ql[8], qh[8]; bf16x8 k0w[4], k1w[4], afr[2];
#define QRD(n) do { ql[(n) & 7] = LDSV(v2u, ((n) & 3) * 16 * ST128 + ((n) >> 2) * 64 + rowQ); qh[(n) & 7] = LDSV(v2u, ((n) & 3) * 16 * ST128 + ((n) >> 2) * 64 + rowQh); asm volatile("" ::: "memory"); } while (0)
#define AFQ(kk) do { const f32x4 sa0 = R[i * 8 + 2 * (kk)], sb0 = R[i * 8 + 2 * (kk) + 1]; pg8::u32x4 aw; aw.x = cvt_pk_bf16(sa0[0], sa0[1]); aw.y = cvt_pk_bf16(sa0[2], sa0[3]); aw.z = cvt_pk_bf16(sb0[0], sb0[1]); aw.w = cvt_pk_bf16(sb0[2], sb0[3]); afr[(kk) & 1] = __builtin_bit_cast(bf16x8, aw); } while (0)
#define QMF(n) do { pg8::u32x4 bw; bw.x = ql[(n) & 7].x; bw.y = ql[(n) & 7].y; bw.z = qh[(n) & 7].x; bw.w = qh[(n) & 7].y; accQ[(n) & 3] = __builtin_amdgcn_mfma_f32_16x16x32_bf16(afr[((n) >> 2) & 1], __builtin_bit_cast(bf16x8, bw), accQ[(n) & 3], 0, 0, 0); } while (0)
#define KRD(t) do { k0w[(t) & 3] = TRFRAG((t) * 32 + trK, STK); k1w[(t) & 3] = TRFRAG(32 * STK + (t) * 32 + trK, STK); } while (0)
#define KDEC(dst, t) do { const f32x4 r_ = R[i * 8 + (t)]; _Pragma("unroll") for (int e_ = 0; e_ < 4; ++e_) { float t_; asm("v_mul_f32 %0, %1, %2" : "=v"(t_) : "v"(r_[e_]), "v"(dec)); dst[e_] = t_; } } while (0)
#define KMF(sv, t) do { sv = __builtin_amdgcn_mfma_f32_16x16x32_bf16(k0w[(t) & 3], vt0, sv, 0, 0, 0); sv = __builtin_amdgcn_mfma_f32_16x16x32_bf16(k1w[(t) & 3], vt1, sv, 0, 0, 0); R[i * 8 + (t)] = sv; } while (0)
                                QRD(0); QRD(1); QRD(2); QRD(3); QRD(4); QRD(5); QRD(6); QRD(7); AFQ(0); SB();
                                const bf16x8 vt0 = TRFRAG(trVT, STV), vt1 = TRFRAG(trVT + 32 * STV, STV);
                                QMF(0); QRD(8); SB();
                                AFQ(1); QMF(1); QRD(9); SB();
                                QMF(2); QRD(10); SB();
                                QMF(3); QRD(11); SB();
                                QMF(4); QRD(12); SB();
                                AFQ(2); QMF(5); QRD(13); SB();
                                QMF(6); QRD(14); SB();
                                QMF(7); QRD(15); SB();
                                QMF(8); KRD(0); SB();
                                AFQ(3); QMF(9); SB();
                                QMF(10); KRD(1); SB();
                                QMF(11); SB();
                                QMF(12); KRD(2); SB();
                                QMF(13); SB();
                                QMF(14); KRD(3); SB();
                                QMF(15); SB();
                                f32x4 svA, svB; KDEC(svA, 0); SB();
                                KDEC(svB, 1); KMF(svA, 0); KRD(4); SB();
                                KDEC(svA, 2); KMF(svB, 1); KRD(5); SB();
                                KDEC(svB, 3); KMF(svA, 2); KRD(6); SB();
                                KDEC(svA, 4); KMF(svB, 3); KRD(7); SB();
                                KDEC(svB, 5); KMF(svA, 4); SB();
                                KDEC(svA, 6); KMF(svB, 5); SB();
                                KDEC(svB, 7); KMF(svA, 6); SB();
                                KMF(svB, 7); SB();
#undef QRD
#undef AFQ
#undef QMF
#undef KRD
#undef KDEC
#undef KMF
                            } else {
                                const int tlq = ltid_u; const int rowq = tlq >> 4; const unsigned colq = (unsigned)(tlq & 15) * 16u;
                                ML_LOADX(i, cnx, i, 0, rowq, colq);
                                SB();
                                const int lnd = FRESHI(lane); const int g4 = lnd >> 4, l15 = lnd & 15;
                                const bool dofold = (ltid < 128) && !(i == 0 && c == 0);
                                const int kr = ((i + 3) & 3) * 128 + (ltid & 127);
                                const float fo_n = nS[kr], fo_p = nPart[((i + 1) & 1) * 128 + (ltid & 127)];
                                const unsigned tbo = MTB_OFF + (c & 1) * 128 + 8 * g4;
                                const v2u t0l = LDSV(v2u, tbo), t0h = LDSV(v2u, tbo + 32), t1l = LDSV(v2u, tbo + 64), t1h = LDSV(v2u, tbo + 96);
                                const unsigned trK = (unsigned)((4 * g4 + (l15 >> 2)) * STK + 8 * (lnd & 3) + MQ_K + b * MQ_BUF + lw * 64);
                                const bf16x8 kfa0 = TRFRAG(trK, STK), kfa1 = TRFRAG(32 * STK + trK, STK);
                                SB();
                                ML_LOADX(i, cnx, i, 1, rowq, colq);
                                SB();
                                if (dofold) { const float dc = i == 0 ? decS[(c + 1) & 1] : dec; const float nn = dc * fo_n + fo_p; nS[kr] = nn; nB[kr] = (unsigned short)f2bf(nn); }
                                { pg8::u32x4 w0, w1; w0.x = t0l.x; w0.y = t0l.y; w0.z = t0h.x; w0.w = t0h.y; w1.x = t1l.x; w1.y = t1l.y; w1.z = t1h.x; w1.w = t1h.y;
                                  const bf16x8 tf0 = __builtin_bit_cast(bf16x8, w0), tf1 = __builtin_bit_cast(bf16x8, w1);
                                  const bf16x8 kfb0 = TRFRAG(32 + trK, STK), kfb1 = TRFRAG(32 * STK + 32 + trK, STK);
                                  f32x4 pn = (f32x4){0.f, 0.f, 0.f, 0.f}; pn = __builtin_amdgcn_mfma_f32_16x16x32_bf16(kfa0, tf0, pn, 0, 0, 0); pn = __builtin_amdgcn_mfma_f32_16x16x32_bf16(kfa1, tf1, pn, 0, 0, 0);
                                  if (l15 == 0) *(LAS f32x4*)(nPart + (i & 1) * 128 + (2 * lw) * 16 + 4 * g4) = pn;
                                  SB(); ML_LOADX(i, cnx, i, 2, rowq, colq); SB();
                                  f32x4 pm = (f32x4){0.f, 0.f, 0.f, 0.f}; pm = __builtin_amdgcn_mfma_f32_16x16x32_bf16(kfb0, tf0, pm, 0, 0, 0); pm = __builtin_amdgcn_mfma_f32_16x16x32_bf16(kfb1, tf1, pm, 0, 0, 0);
                                  if (l15 == 0) *(LAS f32x4*)(nPart + (i & 1) * 128 + (2 * lw + 1) * 16 + 4 * g4) = pm; }
                                SB();
                                ML_LOADX(i, cnx, i, 3, rowq, colq);
                                if (i == 0) ML_LOADS_S(cnx);
                                SB();
                                { const unsigned qro = (unsigned)(b * MQ_BUF + (lw * 16 + l15) * ST128 + 16 * g4), nbo = (unsigned)(MNB_OFF + (i * 128 + 8 * g4) * 2);
                                  bf16x8 qf[4], nf[4];
#pragma unroll
                                  for (int kk = 0; kk < 4; ++kk) { qf[kk] = LDSV(bf16x8, qro + kk * 64); nf[kk] = LDSV(bf16x8, nbo + kk * 64); }
                                  SB();
#pragma unroll
                                  for (int kk = 0; kk < 4; ++kk) qn_acc = __builtin_amdgcn_mfma_f32_16x16x32_bf16(qf[kk], nf[kk], qn_acc, 0, 0, 0); }
                                SB();
                                ML_WRITES(b ^ 1, (i + 1) & 3);
                                if (i == 3) { ML_WRITES_S(cnx); if (l15 == 0) *(LAS f32x4*)(qnP + lw * 16 + 4 * g4) = qn_acc; qn_acc = (f32x4){0.f, 0.f, 0.f, 0.f}; }
                            }
                            __syncthreads();
                        }
                        if (false) {
                            const int lnf = lnu; const int l15 = ul15, g4 = ug4;
                            float qn4[4], gt4[4], em4[4], dn4[4]; f32x4 ib4[4];
#pragma unroll
                            for (int tt = 0; tt < 4; ++tt) { const int t = tt * 16 + l15; qn4[tt] = qnP[t]; gt4[tt] = scc[t]; em4[tt] = scc[64 + t]; dn4[tt] = scc[128 + t]; ib4[tt] = Ib[(v16 * 4 + tt) * 64 + lnf]; }
                            SB();
#pragma unroll
                            for (int tt = 0; tt < 4; ++tt) { const int t = tt * 16 + l15;
                                const float den = dn4[tt] + gt4[tt] * qn4[tt];
                                const float rd = __builtin_amdgcn_rcpf(fmaxf(fabsf(den), em4[tt]));
                                const f32x4 hv = (ib4[tt] + accQ[tt] * gt4[tt]) * rd;
                                if (t < Lv) { v2u o; o.x = pk2(hv[0], hv[1]); o.y = pk2(hv[2], hv[3]); *(v2u*)(H + (size_t)(r0 + t) * ML_INNER + hd * 512 + vs * 64 + v16 * 16 + 4 * g4) = o; } }
                        }
                    }
                    if (!false && ltid < 128) { const int kr = 3 * 128 + ltid; nS[kr] = decS[(nch - 1) & 1] * nS[kr] + nPart[128 + ltid]; }
                    __syncthreads();
                    {
                        const size_t sbo = s < NB_P ? (size_t)(j * NB_P + s) * ML_NH + hd : sbi;
                        int t2_ = tid; asm volatile("" : "+v"(t2_));
                        const unsigned stio = (unsigned)((t2_ >> 4) * 256 + (t2_ & 15) * 16);
                        const unsigned stld = (unsigned)((4 * ((t2_ >> 4) & 3)) * 256 + (((t2_ >> 6) & 3) * 16 + (t2_ & 15)) * 4);
                        if (vs == 0) { out[(s < NB_P ? O_P_MN : O_S_MN) + sbo * ML_HD + tid] = nS[tid]; if (tid == 0) out[(s < NB_P ? O_P_MM : O_S_MM) + sbo] = CHK[((ci0 + nch - 1) * 8 + hd) * 2 + 1]; }
                        __syncthreads();
#pragma unroll
                        for (int h = 0; h < 2; ++h) {
                            if (false) {
#pragma unroll
                                for (int i2 = 0; i2 < 2; ++i2)
#pragma unroll
                                    for (int kt = 0; kt < 8; ++kt)
#pragma unroll
                                        for (int r = 0; r < 4; ++r) LDSV(float, (i2 * 128 + kt * 16 + r) * 256 + stld) = R[(2 * h + i2) * 8 + kt][r];
                            }
                            __syncthreads();
                            float* gp = out + (s < NB_P ? O_P_MC : O_S_MC) + sbo * ML_HD * ML_HD + (size_t)(h * 256 + (t2_ >> 4)) * ML_HD + vs * 64 + (t2_ & 15) * 4;
#pragma unroll 1
                            for (int p = 0; p < 8; ++p) *(f32x4*)(gp + (size_t)p * 32 * ML_HD) = LDSV(f32x4, p * 8192 + stio);
                            __syncthreads();
                        }
                    }
                    __syncthreads();
#undef ML_LOADS
#undef ML_LOADS_S
#undef ML_WRITES
#undef ML_WRITES_S
                }
                }
#undef LDSV
#undef TRFRAG
#undef FRESHI
#undef SB
            }
            SEAM(pb + 4, pb + 5);
            if (IN(pb + 5)) {
                SITE_VARS();
                const float* norm_w = args.in[24] + (size_t)j * ML_INNER; const float* skip = args.in[25] + (size_t)j * ML_INNER;
                for (int it = gw; it < M * 2; it += NGW) {
                    const int row = it >> 1, hh = (it & 1) * 4; const size_t off0 = (size_t)row * ML_INNER + hh * 512 + lane * 8;
                    v4u hw4[4], ow4[4], xw4[4], zw4[4];
#pragma unroll
                    for (int q = 0; q < 4; ++q) { hw4[q] = *(const v4u*)(H + off0 + q * 512); ow4[q] = *(const v4u*)(O + off0 + q * 512); xw4[q] = *(const v4u*)(XC + off0 + q * 512); zw4[q] = *(const v4u*)(Z + off0 + q * 512); }
#pragma unroll
                    for (int q = 0; q < 4; ++q) {
                        const int hd = hh + q; const v4u hw = hw4[q], ow = ow4[q], xw = xw4[q], zw = zw4[q];
                        float h[8] = {bflo(hw.x), bfhi(hw.x), bflo(hw.y), bfhi(hw.y), bflo(hw.z), bfhi(hw.z), bflo(hw.w), bfhi(hw.w)};
                        const float og[8] = {bflo(ow.x), bfhi(ow.x), bflo(ow.y), bfhi(ow.y), bflo(ow.z), bfhi(ow.z), bflo(ow.w), bfhi(ow.w)};
                        const float xc[8] = {bflo(xw.x), bfhi(xw.x), bflo(xw.y), bfhi(xw.y), bflo(xw.z), bfhi(xw.z), bflo(xw.w), bfhi(xw.w)};
                        const float zz[8] = {bflo(zw.x), bfhi(zw.x), bflo(zw.y), bfhi(zw.y), bflo(zw.z), bfhi(zw.z), bflo(zw.w), bfhi(zw.w)};
                        float sm = 0.f;
#pragma unroll
                        for (int i = 0; i < 8; ++i) sm += h[i];
                        const float mu = wave_sum(sm) * (1.f / 512.f); float s2 = 0.f;
#pragma unroll
                        for (int i = 0; i < 8; ++i) { h[i] -= mu; s2 += h[i] * h[i]; }
                        const float rstd = rsqrtf(wave_sum(s2) * (1.f / 512.f) + LN_EPS);
                        const float* nw = norm_w + hd * 512 + lane * 8; const float* sk = skip + hd * 512 + lane * 8;
                        const f32x4 n0 = *(const f32x4*)nw, n1 = *(const f32x4*)(nw + 4), k0 = *(const f32x4*)sk, k1 = *(const f32x4*)(sk + 4);
                        const float nwv[8] = {n0[0], n0[1], n0[2], n0[3], n1[0], n1[1], n1[2], n1[3]}, skv[8] = {k0[0], k0[1], k0[2], k0[3], k1[0], k1[1], k1[2], k1[3]};
                        float y[8];
#pragma unroll
                        for (int i = 0; i < 8; ++i) y[i] = (sigmoid_f(og[i]) * (h[i] * rstd * nwv[i]) + skv[i] * xc[i]) * silu_f(zz[i]);
                        v4u o; o.x = pk2(y[0], y[1]); o.y = pk2(y[2], y[3]); o.z = pk2(y[4], y[5]); o.w = pk2(y[6], y[7]);
                        *(v4u*)(YG + off0 + q * 512) = o;
                    }
                }
            }
            SEAM(pb + 5, pb + 6);
            if (IN(pb + 6)) {
                SITE_VARS();
                pg8::Gemm g{YG, (const bf16*)(ws + WS_WML_OUT) + (size_t)j * DM * ML_INNER, ML_INNER, ML_INNER, -1};
                pg8::SplitTailOrder S; S.init(M_P / 256, DM / 256, M_S / 256, G, bx, WGM_OUT);
                EpiResid E{XB, VPRE, DN_ALPHA, SLAB};
                pg8::gemm_phase<EpiResid, pg8::SplitTailOrder, PG8_ALIGN, PG8_SP2, true>(lds, g, S, E, tid);
            }
            SEAM(pb + 6, pb + 7);
            if (IN(pb + 7)) {
                SITE_VARS();
                const float* lg = args.in[27] + (size_t)li * DM; const float* lb = args.in[28] + (size_t)li * DM;
                const bool lastl = (li == 3);
                for (int row = gw; row < M; row += NGW) {
                    const v4u* vr = (const v4u*)(VPRE + (size_t)row * DM) + lane;
                    const v4u* XBV = (const v4u*)XB;
                    float v[32]; float sm = 0.f;
#pragma unroll
                    for (int q = 0; q < 4; ++q) { v4u w = vr[64 * q]; if (row >= M_P) w = (XBV + (size_t)row * (DM / 8) + lane)[64 * q]; v[8 * q + 0] = bflo(w.x); v[8 * q + 1] = bfhi(w.x); v[8 * q + 2] = bflo(w.y); v[8 * q + 3] = bfhi(w.y); v[8 * q + 4] = bflo(w.z); v[8 * q + 5] = bfhi(w.z); v[8 * q + 6] = bflo(w.w); v[8 * q + 7] = bfhi(w.w); }
                    if (row >= M_P) {
#pragma unroll
                        for (int i = 0; i < 32; ++i) v[i] *= DN_ALPHA;
#pragma unroll
                        for (int kq = 0; kq < 4; ++kq)
#pragma unroll
                            for (int q = 0; q < 4; ++q) { const float* sp = SLAB + ((size_t)kq * M_S + (row - M_P)) * DM + 8 * (lane + 64 * q); const f32x4 s0 = *(const f32x4*)sp, s1 = *(const f32x4*)(sp + 4);
                                v[8 * q + 0] += s0[0]; v[8 * q + 1] += s0[1]; v[8 * q + 2] += s0[2]; v[8 * q + 3] += s0[3]; v[8 * q + 4] += s1[0]; v[8 * q + 5] += s1[1]; v[8 * q + 6] += s1[2]; v[8 * q + 7] += s1[3]; }
                    }
#pragma unroll
                    for (int i = 0; i < 32; ++i) sm += v[i];
                    const float mean = wave_sum(sm) * (1.f / DM); float s2 = 0.f;
#pragma unroll
                    for (int i = 0; i < 32; ++i) { v[i] -= mean; s2 += v[i] * v[i]; }
                    const float rstd = rsqrtf(wave_sum(s2) * (1.f / DM) + LN_EPS);
#pragma unroll
                    for (int q = 0; q < 4; ++q) { const int c = 8 * (lane + 64 * q); const f32x4 g0 = *(const f32x4*)(lg + c), g1 = *(const f32x4*)(lg + c + 4), b0 = *(const f32x4*)(lb + c), b1 = *(const f32x4*)(lb + c + 4);
                        f32x4 o0, o1;
#pragma unroll
                        for (int e = 0; e < 4; ++e) { o0[e] = v[8 * q + e] * rstd * g0[e] + b0[e]; o1[e] = v[8 * q + 4 + e] * rstd * g1[e] + b1[e]; }
                        if (lastl) { float* orow = out + (size_t)row * DM + c; *(f32x4*)orow = o0; *(f32x4*)(orow + 4) = o1; } else { v4u w; w.x = pk2(o0[0], o0[1]); w.y = pk2(o0[2], o0[3]); w.z = pk2(o1[0], o1[1]); w.w = pk2(o1[2], o1[3]); *(v4u*)(XB + (size_t)row * DM + c) = w; } }
                }
            }
            SEAM(pb + 7, pb + 8);
        }
    }
#undef IN
#undef SEAM
}

static bool phase_used(int ph) { if (ph == 0) return true; const int i = (ph - 1) / 8, k = (ph - 1) % 8; return (i & 1) ? (k < 8) : (k < 6); }
constexpr int N_PHASE_IDS = 33;

extern "C" void kernel_launch(void* const* d_in, const int* in_sizes, int n_in, void* d_out, int out_size, void* d_ws, size_t ws_size, hipStream_t stream) {
    static int grid = 0;
    if (grid == 0) {
        if (n_in != 29 || (size_t)out_size != O_END || ws_size < WS_END) { fprintf(stderr, "kernel_launch: shape mismatch: n_in %d out %d (want %zu) ws %zu (want %zu)\n", n_in, out_size, (size_t)O_END, ws_size, (size_t)WS_END); grid = -1; return; }
        int dev = 0, cus = 0;
        if (hipGetDevice(&dev) != hipSuccess || hipDeviceGetAttribute(&cus, hipDeviceAttributeMultiprocessorCount, dev) != hipSuccess) { grid = -1; return; }
        if (hipFuncSetAttribute((const void*)mk_fwd, hipFuncAttributeMaxDynamicSharedMemorySize, LDS_BYTES) != hipSuccess) { fprintf(stderr, "kernel_launch: hipFuncSetAttribute failed\n"); grid = -1; return; }
        int per_cu = 0;
        (void)hipOccupancyMaxActiveBlocksPerMultiprocessor(&per_cu, (const void*)mk_fwd, NWAVES * 64, LDS_BYTES);
        (void)hipGetLastError();
        grid = cus;
    }
    if (grid < 0) return;
    if (hipMemsetAsync((char*)d_ws + WS_CTL, 0, CTL_ZERO_BYTES, stream) != hipSuccess) return;
    Args a{};
    for (int i = 0; i < 29; ++i) a.in[i] = (const float*)d_in[i];
    a.out = (float*)d_out; a.ws = (unsigned char*)d_ws;
#if MK_ONE_LAUNCH
    a.ph_lo = 0; a.ph_hi = N_PHASE_IDS;
    hipLaunchKernelGGL(mk_fwd, dim3(grid), dim3(NWAVES * 64), LDS_BYTES, stream, a);
#else
    for (int ph = 0; ph < N_PHASE_IDS; ++ph) {
        if (!phase_used(ph)) continue;
        a.ph_lo = ph; a.ph_hi = ph + 1;
        hipLaunchKernelGGL(mk_fwd, dim3(grid), dim3(NWAVES * 64), LDS_BYTES, stream, a);
    }
#endif
}
```

```cpp
#include <hip/hip_runtime.h>
#include <cstdio>
#include <cstdint>

#ifndef MK_ONE_LAUNCH
#define MK_ONE_LAUNCH 1
#endif

namespace pg8 {
#define PG8_LAS __attribute__((address_space(3)))
typedef unsigned short bf16_t;
typedef short bf16x8 __attribute__((ext_vector_type(8)));
typedef float f32x4 __attribute__((ext_vector_type(4)));
typedef unsigned u32x4 __attribute__((ext_vector_type(4)));
typedef unsigned u32x2 __attribute__((ext_vector_type(2)));
constexpr int BM = 256, BK = 64, HALF = 128, HTB = HALF * BK * 2  , STAGE_BYTES = 8 * HTB, NXCD = 8, WGM = 8;

__host__ __device__ __forceinline__ int lds_byte(int r, int c) { const int st = (r >> 4) * 2 + (c >> 5), rr = r & 15, cc = c & 31, ob = rr * 64 + cc * 2; return st * 1024 + (ob ^ (((ob >> 9) & 1) << 5)); }
__host__ __device__ __forceinline__ void stage_rc(int b, int& R, int& C) { const int st = b / 1024, sb = b % 1024, swz = sb ^ (((sb >> 9) & 1) << 5); R = (st >> 1) * 16 + swz / 64; C = (st & 1) * 32 + (swz % 64) / 2; }
__host__ __device__ __forceinline__ int perm32(int rho) { const int n = rho >> 4, i = rho & 15; return 8 * (i >> 2) + 4 * n + (i & 3); }

struct Unit { int pm, pn, kq; };
struct Gemm { const bf16_t* A; const bf16_t* Bt; int lda; int K; int hshift; };

struct StaticOrder {
    int nM, nN, nwg, G, c, wgm;
    __host__ __device__ void init(int nM_, int nN_, int G_, int c_, int wgm_ = 4) { nM = nM_; nN = nN_; nwg = nM * nN; G = G_; c = c_; wgm = wgm_; }
    __host__ __device__ bool next(int i, Unit& u) const {
        const long L = (long)i * G + c; if (L >= nwg) return false;
        int wgid = (int)L; { const int q = nwg / NXCD, r = nwg % NXCD, xcd = wgid % NXCD, off = wgid / NXCD; wgid = (xcd < r ? xcd * (q + 1) : r * (q + 1) + (xcd - r) * q) + off; }
        const int nig = wgm * nN, gid = wgid / nig, fm = gid * wgm, gsz = (nM - fm) < wgm ? (nM - fm) : wgm;
        u.pm = fm + ((wgid % nig) % gsz); u.pn = (wgid % nig) / gsz; u.kq = -1; return true;
    }
    __device__ __forceinline__ void a_ready(const Unit&) const {}
    __device__ __forceinline__ void done(const Unit&) const {}
};

struct SplitTailOrder {
    StaticOrder base; int nMf, nN, ntail, G, c;
    __host__ __device__ void init(int nMf_, int nN_, int ntail_, int G_, int c_, int wgm_ = 4) { nMf = nMf_; nN = nN_; ntail = ntail_; G = G_; c = c_; base.init(nMf_, nN_, G_, c_, wgm_); }
    __host__ __device__ bool next(int i, Unit& u) const {
        const long L = (long)i * G + c; const int nfull = nMf * nN;
        if (L < nfull) return base.next(i, u);
        const int x = (int)(L - nfull); if (x >= ntail * nN * 4) return false;
        u.pm = nMf + x / (nN * 4); u.pn = (x >> 2) % nN; u.kq = x & 3; return true;
    }
    __device__ __forceinline__ void a_ready(const Unit&) const {}
    __device__ __forceinline__ void done(const Unit&) const {}
};
__device__ __forceinline__ u32x4 xw_a(const u32x4 w0, const u32x4 w1) { u32x4 r;
    r.x = (unsigned)__builtin_amdgcn_update_dpp((int)w0.x, (int)w1.x, 0x128, 0xf, 0xc, false); r.y = (unsigned)__builtin_amdgcn_update_dpp((int)w0.y, (int)w1.y, 0x128, 0xf, 0xc, false);
    r.z = (unsigned)__builtin_amdgcn_update_dpp((int)w0.z, (int)w1.z, 0x128, 0xf, 0xc, false); r.w = (unsigned)__builtin_amdgcn_update_dpp((int)w0.w, (int)w1.w, 0x128, 0xf, 0xc, false); return r; }
__device__ __forceinline__ u32x4 xw_b(const u32x4 w0, const u32x4 w1) { u32x4 r;
    r.x = (unsigned)__builtin_amdgcn_update_dpp((int)w1.x, (int)w0.x, 0x128, 0xf, 0x3, false); r.y = (unsigned)__builtin_amdgcn_update_dpp((int)w1.y, (int)w0.y, 0x128, 0xf, 0x3, false);
    r.z = (unsigned)__builtin_amdgcn_update_dpp((int)w1.z, (int)w0.z, 0x128, 0xf, 0x3, false); r.w = (unsigned)__builtin_amdgcn_update_dpp((int)w1.w, (int)w0.w, 0x128, 0xf, 0x3, false); return r; }
__device__ __forceinline__ unsigned cvt_pk_bf16(float lo, float hi) { unsigned r; asm volatile("v_cvt_pk_bf16_f32 %0, %1, %2" : "=v"(r) : "v"(lo), "v"(hi)); return r; }

template <class Epi, class Sched, bool ALIGN_EPI = false, bool SP2 = false, bool SPLITK = false>
__device__ __forceinline__ void gemm_phase(PG8_LAS unsigned char* lds, const Gemm g, const Sched& S, const Epi& E, const int tid_in) {
    int tid_ = tid_in; asm volatile("" : "+v"(tid_));
    const int tid = tid_, wid = __builtin_amdgcn_readfirstlane(tid >> 6), lane = tid & 63, wr = wid >> 2, wc = wid & 3, fr = lane & 15, fq = lane >> 4;
    const int K = g.K, nt = K / BK, lda = g.lda;
    unsigned voffA[2], voffB[2];
#pragma unroll
    for (int i = 0; i < 2; ++i) { int R, C; stage_rc(tid * 16 + i * 8192, R, C); const int Rb = Epi::PERM ? (64 * (R >> 5) + perm32(R & 31)) : R;
        voffA[i] = (unsigned)(R * lda + C) * 2u; voffB[i] = (unsigned)(Rb * K + C) * 2u; }
    const size_t kstep = (size_t)(BK * 2);
    const size_t hstepA = (size_t)HALF * lda * 2, hstepB = (size_t)(Epi::PERM ? 32 : HALF) * K * 2;
    const unsigned ldsw = (unsigned)wid * 1024u;
    const int aoff = lds_byte(wr * 64 + fr, fq * 8), boff = lds_byte(wc * 32 + fr, fq * 8);
#define PG8_KOFF(u) ((SPLITK && (u).kq > 0) ? (size_t)(u).kq * (size_t)(K / 4) * 2 : (size_t)0)
#define PG8_ABASE(u) ((const char*)g.A + ((size_t)(u).pm * 256 * lda + (g.hshift >= 0 ? (size_t)((u).pn >> g.hshift) * 512 : (size_t)0)) * 2 + PG8_KOFF(u))
#define PG8_BBASE(u) ((const char*)g.Bt + (size_t)(u).pn * 256 * K * 2 + PG8_KOFF(u))
#define PG8_SA(b, h) (((b) * 2 + (h)) * HTB)
#define PG8_SB(b, h) ((4 + (b) * 2 + (h)) * HTB)
#define PG8_STAGE(bufoff, gbase, voff) do { _Pragma("unroll") for (int _i = 0; _i < 2; ++_i) \
        __builtin_amdgcn_global_load_lds((const unsigned*)((const char*)(gbase) + (voff)[_i]), (PG8_LAS unsigned*)(lds + (bufoff) + ldsw + _i * 8192), 16, 0, 0); } while (0)
#define PG8_LDA(dst, b, h) do { _Pragma("unroll") for (int m = 0; m < 4; ++m) _Pragma("unroll") for (int k = 0; k < 2; ++k) dst[m][k] = *(const PG8_LAS bf16x8*)(lds + PG8_SA(b, h) + aoff + m * 2048 + k * 1024); } while (0)
#define PG8_LDB(dst, b, h) do { _Pragma("unroll") for (int n = 0; n < 2; ++n) _Pragma("unroll") for (int k = 0; k < 2; ++k) dst[n][k] = *(const PG8_LAS bf16x8*)(lds + PG8_SB(b, h) + boff + n * 2048 + k * 1024); } while (0)
#define PG8_MMA(ai, bj, At, Bt) do { __builtin_amdgcn_s_setprio(1); _Pragma("unroll") for (int m = 0; m < 4; ++m) _Pragma("unroll") for (int n = 0; n < 2; ++n) _Pragma("unroll") for (int k = 0; k < 2; ++k) \
        acc[ai][bj][m][n] = __builtin_amdgcn_mfma_f32_16x16x32_bf16(Bt[n][k], At[m][k], acc[ai][bj][m][n], 0, 0, 0); __builtin_amdgcn_s_setprio(0); } while (0)
#define PG8_WAIT_V(n) asm volatile("s_waitcnt vmcnt(" #n ")" ::: "memory")
#define PG8_WAIT_L(n) asm volatile("s_waitcnt lgkmcnt(" #n ")" ::: "memory")
#define PG8_BAR __builtin_amdgcn_s_barrier()
#define PG8_SCHED __builtin_amdgcn_sched_barrier(0)
    Unit cur, nxt; int ui = 0;
    if (!S.next(0, cur)) return;
    int ntc = (SPLITK && cur.kq >= 0) ? nt / 4 : nt;
    f32x4 acc[2][2][4][2];
#pragma unroll
    for (int a = 0; a < 2; ++a)
#pragma unroll
        for (int b = 0; b < 2; ++b)
#pragma unroll
            for (int m = 0; m < 4; ++m)
#pragma unroll
                for (int n = 0; n < 2; ++n) acc[a][b][m][n] = (f32x4){0.f, 0.f, 0.f, 0.f};
    bf16x8 At[4][2], B0[2][2], B1[2][2];
    const char* cA = PG8_ABASE(cur); const char* cB = PG8_BBASE(cur);
    S.a_ready(cur);
    if constexpr (SP2) {
        PG8_STAGE(PG8_SB(0, 0), cB, voffB); PG8_STAGE(PG8_SB(0, 1), cB + hstepB, voffB); PG8_STAGE(PG8_SA(0, 0), cA, voffA); PG8_STAGE(PG8_SA(0, 1), cA + hstepA, voffA);
        if (wr == 1) PG8_BAR;
        PG8_WAIT_V(2); PG8_BAR;
        PG8_STAGE(PG8_SB(1, 0), cB + kstep, voffB); PG8_STAGE(PG8_SA(1, 0), cA + kstep, voffA); PG8_STAGE(PG8_SB(1, 1), cB + hstepB + kstep, voffB);
        PG8_WAIT_V(6); PG8_BAR;
    } else {
        PG8_STAGE(PG8_SB(0, 0), cB, voffB); PG8_STAGE(PG8_SA(0, 0), cA, voffA); PG8_STAGE(PG8_SB(0, 1), cB + hstepB, voffB); PG8_STAGE(PG8_SA(0, 1), cA + hstepA, voffA);
        if (wr == 1) PG8_BAR;
        PG8_WAIT_V(4); PG8_BAR;
        PG8_STAGE(PG8_SB(1, 0), cB + kstep, voffB); PG8_STAGE(PG8_SA(1, 0), cA + kstep, voffA); PG8_STAGE(PG8_SB(1, 1), cB + hstepB + kstep, voffB);
        PG8_WAIT_V(6); PG8_BAR;
    }
    for (;;) {
        const bool has_next = S.next(ui + 1, nxt);
        const char* nA = has_next ? PG8_ABASE(nxt) : cA; const char* nB = has_next ? PG8_BBASE(nxt) : cB;
        for (int t = 0; t < ntc; t += 2) {
            const bool last = (t == ntc - 2);
            const char* a1 = cA + (size_t)(t + 1) * kstep;
            const char* a2 = last ? nA : cA + (size_t)(t + 2) * kstep; const char* b2 = last ? nB : cB + (size_t)(t + 2) * kstep;
            const char* a3 = a2 + kstep; const char* b3 = b2 + kstep;
            if (last && has_next) S.a_ready(nxt);
            if constexpr (SP2) {
            PG8_LDB(B0, 0, 0); PG8_LDB(B1, 0, 1); PG8_SCHED; PG8_LDA(At, 0, 0); PG8_STAGE(PG8_SA(1, 1), a1 + hstepA, voffA);
            PG8_WAIT_V(8); PG8_WAIT_L(0); PG8_BAR; PG8_MMA(0, 0, At, B0); PG8_MMA(0, 1, At, B1); PG8_BAR; PG8_SCHED;
            PG8_LDA(At, 0, 1); PG8_STAGE(PG8_SB(0, 0), b2, voffB); PG8_STAGE(PG8_SB(0, 1), b2 + hstepB, voffB); PG8_STAGE(PG8_SA(0, 0), a2, voffA);
            PG8_WAIT_V(8); PG8_WAIT_L(0); PG8_BAR; PG8_MMA(1, 0, At, B0); PG8_MMA(1, 1, At, B1); PG8_BAR; PG8_SCHED;
            PG8_LDB(B0, 1, 0); PG8_LDB(B1, 1, 1); PG8_SCHED; PG8_LDA(At, 1, 0); PG8_STAGE(PG8_SA(0, 1), a2 + hstepA, voffA);
            PG8_WAIT_V(8); PG8_WAIT_L(0); PG8_BAR; PG8_MMA(0, 0, At, B0); PG8_MMA(0, 1, At, B1); PG8_BAR; PG8_SCHED;
            PG8_LDA(At, 1, 1); PG8_STAGE(PG8_SB(1, 0), b3, voffB); PG8_STAGE(PG8_SB(1, 1), b3 + hstepB, voffB); PG8_STAGE(PG8_SA(1, 0), a3, voffA);
            PG8_WAIT_V(8); PG8_WAIT_L(0); PG8_BAR; PG8_MMA(1, 0, At, B0); PG8_MMA(1, 1, At, B1); PG8_BAR; PG8_SCHED;
            } else {
            PG8_LDB(B0, 0, 0); PG8_SCHED; PG8_LDA(At, 0, 0); PG8_STAGE(PG8_SA(1, 1), a1 + hstepA, voffA);
            PG8_WAIT_L(8); PG8_BAR; PG8_WAIT_L(0); PG8_MMA(0, 0, At, B0); PG8_BAR; PG8_SCHED;
            PG8_LDB(B1, 0, 1); PG8_STAGE(PG8_SB(0, 0), b2, voffB);
            PG8_BAR; PG8_WAIT_L(0); PG8_MMA(0, 1, At, B1); PG8_BAR;
            PG8_LDA(At, 0, 1); PG8_STAGE(PG8_SA(0, 0), a2, voffA);
            PG8_BAR; PG8_WAIT_L(0); PG8_MMA(1, 0, At, B0); PG8_BAR; PG8_SCHED;
            PG8_STAGE(PG8_SB(0, 1), b2 + hstepB, voffB);
            PG8_WAIT_V(6); PG8_BAR; PG8_MMA(1, 1, At, B1); PG8_BAR;
            PG8_LDB(B0, 1, 0); PG8_SCHED; PG8_LDA(At, 1, 0); PG8_STAGE(PG8_SA(0, 1), a2 + hstepA, voffA);
            PG8_WAIT_L(8); PG8_BAR; PG8_WAIT_L(0); PG8_MMA(0, 0, At, B0); PG8_BAR; PG8_SCHED;
            PG8_LDB(B1, 1, 1); PG8_STAGE(PG8_SB(1, 0), b3, voffB);
            PG8_BAR; PG8_WAIT_L(0); PG8_MMA(0, 1, At, B1); PG8_BAR;
            PG8_LDA(At, 1, 1); PG8_STAGE(PG8_SA(1, 0), a3, voffA);
            PG8_BAR; PG8_WAIT_L(0); PG8_MMA(1, 0, At, B0); PG8_BAR; PG8_SCHED;
            PG8_STAGE(PG8_SB(1, 1), b3 + hstepB, voffB);
            PG8_WAIT_V(6); PG8_BAR; PG8_MMA(1, 1, At, B1); PG8_BAR;
            }
        }
        if constexpr (ALIGN_EPI) { if (wr == 0) PG8_BAR; }
        E(acc, cur, wr, wc, fr, fq); S.done(cur);
        if (!has_next) break;
#pragma unroll
        for (int a = 0; a < 2; ++a)
#pragma unroll
            for (int b = 0; b < 2; ++b)
#pragma unroll
                for (int m = 0; m < 4; ++m)
#pragma unroll
                    for (int n = 0; n < 2; ++n) acc[a][b][m][n] = (f32x4){0.f, 0.f, 0.f, 0.f};
        cur = nxt; cA = nA; cB = nB; ++ui; ntc = (SPLITK && cur.kq >= 0) ? nt / 4 : nt;
        if constexpr (ALIGN_EPI) { if (wr == 1) PG8_BAR; }
    }
    PG8_WAIT_V(0);
    if constexpr (!ALIGN_EPI) { if (wr == 0) PG8_BAR; }
    PG8_BAR;
#undef PG8_KOFF
#undef PG8_ABASE
#undef PG8_BBASE
#undef PG8_SA
#undef PG8_SB
#undef PG8_STAGE
#undef PG8_LDA
#undef PG8_LDB
#undef PG8_MMA
#undef PG8_WAIT_V
#undef PG8_WAIT_L
#undef PG8_BAR
#undef PG8_SCHED
}
}

#ifndef WGM_OUT
#define WGM_OUT 2
#endif
#ifndef WGM_HEAD
#define WGM_HEAD 4
#endif
#define PG8_SP2 true
#define PG8_ALIGN true

constexpr int DM = 2048;
constexpr int NB_P = 4, T_P = 8192, NB_S = 32, T_S = 16;
constexpr int M_P = NB_P * T_P, M_S = NB_S * T_S, M = M_P + M_S;
constexpr int NSTREAM = NB_P + NB_S;
constexpr int NPANEL = M / 256;
constexpr int SSD_INNER = 4096, SSD_HD = 64, SSD_NH = 64, SSD_NG = 8, SSD_DS = 128, SSD_CONVD = 6144, SSD_PROJ = 10304, SSD_NPAD = 10496;
constexpr int ML_INNER = 4096, ML_NH = 8, ML_HD = 512, ML_PROJ = 12304, ML_NPAD = 12544;
constexpr float DN_ALPHA = 1.6817928305074290f;
constexpr float LN_EPS = 1e-5f, RMS_EPS = 1e-6f;
constexpr float ML_QSCALE = 0.04419417382415922f;

constexpr size_t O_YP = 0;
constexpr size_t O_YS = O_YP + (size_t)M_P * DM;
constexpr size_t O_P_SCONV = O_YS + (size_t)M_S * DM;
constexpr size_t O_P_SH = O_P_SCONV + (size_t)2 * NB_P * 3 * SSD_CONVD;
constexpr size_t O_P_MCONV = O_P_SH + (size_t)2 * NB_P * SSD_NH * SSD_HD * SSD_DS;
constexpr size_t O_P_MC = O_P_MCONV + (size_t)2 * NB_P * 3 * ML_INNER;
constexpr size_t O_P_MN = O_P_MC + (size_t)2 * NB_P * ML_NH * ML_HD * ML_HD;
constexpr size_t O_P_MM = O_P_MN + (size_t)2 * NB_P * ML_NH * ML_HD;
constexpr size_t O_S_SCONV = O_P_MM + (size_t)2 * NB_P * ML_NH;
constexpr size_t O_S_SH = O_S_SCONV + (size_t)2 * NB_S * 3 * SSD_CONVD;
constexpr size_t O_S_MCONV = O_S_SH + (size_t)2 * NB_S * SSD_NH * SSD_HD * SSD_DS;
constexpr size_t O_S_MC = O_S_MCONV + (size_t)2 * NB_S * 3 * ML_INNER;
constexpr size_t O_S_MN = O_S_MC + (size_t)2 * NB_S * ML_NH * ML_HD * ML_HD;
constexpr size_t O_S_MM = O_S_MN + (size_t)2 * NB_S * ML_NH * ML_HD;
constexpr size_t O_END = O_S_MM + (size_t)2 * NB_S * ML_NH;

constexpr size_t MiB = 1u << 20;
constexpr size_t WS_CTL = 0, CTL_ZERO_BYTES = 1 * MiB;
constexpr size_t WS_WSSD_IN = 1 * MiB;
constexpr size_t WS_WSSD_OUT = 83 * MiB;
constexpr size_t WS_WML_IN = 115 * MiB;
constexpr size_t WS_WML_QK = 213 * MiB;
constexpr size_t WS_WML_V = 229 * MiB;
constexpr size_t WS_WML_OUT = 237 * MiB;
constexpr size_t WS_XB = 269 * MiB;
constexpr size_t WS_ACT = 399 * MiB;
constexpr size_t ACT_U = (size_t)M * 4096 * 2;
static_assert(ACT_U == 260 * MiB, "unit");
constexpr size_t WS_S_XBCC = WS_ACT + 920 * MiB;
constexpr size_t WS_S_Z = WS_ACT, WS_S_XBC = WS_ACT + 260 * MiB, WS_S_Y = WS_ACT + 650 * MiB, WS_S_DT = WS_ACT + 910 * MiB, WS_S_VPRE = WS_S_XBC;
constexpr size_t WS_M_XM = WS_ACT, WS_M_Q = WS_ACT, WS_M_YG = WS_ACT, WS_M_Z = WS_ACT + 260 * MiB, WS_M_O = WS_ACT + 520 * MiB, WS_M_XC = WS_ACT + 780 * MiB,
                 WS_M_K = WS_ACT + 1040 * MiB, WS_M_VPRE = WS_M_K, WS_M_V = WS_ACT + 1300 * MiB, WS_M_H = WS_M_V, WS_M_GATES = WS_ACT + 1560 * MiB;
constexpr size_t WS_M_S = WS_ACT + 1564 * MiB, WS_M_TOK = WS_ACT + 1600 * MiB, WS_M_CHK = WS_ACT + 1605 * MiB, WS_M_CHP = WS_M_CHK + 512 * 1024;
constexpr size_t WS_END = WS_ACT + 1606 * MiB;
constexpr int ML_NCHUNK = 512 + NB_S;
constexpr int CW_BAR = 4096;

constexpr int NWAVES = 8;
constexpr int ST64 = 144, ST128 = 272;
constexpr int SX_OFF = 0, SXS_OFF = 9216, SB_OFF = 18432, SC_OFF = 35840, SH_OFF = 53248, SW_OFF = 70656, SS_OFF = 79872;
constexpr int RING_BYTES = 131072;
constexpr int LDS_BYTES = 163840;
constexpr int MISC_OFF = LDS_BYTES - 256;
constexpr int STK = 288, STV = 160, MQ_K = 17408, MQ_BUF = 35840, MV_IMG = 10240;
constexpr int MS_OFF = 71680, MV_OFF = 80896, MVT_OFF = 91136, MP_OFF = 111616, MSC_OFF = 128000, MN_OFF = 130048, MNP_OFF = 132096, MQN_OFF = 133120, MNB_OFF = 133376, MTB_OFF = 134400, MDEC_OFF = 135168, MI_OFF = 135424;

#define GAS __attribute__((address_space(1)))
#define LAS __attribute__((address_space(3)))
typedef unsigned short bf16;
typedef unsigned v4u __attribute__((ext_vector_type(4)));
typedef unsigned v2u __attribute__((ext_vector_type(2)));
typedef float f32x4 __attribute__((ext_vector_type(4)));
#define LDS_WAIT() asm volatile("s_waitcnt lgkmcnt(0)" ::: "memory")
#define VM_WAIT() asm volatile("s_waitcnt vmcnt(0)" ::: "memory")
typedef __bf16 bf16x2n __attribute__((ext_vector_type(2)));
__device__ __forceinline__ unsigned f2bf(float f) { return (unsigned)__builtin_bit_cast(unsigned short, (__bf16)f); }
__device__ __forceinline__ unsigned pk2(float lo, float hi) { bf16x2n v; v[0] = (__bf16)lo; v[1] = (__bf16)hi; return __builtin_bit_cast(unsigned, v); }
__device__ __forceinline__ float bf2f(unsigned b) { return __builtin_bit_cast(float, b << 16); }
__device__ __forceinline__ float bflo(unsigned w) { return __builtin_bit_cast(float, w << 16); }
__device__ __forceinline__ float bfhi(unsigned w) { return __builtin_bit_cast(float, w & 0xffff0000u); }
__device__ __forceinline__ float silu_f(float x) { return x * __builtin_amdgcn_rcpf(1.f + __expf(-x)); }
__device__ __forceinline__ float sigmoid_f(float x) { return __builtin_amdgcn_rcpf(1.f + __expf(-x)); }
__device__ __forceinline__ float softplus_f(float x) { return fmaxf(x, 0.f) + __logf(1.f + __expf(-fabsf(x))); }
__device__ __forceinline__ float logsigmoid_f(float x) { return fminf(x, 0.f) - __logf(1.f + __expf(-fabsf(x))); }
#define RDLANE(v, l) __builtin_bit_cast(float, __builtin_amdgcn_readlane(__builtin_bit_cast(int, (float)(v)), (l)))
#define BPERM(v, srclane) __builtin_bit_cast(float, __builtin_amdgcn_ds_bpermute((srclane) << 2, __builtin_bit_cast(int, (float)(v))))
#define DPPF(oldv, srcv, ctrl, rmask) __builtin_bit_cast(float, __builtin_amdgcn_update_dpp(__builtin_bit_cast(int, (float)(oldv)), __builtin_bit_cast(int, (float)(srcv)), (ctrl), (rmask), 0xf, false))
__device__ __forceinline__ float wave_scan_add(float v) {
    v += DPPF(0.f, v, 0x111, 0xf); v += DPPF(0.f, v, 0x112, 0xf); v += DPPF(0.f, v, 0x114, 0xf); v += DPPF(0.f, v, 0x118, 0xf);
    v += DPPF(0.f, v, 0x142, 0xa); v += DPPF(0.f, v, 0x143, 0xc);
    return v;
}
__device__ __forceinline__ float wave_scan_max(float v) {
    const float ni = -3.0e38f;
    v = fmaxf(v, DPPF(ni, v, 0x111, 0xf)); v = fmaxf(v, DPPF(ni, v, 0x112, 0xf)); v = fmaxf(v, DPPF(ni, v, 0x114, 0xf)); v = fmaxf(v, DPPF(ni, v, 0x118, 0xf));
    v = fmaxf(v, DPPF(ni, v, 0x142, 0xa)); v = fmaxf(v, DPPF(ni, v, 0x143, 0xc));
    return v;
}
__device__ __forceinline__ float wave_sum(float v) { return __builtin_bit_cast(float, __builtin_amdgcn_readlane(__builtin_bit_cast(int, wave_scan_add(v)), 63)); }

#define XB_TMO      128
#define XB_XCNT(j)  (256  + 64 * (j))
#define XB_XSUB(j)  (1280 + 64 * (j))
#define XB_XGEN(j)  (2304 + 64 * (j))
#define XB_TOP      3328
#define XB_TOPGEN   3392
#define XCD_BAR_WORDS 3456
#define XB_SPIN_CAP (1u << 21)

__device__ __forceinline__ unsigned xb_ld(unsigned* p)              { return __hip_atomic_load(p, __ATOMIC_RELAXED, __HIP_MEMORY_SCOPE_AGENT); }
__device__ __forceinline__ unsigned xb_add(unsigned* p, unsigned v) { return __hip_atomic_fetch_add(p, v, __ATOMIC_RELAXED, __HIP_MEMORY_SCOPE_AGENT); }
__device__ __forceinline__ unsigned xb_xcc_id() { return (unsigned)__builtin_amdgcn_s_getreg((3 << 11) | 20) & 0xFu; }
#define XB_SPIN(cond, bar) do { unsigned _sp = 0; while (cond) { __builtin_amdgcn_s_sleep(1); \
    if ((++_sp & 255u) == 0u) { if (xb_ld(&(bar)[XB_TMO])) break; if (_sp > XB_SPIN_CAP) { atomicAdd(&(bar)[XB_TMO], 1u); break; } } } } while (0)

struct XcdBarrier {
    unsigned* bar; unsigned x;
    volatile LAS unsigned* st;
};
__device__ __forceinline__ XcdBarrier xcd_barrier_post(unsigned* bar, volatile LAS unsigned* st) {
    XcdBarrier b; b.bar = bar; b.x = xb_xcc_id(); b.st = st;
    if (threadIdx.x == 0) (void)xb_add(&bar[XB_XCNT(b.x)], 1u);
    return b;
}
__device__ __forceinline__ void xcd_barrier_complete(unsigned* bar, unsigned x, unsigned& nloc, unsigned& nx) {
    const unsigned G = gridDim.x * gridDim.y * gridDim.z;
    unsigned sum, cnt, mine, sp = 0u;
    for (;;) {
        sum = 0u; cnt = 0u; mine = 0u;
#pragma unroll
        for (unsigned j = 0; j < 16; ++j) { const unsigned c = xb_ld(&bar[XB_XCNT(j)]); sum += c; cnt += (c > 0u) ? 1u : 0u; mine = (j == x) ? c : mine; }
        if (sum == G) break;
        __builtin_amdgcn_s_sleep(1);
        if ((++sp & 255u) == 0u) { if (xb_ld(&bar[XB_TMO])) break; if (sp > XB_SPIN_CAP) { atomicAdd(&bar[XB_TMO], 1u); break; } }
    }
    nloc = mine > 0u ? mine : 1u; nx = cnt > 0u ? cnt : 1u;
}
__device__ __forceinline__ void xcd_barrier(const XcdBarrier& b, const bool leader) {
    asm volatile("s_waitcnt vmcnt(0)" ::: "memory");
    __syncthreads();
    if (leader) {
        size_t bo_ = 0; asm volatile("" : "+s"(bo_)); unsigned* bar = b.bar + bo_;
        __builtin_amdgcn_s_waitcnt(0);
        unsigned nloc = b.st[0], nx = b.st[1];
        if (nloc == 0u) { xcd_barrier_complete(bar, b.x, nloc, nx); b.st[0] = nloc; b.st[1] = nx; }
        const unsigned old = xb_add(&bar[XB_XSUB(b.x)], 1u);
        const unsigned gen = old / nloc;
        if (old + 1u == (gen + 1u) * nloc) {
            __builtin_amdgcn_fence(__ATOMIC_RELEASE, "agent");
            asm volatile("s_waitcnt vmcnt(0)" ::: "memory");
            const unsigned og = xb_add(&bar[XB_TOP], 1u);
            const unsigned tg = og / nx;
            if (og + 1u == (tg + 1u) * nx) xb_add(&bar[XB_TOPGEN], 1u);
            else XB_SPIN(xb_ld(&bar[XB_TOPGEN]) == tg, bar);
            __builtin_amdgcn_fence(__ATOMIC_ACQUIRE, "agent");
            xb_add(&bar[XB_XGEN(b.x)], 1u);
            asm volatile("s_waitcnt vmcnt(0)" ::: "memory");
        } else {
            XB_SPIN(xb_ld(&bar[XB_XGEN(b.x)]) == gen, bar);
            __builtin_amdgcn_fence(__ATOMIC_ACQUIRE, "agent");
            asm volatile("s_waitcnt vmcnt(0)" ::: "memory");
        }
    }
    __syncthreads();
}

using pg8::Unit; using pg8::u32x4; using pg8::cvt_pk_bf16; using pg8::xw_a; using pg8::xw_b;
struct EpiSsdIn {
    static constexpr bool PERM = true, AFTER_DRAIN = false;
    bf16* Z; bf16* XBC; float* DT;
    __device__ __forceinline__ void operator()(const f32x4 (&acc)[2][2][4][2], const Unit& u, int wr, int wc, int fr, int fq) const {
        if (u.pn < 40) {
            bf16* base; int ldc, colt;
            if (u.pn < 16) { base = Z; ldc = 4096; colt = u.pn * 256; } else { base = XBC; ldc = 6144; colt = (u.pn - 16) * 256; }
            const int rowx = u.pm * 256 + wr * 64 + (fr & 7), colx = colt + wc * 64 + 8 * fq + 32 * (fr >> 3);
#pragma unroll
            for (int ai = 0; ai < 2; ++ai)
#pragma unroll
                for (int m = 0; m < 4; ++m) { bf16* rowp = base + (size_t)(rowx + ai * 128 + m * 16) * ldc + colx; u32x4 w[2];
#pragma unroll
                    for (int bj = 0; bj < 2; ++bj) { const f32x4 v0 = acc[ai][bj][m][0], v1 = acc[ai][bj][m][1];
                        w[bj].x = cvt_pk_bf16(v0[0], v0[1]); w[bj].y = cvt_pk_bf16(v0[2], v0[3]); w[bj].z = cvt_pk_bf16(v1[0], v1[1]); w[bj].w = cvt_pk_bf16(v1[2], v1[3]); }
                    *(u32x4*)(rowp) = xw_a(w[0], w[1]); *(u32x4*)(rowp + (size_t)8 * ldc) = xw_b(w[0], w[1]); }
        } else if (wc == 0) {
            const int row0 = u.pm * 256 + wr * 64 + fr;
#pragma unroll
            for (int ai = 0; ai < 2; ++ai)
#pragma unroll
                for (int m = 0; m < 4; ++m) { float* rowp = DT + (size_t)(row0 + ai * 128 + m * 16) * 64 + 8 * fq;
#pragma unroll
                    for (int bj = 0; bj < 2; ++bj) { *(f32x4*)(rowp + 32 * bj) = acc[ai][bj][m][0]; *(f32x4*)(rowp + 32 * bj + 4) = acc[ai][bj][m][1]; } }
        }
    }
};
struct EpiMlIn {
    static constexpr bool PERM = true, AFTER_DRAIN = false;
    bf16* XM; size_t tstride; float* GATES;
    __device__ __forceinline__ void operator()(const f32x4 (&acc)[2][2][4][2], const Unit& u, int wr, int wc, int fr, int fq) const {
        const int row0 = u.pm * 256 + wr * 64 + fr;
        if (u.pn < 48) {
            bf16* base = XM + (size_t)(u.pn >> 4) * tstride;
            const int rowx = u.pm * 256 + wr * 64 + (fr & 7), colx = (u.pn & 15) * 256 + wc * 64 + 8 * fq + 32 * (fr >> 3);
#pragma unroll
            for (int ai = 0; ai < 2; ++ai)
#pragma unroll
                for (int m = 0; m < 4; ++m) { bf16* rowp = base + (size_t)(rowx + ai * 128 + m * 16) * 4096 + colx; u32x4 w[2];
#pragma unroll
                    for (int bj = 0; bj < 2; ++bj) { const f32x4 v0 = acc[ai][bj][m][0], v1 = acc[ai][bj][m][1];
                        w[bj].x = cvt_pk_bf16(v0[0], v0[1]); w[bj].y = cvt_pk_bf16(v0[2], v0[3]); w[bj].z = cvt_pk_bf16(v1[0], v1[1]); w[bj].w = cvt_pk_bf16(v1[2], v1[3]); }
                    *(u32x4*)(rowp) = xw_a(w[0], w[1]); *(u32x4*)(rowp + 8 * 4096) = xw_b(w[0], w[1]); }
        } else if (wc == 0 && fq < 2) {
#pragma unroll
            for (int ai = 0; ai < 2; ++ai)
#pragma unroll
                for (int m = 0; m < 4; ++m) { float* rowp = GATES + (size_t)(row0 + ai * 128 + m * 16) * 16 + 8 * fq;
                    *(f32x4*)(rowp) = acc[ai][0][m][0]; *(f32x4*)(rowp + 4) = acc[ai][0][m][1]; }
        }
    }
};
template <int MODE> struct EpiHead {
    static constexpr bool PERM = true, AFTER_DRAIN = false;
    bf16* O0; bf16* O1; float scale0;
    __device__ __forceinline__ void operator()(const f32x4 (&acc)[2][2][4][2], const Unit& u, int wr, int wc, int fr, int fq) const {
        bf16* base; int colt; float sc = 1.f;
        if (MODE == 0) { base = O0; colt = u.pn * 256; }
        else { const int head = u.pn >> 2, sub = u.pn & 3; if (sub < 2) { base = O0; colt = head * 512 + sub * 256; sc = scale0; } else { base = O1; colt = head * 512 + (sub - 2) * 256; } }
        const int rowx = u.pm * 256 + wr * 64 + (fr & 7), colx = colt + wc * 64 + 8 * fq + 32 * (fr >> 3);
#pragma unroll
        for (int ai = 0; ai < 2; ++ai)
#pragma unroll
            for (int m = 0; m < 4; ++m) { bf16* rowp = base + (size_t)(rowx + ai * 128 + m * 16) * 4096 + colx; u32x4 w[2];
#pragma unroll
                for (int bj = 0; bj < 2; ++bj) { const f32x4 v0 = acc[ai][bj][m][0] * sc, v1 = acc[ai][bj][m][1] * sc;
                    w[bj].x = cvt_pk_bf16(v0[0], v0[1]); w[bj].y = cvt_pk_bf16(v0[2], v0[3]); w[bj].z = cvt_pk_bf16(v1[0], v1[1]); w[bj].w = cvt_pk_bf16(v1[2], v1[3]); }
                *(u32x4*)(rowp) = xw_a(w[0], w[1]); *(u32x4*)(rowp + 8 * 4096) = xw_b(w[0], w[1]); }
    }
};
struct EpiResid {
    static constexpr bool PERM = true, AFTER_DRAIN = false;
    const bf16* XB; bf16* V; float alpha; float* SLAB;
    __device__ __forceinline__ void operator()(const f32x4 (&acc)[2][2][4][2], const Unit& u, int wr, int wc, int fr, int fq) const {
        const int row0 = u.pm * 256 + wr * 64 + fr, col0 = u.pn * 256 + wc * 64 + 8 * fq;
        if (u.kq >= 0) {
#pragma unroll
            for (int ai = 0; ai < 2; ++ai)
#pragma unroll
                for (int m = 0; m < 4; ++m) { float* sp = SLAB + ((size_t)u.kq * M_S + (row0 + ai * 128 + m * 16 - M_P)) * DM + col0;
#pragma unroll
                    for (int bj = 0; bj < 2; ++bj) { *(f32x4*)(sp + bj * 32) = acc[ai][bj][m][0]; *(f32x4*)(sp + bj * 32 + 4) = acc[ai][bj][m][1]; } }
            return;
        }
#pragma unroll
        for (int ai = 0; ai < 2; ++ai)
#pragma unroll
            for (int m = 0; m < 4; ++m) { const size_t off = (size_t)(row0 + ai * 128 + m * 16) * DM + col0; u32x4 w[2];
#pragma unroll
                for (int bj = 0; bj < 2; ++bj) { const v4u xw = *(const v4u*)(XB + off + bj * 32); const f32x4 v0 = acc[ai][bj][m][0], v1 = acc[ai][bj][m][1];
                    w[bj].x = cvt_pk_bf16(alpha * bflo(xw.x) + v0[0], alpha * bfhi(xw.x) + v0[1]); w[bj].y = cvt_pk_bf16(alpha * bflo(xw.y) + v0[2], alpha * bfhi(xw.y) + v0[3]);
                    w[bj].z = cvt_pk_bf16(alpha * bflo(xw.z) + v1[0], alpha * bfhi(xw.z) + v1[1]); w[bj].w = cvt_pk_bf16(alpha * bflo(xw.w) + v1[2], alpha * bfhi(xw.w) + v1[3]); }
                bf16* vp = V + (size_t)(u.pm * 256 + wr * 64 + (fr & 7) + ai * 128 + m * 16) * DM + col0 + 32 * (fr >> 3);
                *(u32x4*)(vp) = xw_a(w[0], w[1]); *(u32x4*)(vp + 8 * DM) = xw_b(w[0], w[1]); }
    }
};

__device__ __forceinline__ void transpose_item(const float* W, int ldw, int nvalid, int K, bf16* WT, int kb, int nb, LAS float* scr, int lane) {
    const int k0 = 64 * kb, n0 = 32 * nb;
    const int n4 = (lane & 7) * 4, nn = n0 + n4;
    f32x4 wv[8];
#pragma unroll
    for (int i = 0; i < 8; ++i) { const int kk = (lane >> 3) + 8 * i; wv[i] = nn < nvalid ? *(const f32x4*)(W + (size_t)(k0 + kk) * ldw + nn) : (f32x4){0.f, 0.f, 0.f, 0.f}; }
#pragma unroll
    for (int i = 0; i < 8; ++i) { const int kk = (lane >> 3) + 8 * i; LAS float* d = scr + kk * 33 + n4; d[0] = wv[i][0]; d[1] = wv[i][1]; d[2] = wv[i][2]; d[3] = wv[i][3]; }
    LDS_WAIT(); asm volatile("" ::: "memory");
    const int c = lane & 7;
#pragma unroll
    for (int j = 0; j < 4; ++j) { const int n = (lane >> 3) + 8 * j; const LAS float* s = scr + (8 * c) * 33 + n;
        v4u o; o.x = pk2(s[0 * 33], s[1 * 33]); o.y = pk2(s[2 * 33], s[3 * 33]); o.z = pk2(s[4 * 33], s[5 * 33]); o.w = pk2(s[6 * 33], s[7 * 33]);
        *(v4u*)(WT + (size_t)(n0 + n) * K + k0 + 8 * c) = o; }
    LDS_WAIT(); asm volatile("" ::: "memory");
}

typedef short bf16x8 __attribute__((ext_vector_type(8)));
typedef short v4s __attribute__((ext_vector_type(4)));
__device__ __forceinline__ bf16x8 lds_tr_frag(LAS unsigned char* img, int stride, int krow0, int q, int colbyte) {
    const v4s lo = __builtin_amdgcn_ds_read_tr16_b64_v4i16((LAS v4s*)(img + (krow0 + q) * stride + colbyte));
    const v4s hi = __builtin_amdgcn_ds_read_tr16_b64_v4i16((LAS v4s*)(img + (krow0 + 4 + q) * stride + colbyte));
    return (bf16x8){lo[0], lo[1], lo[2], lo[3], hi[0], hi[1], hi[2], hi[3]};
}
__device__ __forceinline__ void ml_gate_scalars(const float* GATES, int r0, int Lv, int hd, float bi, float bfv, int lane, float& b, float& a, float& pm) {
    float lf = 0.f, li = -1e30f;
    if (lane < Lv) { const float* gp = GATES + (size_t)(r0 + lane) * 16; li = gp[hd] + bi; lf = logsigmoid_f(gp[8 + hd] + bfv); }
    b = wave_scan_add(lf);
    a = li - b; pm = wave_scan_max(a);
}
template <int C> __device__ __forceinline__ void conv_pass(const bf16* raw, bf16* outp, const float* cw, const float* cb, const float* st_in, float* so_p, float* so_s, size_t gtid, size_t NGT) {
    constexpr int NCH = C / 8, NBLK = M / 16;
    for (size_t it = gtid; it < (size_t)NBLK * NCH; it += NGT) {
        const int rb = (int)(it / NCH), c0 = (int)(it % NCH) * 8;
        int s, t0; if (rb < M_P / 16) { s = rb >> 9; t0 = (rb & 511) * 16; } else { s = NB_P + (rb - M_P / 16); t0 = 0; }
        const int row0 = rb * 16;
        const bool lastblk = (s >= NB_P) || ((rb & 511) == 511);
        v4u rw[16];
#pragma unroll
        for (int r = 0; r < 16; ++r) rw[r] = *(const v4u*)(raw + (size_t)(row0 + r) * C + c0);
        float h0[8], h1[8], h2[8];
        if (t0 > 0) { const v4u a = *(const v4u*)(raw + (size_t)(row0 - 3) * C + c0), b = *(const v4u*)(raw + (size_t)(row0 - 2) * C + c0), c = *(const v4u*)(raw + (size_t)(row0 - 1) * C + c0);
            h0[0] = bflo(a.x); h0[1] = bfhi(a.x); h0[2] = bflo(a.y); h0[3] = bfhi(a.y); h0[4] = bflo(a.z); h0[5] = bfhi(a.z); h0[6] = bflo(a.w); h0[7] = bfhi(a.w);
            h1[0] = bflo(b.x); h1[1] = bfhi(b.x); h1[2] = bflo(b.y); h1[3] = bfhi(b.y); h1[4] = bflo(b.z); h1[5] = bfhi(b.z); h1[6] = bflo(b.w); h1[7] = bfhi(b.w);
            h2[0] = bflo(c.x); h2[1] = bfhi(c.x); h2[2] = bflo(c.y); h2[3] = bfhi(c.y); h2[4] = bflo(c.z); h2[5] = bfhi(c.z); h2[6] = bflo(c.w); h2[7] = bfhi(c.w);
        } else if (s >= NB_P) { const float* sp = st_in + (size_t)(s - NB_P) * 3 * C + c0;
#pragma unroll
            for (int e = 0; e < 8; ++e) { h0[e] = sp[e]; h1[e] = sp[C + e]; h2[e] = sp[2 * C + e]; }
        } else {
#pragma unroll
            for (int e = 0; e < 8; ++e) { h0[e] = 0.f; h1[e] = 0.f; h2[e] = 0.f; } }
        float w0[8], w1[8], w2[8], w3[8], bb[8];
#pragma unroll
        for (int e = 0; e < 8; ++e) { w0[e] = cw[c0 + e]; w1[e] = cw[C + c0 + e]; w2[e] = cw[2 * C + c0 + e]; w3[e] = cw[3 * C + c0 + e]; bb[e] = cb[c0 + e]; }
#pragma unroll
        for (int r = 0; r < 16; ++r) {
            const v4u w = rw[r]; const float x[8] = {bflo(w.x), bfhi(w.x), bflo(w.y), bfhi(w.y), bflo(w.z), bfhi(w.z), bflo(w.w), bfhi(w.w)};
            float y[8];
#pragma unroll
            for (int e = 0; e < 8; ++e) { y[e] = silu_f(bb[e] + w0[e] * h0[e] + w1[e] * h1[e] + w2[e] * h2[e] + w3[e] * x[e]); h0[e] = h1[e]; h1[e] = h2[e]; h2[e] = x[e]; }
            v4u o; o.x = pk2(y[0], y[1]); o.y = pk2(y[2], y[3]); o.z = pk2(y[4], y[5]); o.w = pk2(y[6], y[7]);
            *(v4u*)(outp + (size_t)(row0 + r) * C + c0) = o;
        }
        if (lastblk) { float* so = (s < NB_P ? so_p + (size_t)s * 3 * C : so_s + (size_t)(s - NB_P) * 3 * C) + c0;
#pragma unroll
            for (int e = 0; e < 8; ++e) { so[e] = h0[e]; so[C + e] = h1[e]; so[2 * C + e] = h2[e]; } }
    }
}
struct Args { const float* in[29]; float* out; unsigned char* ws; int ph_lo, ph_hi; };

__device__ __forceinline__ int stream_T(int s) { return s < NB_P ? T_P : T_S; }
__device__ __forceinline__ int stream_row0(int s) { return s < NB_P ? s * T_P : M_P + (s - NB_P) * T_S; }

__global__ void __launch_bounds__(NWAVES * 64, 2) mk_fwd(Args args) {
    extern __shared__ __attribute__((aligned(16))) unsigned char lds_raw[];
    LAS unsigned char* lds = (LAS unsigned char*)lds_raw;
    volatile LAS unsigned* MISC = (volatile LAS unsigned*)(lds + MISC_OFF);
    const int G = gridDim.x, bx = blockIdx.x;
    const int wave0 = __builtin_amdgcn_readfirstlane((int)threadIdx.x >> 6);
    const int NGW = G * NWAVES; const size_t NGT = (size_t)G * (NWAVES * 64);
#define SITE_VARS() int lane__; asm volatile("v_mbcnt_lo_u32_b32 %0, -1, 0\n\tv_mbcnt_hi_u32_b32 %0, -1, %0" : "=v"(lane__)); int tid_ = wave0 * 64 + lane__; asm volatile("" : "+v"(tid_)); const int tid = tid_, lane = tid & 63, wave = __builtin_amdgcn_readfirstlane(tid >> 6); \
    const int gw = bx * NWAVES + wave; const size_t gtid = (size_t)bx * (NWAVES * 64) + tid; (void)lane; (void)gw; (void)gtid
    unsigned char* ws0 = args.ws; unsigned char* ws = ws0;
    unsigned* ctl = (unsigned*)(ws + WS_CTL);
    float* out0 = args.out; float* out = out0; (void)out;

    for (int u = threadIdx.x; u < (LDS_BYTES - RING_BYTES) / 4; u += NWAVES * 64) ((LAS unsigned*)(lds + RING_BYTES))[u] = 0u;
    __syncthreads();
#if MK_ONE_LAUNCH
    XcdBarrier bar = xcd_barrier_post(ctl + CW_BAR, MISC + 8);
#define GRID_BAR() do { int lane__; asm volatile("v_mbcnt_lo_u32_b32 %0, -1, 0\n\tv_mbcnt_hi_u32_b32 %0, -1, %0" : "=v"(lane__)); xcd_barrier(bar, wave0 == 0 && lane__ == 0); } while (0)
#else
#define GRID_BAR() do { } while (0)
#endif
    const int lo = args.ph_lo, hi = args.ph_hi;
#define IN(k) (lo <= (k) && (k) < hi)
#define SEAM(a, b) do { if (IN(a) && IN(b)) GRID_BAR(); } while (0)

    const float* x_prompt = args.in[0]; const float* x_sample = args.in[1];
    const float* st_sconv = args.in[2]; const float* st_sh = args.in[3]; const float* st_mconv = args.in[4];
    const float* st_mC = args.in[5]; const float* st_mn = args.in[6]; const float* st_mm = args.in[7];
    bf16* XB = (bf16*)(ws + WS_XB);

    if (IN(0)) {
        SITE_VARS();
        LAS float* scr = (LAS float*)(lds + wave * 16384);
        constexpr int I_SIN = 32 * (SSD_NPAD / 32), I_SOUT = 64 * 64, I_MIN = 32 * (ML_NPAD / 32), I_H = 8 * 16, I_MOUT = 64 * 64;
        constexpr int PER_L = I_SIN + I_SOUT + I_MIN + 3 * 8 * I_H + I_MOUT;
        for (int it = gw; it < 2 * PER_L; it += NGW) {
            const int j = it / PER_L; int r = it % PER_L;
            if (r < I_SIN) { const int nbn = SSD_NPAD / 32; transpose_item(args.in[8] + (size_t)j * DM * SSD_PROJ, SSD_PROJ, SSD_PROJ, DM, (bf16*)(ws + WS_WSSD_IN) + (size_t)j * SSD_NPAD * DM, r / nbn, r % nbn, scr, lane); continue; } r -= I_SIN;
            if (r < I_SOUT) { transpose_item(args.in[15] + (size_t)j * SSD_INNER * DM, DM, DM, SSD_INNER, (bf16*)(ws + WS_WSSD_OUT) + (size_t)j * DM * SSD_INNER, r / 64, r % 64, scr, lane); continue; } r -= I_SOUT;
            if (r < I_MIN) { const int nbn = ML_NPAD / 32; transpose_item(args.in[16] + (size_t)j * DM * ML_PROJ, ML_PROJ, ML_PROJ, DM, (bf16*)(ws + WS_WML_IN) + (size_t)j * ML_NPAD * DM, r / nbn, r % nbn, scr, lane); continue; } r -= I_MIN;
            if (r < 3 * 8 * I_H) { const int which = r / (8 * I_H), rr = r % (8 * I_H), head = rr / I_H, it2 = rr % I_H;
                const float* W = args.in[19 + which] + ((size_t)(j * 8 + head) * 512) * 512;
                bf16* WT = which == 2 ? (bf16*)(ws + WS_WML_V) + ((size_t)j * 4096 + head * 512) * 512
                                      : (bf16*)(ws + WS_WML_QK) + ((size_t)j * 8192 + head * 1024 + which * 512) * 512;
                transpose_item(W, 512, 512, 512, WT, it2 / 16, it2 % 16, scr, lane); continue; } r -= 3 * 8 * I_H;
            transpose_item(args.in[26] + (size_t)j * ML_INNER * DM, DM, DM, ML_INNER, (bf16*)(ws + WS_WML_OUT) + (size_t)j * DM * ML_INNER, r / 64, r % 64, scr, lane);
        }
        for (size_t i = gtid; i < (size_t)M * DM / 8; i += NGT) {
            const size_t e = i * 8;
            const float* src = e < (size_t)M_P * DM ? x_prompt + e : x_sample + (e - (size_t)M_P * DM);
            const f32x4 a = *(const f32x4*)src, b = *(const f32x4*)(src + 4);
            v4u o; o.x = pk2(a[0], a[1]); o.y = pk2(a[2], a[3]); o.z = pk2(b[0], b[1]); o.w = pk2(b[2], b[3]);
            *(v4u*)(XB + e) = o;
        }
    }
    SEAM(0, 1);

    for (int jp = 0; jp < 2; ++jp) {
        {
            const int li = 2 * jp, pb = 1 + 8 * li, j = jp;
            size_t lo_ = 0; asm volatile("" : "+s"(lo_)); unsigned char* ws = ws0 + lo_; float* out = out0 + lo_;
            bf16* Z = (bf16*)(ws + WS_S_Z); bf16* XBC = (bf16*)(ws + WS_S_XBC); bf16* Y = (bf16*)(ws + WS_S_Y); bf16* XBCC = (bf16*)(ws + WS_S_XBCC); float* DT = (float*)(ws + WS_S_DT); bf16* VPRE = (bf16*)(ws + WS_S_VPRE); float* SLAB = (float*)(ws + WS_S_VPRE + 136 * MiB);
            const float* conv_w = args.in[9] + (size_t)j * 4 * SSD_CONVD; const float* conv_b = args.in[10] + (size_t)j * SSD_CONVD;
            if (IN(pb + 0)) {
                SITE_VARS();
                pg8::Gemm g{XB, (const bf16*)(ws + WS_WSSD_IN) + (size_t)j * SSD_NPAD * DM, DM, DM, -1};
                pg8::StaticOrder S; S.init(NPANEL, SSD_NPAD / 256, G, bx);
                EpiSsdIn E{Z, XBC, DT};
                pg8::gemm_phase<EpiSsdIn, pg8::StaticOrder, PG8_ALIGN, PG8_SP2>(lds, g, S, E, tid);
            }
            SEAM(pb + 0, pb + 1);
            if (IN(pb + 1)) {
                SITE_VARS();
                conv_pass<SSD_CONVD>(XBC, XBCC, conv_w, conv_b, st_sconv + (size_t)j * NB_S * 3 * SSD_CONVD, out + O_P_SCONV + (size_t)j * NB_P * 3 * SSD_CONVD, out + O_S_SCONV + (size_t)j * NB_S * 3 * SSD_CONVD, gtid, NGT);
            }
            SEAM(pb + 1, pb + 2);
            if (IN(pb + 2)) {
                SITE_VARS();
                const float* dt_bias = args.in[11] + j * 64; const float* A_log = args.in[12] + j * 64; const float* Dp = args.in[13] + j * 64;
                const int g4 = lane >> 4, l15 = lane & 15, q4 = l15 >> 2, p4 = lane & 3;
                LAS unsigned char* Xi = lds + SX_OFF; LAS unsigned char* XSi = lds + SXS_OFF; LAS unsigned char* Bi = lds + SB_OFF; LAS unsigned char* Ci = lds + SC_OFF;
                LAS unsigned char* Hi = lds + SH_OFF; LAS unsigned char* Wi = lds + SW_OFF;
                LAS float* cumS = (LAS float*)(lds + SS_OFF); LAS float* dtS = cumS + 64; LAS float* tailS = cumS + 128; LAS float* ecumS = cumS + 192;
                for (int u = bx; u < NSTREAM * SSD_NH; u += G) {
                    const int s = u >> 6, hd = u & 63, grp = hd >> 3;
                    const int T = stream_T(s), row0 = stream_row0(s), Lv = T < 64 ? T : 64, nch = T < 64 ? 1 : T / 64;
                    const float Aneg = -__expf(A_log[hd]), dtb = dt_bias[hd], Dh = Dp[hd];
                    f32x4 st[4];
                    if (s < NB_P) {
#pragma unroll
                        for (int pt = 0; pt < 4; ++pt) st[pt] = (f32x4){0.f, 0.f, 0.f, 0.f};
                    } else {
#pragma unroll
                        for (int pt = 0; pt < 4; ++pt) st[pt] = *(const f32x4*)(st_sh + (((size_t)(j * NB_S + (s - NB_P)) * SSD_NH + hd) * SSD_HD + pt * 16 + l15) * SSD_DS + wave * 16 + 4 * g4);
                    }
                    v4u xr, br[2], cr[2];
#define SSD_LOADS(cn) do { const char* xb_ = (const char*)(XBCC + ((size_t)row0 + (size_t)(cn) * 64) * SSD_CONVD + hd * 64); \
    xr = *(const v4u*)(xb_ + xo_u); if ((tid >> 3) >= Lv) xr = (v4u){0u, 0u, 0u, 0u}; \
    br[0] = *(const v4u*)(xb_ + bo_u0); cr[0] = *(const v4u*)(xb_ + bo_u0 + 2048); br[1] = *(const v4u*)(xb_ + bo_u1); cr[1] = *(const v4u*)(xb_ + bo_u1 + 2048); \
    if ((tid >> 4) >= Lv) { br[0] = (v4u){0u, 0u, 0u, 0u}; cr[0] = (v4u){0u, 0u, 0u, 0u}; } if ((tid >> 4) + 32 >= Lv) { br[1] = (v4u){0u, 0u, 0u, 0u}; cr[1] = (v4u){0u, 0u, 0u, 0u}; } \
    } while (0)
#define SSD_DTLOAD(cn) (*(const float*)((const char*)(DT + ((size_t)row0 + (size_t)(cn) * 64) * 64 + hd) + do_u))
#define SSD_SCALARS(bufp, dtrv) do { float dtv_ = 0.f; if (lane < Lv) dtv_ = softplus_f((dtrv) + dtb); const float cs_ = wave_scan_add(dtv_ * Aneg); const float c63_ = RDLANE(cs_, 63); LAS float* sb_ = (bufp); \
    sb_[lane] = cs_ * 1.44269504f; sb_[64 + lane] = cs_ * 1.44269504f - __builtin_amdgcn_logf(dtv_); sb_[128 + lane] = __expf(c63_ - cs_) * dtv_; sb_[192 + lane] = __expf(cs_); if (lane == 0) sb_[256] = __expf(c63_); } while (0)
                    const unsigned xo_u = (unsigned)(((tid >> 3) < Lv ? (tid >> 3) : Lv - 1) * SSD_CONVD + (tid & 7) * 8) * 2u;
                    const unsigned bo_u0 = (unsigned)(((tid >> 4) < Lv ? (tid >> 4) : Lv - 1) * SSD_CONVD + 4096 - hd * 64 + grp * 128 + (tid & 15) * 8) * 2u;
                    const unsigned bo_u1 = (unsigned)(((tid >> 4) + 32 < Lv ? (tid >> 4) + 32 : Lv - 1) * SSD_CONVD + 4096 - hd * 64 + grp * 128 + (tid & 15) * 8) * 2u;
                    const unsigned do_u = (unsigned)((lane < Lv ? lane : Lv - 1) * 64) * 4u;
                    SSD_LOADS(0);
                    { asm volatile("" ::: "memory"); bf16* dp_ = (bf16*)(ws + WS_CTL + 512 * 1024) + tid * 4; const v2u z_ = {0u, 0u}; *(v2u*)dp_ = z_; *(v2u*)(dp_ + 4096) = z_; asm volatile("" ::: "memory"); }
                    float dtn = 0.f;
                    if (wave == 4) { const float dt0_ = SSD_DTLOAD(0); dtn = SSD_DTLOAD(nch > 1 ? 1 : 0); SSD_SCALARS(cumS, dt0_); }
                    __syncthreads();
                    for (int c = 0; c < nch; ++c) {
                        const int r0 = row0 + c * 64;
                        LAS float* cumC = cumS + (c & 1) * 320; LAS float* dtC = cumC + 64; LAS float* tailC = cumC + 128; LAS float* ecumC = cumC + 192;
                        { const int t = tid >> 3, c8 = (tid & 7) * 8; *(LAS v4u*)(Xi + t * ST64 + c8 * 2) = xr;
                          const float tl = tailC[t]; v4u o;
                          o.x = pk2(bflo(xr.x) * tl, bfhi(xr.x) * tl); o.y = pk2(bflo(xr.y) * tl, bfhi(xr.y) * tl); o.z = pk2(bflo(xr.z) * tl, bfhi(xr.z) * tl); o.w = pk2(bflo(xr.w) * tl, bfhi(xr.w) * tl);
                          *(LAS v4u*)(XSi + t * ST64 + c8 * 2) = o; }
#pragma unroll
                        for (int i = 0; i < 2; ++i) { const int e = tid + 512 * i, t = e >> 4, c8 = (e & 15) * 8; *(LAS v4u*)(Bi + t * ST128 + c8 * 2) = br[i]; *(LAS v4u*)(Ci + t * ST128 + c8 * 2) = cr[i]; }
#pragma unroll
                        for (int pt = 0; pt < 4; ++pt) { v2u w; w.x = pk2(st[pt][0], st[pt][1]); w.y = pk2(st[pt][2], st[pt][3]); *(LAS v2u*)(Hi + (pt * 16 + l15) * ST128 + (wave * 16 + 4 * g4) * 2) = w; }
                        __syncthreads();
                        SSD_LOADS(c + 1 < nch ? c + 1 : nch - 1);
                        if (wave == 4) { SSD_SCALARS(cumS + ((c + 1) & 1) * 320, dtn); dtn = SSD_DTLOAD(c + 2 < nch ? c + 2 : nch - 1); }
                        {
                            const int si = wave >> 1;
                            bf16x8 af[4], cfr[2][4]; float cum_t2[2];
#pragma unroll
                            for (int kk = 0; kk < 4; ++kk) af[kk] = *(const LAS bf16x8*)(Bi + (si * 16 + l15) * ST128 + (kk * 32 + 8 * g4) * 2);
                            const f32x4 g_s = *(const LAS f32x4*)(dtC + si * 16 + 4 * g4);
#pragma unroll
                            for (int tj = 0; tj < 2; ++tj) { const int t = (2 * (wave & 1) + tj) * 16 + l15; cum_t2[tj] = cumC[t];
#pragma unroll
                                for (int kk = 0; kk < 4; ++kk) cfr[tj][kk] = *(const LAS bf16x8*)(Ci + t * ST128 + (kk * 32 + 8 * g4) * 2); }
                            __builtin_amdgcn_sched_barrier(0);
#pragma unroll
                            for (int tj = 0; tj < 2; ++tj) {
                                const int ti = 2 * (wave & 1) + tj, t = ti * 16 + l15;
                                v2u w; w.x = 0u; w.y = 0u;
                                if (si <= ti) {
                                    f32x4 d = (f32x4){0.f, 0.f, 0.f, 0.f};
#pragma unroll
                                    for (int kk = 0; kk < 4; ++kk) d = __builtin_amdgcn_mfma_f32_16x16x32_bf16(af[kk], cfr[tj][kk], d, 0, 0, 0);
                                    const float cum_t = cum_t2[tj]; float wv[4];
#pragma unroll
                                    for (int r = 0; r < 4; ++r) wv[r] = d[r] * __builtin_amdgcn_exp2f(cum_t - g_s[r]);
                                    if (si == ti) {
#pragma unroll
                                        for (int r = 0; r < 4; ++r) { float w_ = wv[r]; asm volatile("" : "+v"(w_)); wv[r] = (4 * g4 + r <= l15) ? w_ : 0.f; } }
                                    w.x = pk2(wv[0], wv[1]); w.y = pk2(wv[2], wv[3]);
                                }
                                *(LAS v2u*)(Wi + t * ST64 + (si * 16 + 4 * g4) * 2) = w;
                            }
                        }
                        __syncthreads();
                        {
                            const int ti = wave >> 1, t = ti * 16 + l15;
                            bf16x8 cf[4], wf[2], hfr[2][4], xfr[2][2], bf2[2], xsf[4][2]; v2u xw2[2];
#pragma unroll
                            for (int kk = 0; kk < 4; ++kk) cf[kk] = *(const LAS bf16x8*)(Ci + t * ST128 + (kk * 32 + 8 * g4) * 2);
#pragma unroll
                            for (int ks = 0; ks < 2; ++ks) wf[ks] = *(const LAS bf16x8*)(Wi + t * ST64 + (ks * 32 + 8 * g4) * 2);
                            const float ec = ecumC[t], dec = cumC[256];
#pragma unroll
                            for (int pj = 0; pj < 2; ++pj) { const int pt = 2 * (wave & 1) + pj;
#pragma unroll
                                for (int kk = 0; kk < 4; ++kk) hfr[pj][kk] = *(const LAS bf16x8*)(Hi + (pt * 16 + l15) * ST128 + (kk * 32 + 8 * g4) * 2);
#pragma unroll
                                for (int ks = 0; ks < 2; ++ks) xfr[pj][ks] = lds_tr_frag(Xi, ST64, ks * 32 + 8 * g4, q4, (pt * 16 + 4 * p4) * 2);
                                xw2[pj] = *(const LAS v2u*)(Xi + t * ST64 + (pt * 16 + 4 * g4) * 2); }
#pragma unroll
                            for (int ks = 0; ks < 2; ++ks) bf2[ks] = lds_tr_frag(Bi, ST128, ks * 32 + 8 * g4, q4, (wave * 16 + 4 * p4) * 2);
#pragma unroll
                            for (int pt = 0; pt < 4; ++pt)
#pragma unroll
                                for (int ks = 0; ks < 2; ++ks) xsf[pt][ks] = lds_tr_frag(XSi, ST64, ks * 32 + 8 * g4, q4, (pt * 16 + 4 * p4) * 2);
                            __builtin_amdgcn_sched_barrier(0);
#pragma unroll
                            for (int pj = 0; pj < 2; ++pj) {
                                const int pt = 2 * (wave & 1) + pj;
                                f32x4 d = (f32x4){0.f, 0.f, 0.f, 0.f};
#pragma unroll
                                for (int kk = 0; kk < 4; ++kk) d = __builtin_amdgcn_mfma_f32_16x16x32_bf16(hfr[pj][kk], cf[kk], d, 0, 0, 0);
                                d = d * ec;
#pragma unroll
                                for (int ks = 0; ks < 2; ++ks) { if (ks == 0 || ti >= 2) d = __builtin_amdgcn_mfma_f32_16x16x32_bf16(xfr[pj][ks], wf[ks], d, 0, 0, 0); }
                                const v2u xw = xw2[pj];
                                d[0] += Dh * bflo(xw.x); d[1] += Dh * bfhi(xw.x); d[2] += Dh * bflo(xw.y); d[3] += Dh * bfhi(xw.y);
                                { v2u o; o.x = pk2(d[0], d[1]); o.y = pk2(d[2], d[3]); bf16* yp = Y + (size_t)(r0 + t) * SSD_INNER + hd * 64 + pt * 16 + 4 * g4; if (t >= Lv) yp = (bf16*)(ws + WS_CTL + 512 * 1024) + tid * 4; *(v2u*)yp = o; }
                            }
#pragma unroll
                            for (int pt = 0; pt < 4; ++pt) { st[pt] = st[pt] * dec;
#pragma unroll
                                for (int ks = 0; ks < 2; ++ks) st[pt] = __builtin_amdgcn_mfma_f32_16x16x32_bf16(bf2[ks], xsf[pt][ks], st[pt], 0, 0, 0); }
                        }
                        __syncthreads();
                    }
                    {
                        float* ho = s < NB_P ? out + O_P_SH + ((size_t)(j * NB_P + s) * SSD_NH + hd) * SSD_HD * SSD_DS : out + O_S_SH + ((size_t)(j * NB_S + (s - NB_P)) * SSD_NH + hd) * SSD_HD * SSD_DS;
#pragma unroll
                        for (int pt = 0; pt < 4; ++pt) *(f32x4*)(ho + (size_t)(pt * 16 + l15) * SSD_DS + wave * 16 + 4 * g4) = st[pt];
                    }
                }
            }
            SEAM(pb + 2, pb + 3);
            if (IN(pb + 3)) {
                SITE_VARS();
                const float* norm_w = args.in[14] + (size_t)j * SSD_INNER;
                for (int row = gw; row < M; row += NGW) {
                    const size_t off0 = (size_t)row * SSD_INNER + lane * 8;
                    v4u yw[8], zw[8];
#pragma unroll
                    for (int grp = 0; grp < 8; ++grp) { yw[grp] = *(const v4u*)(Y + off0 + grp * 512); zw[grp] = *(const v4u*)(Z + off0 + grp * 512); }
#pragma unroll
                    for (int grp = 0; grp < 8; ++grp) {
                        float v[8];
                        v[0] = bflo(yw[grp].x) * silu_f(bflo(zw[grp].x)); v[1] = bfhi(yw[grp].x) * silu_f(bfhi(zw[grp].x)); v[2] = bflo(yw[grp].y) * silu_f(bflo(zw[grp].y)); v[3] = bfhi(yw[grp].y) * silu_f(bfhi(zw[grp].y));
                        v[4] = bflo(yw[grp].z) * silu_f(bflo(zw[grp].z)); v[5] = bfhi(yw[grp].z) * silu_f(bfhi(zw[grp].z)); v[6] = bflo(yw[grp].w) * silu_f(bflo(zw[grp].w)); v[7] = bfhi(yw[grp].w) * silu_f(bfhi(zw[grp].w));
                        float ss = 0.f;
#pragma unroll
                        for (int i = 0; i < 8; ++i) ss += v[i] * v[i];
                        const float r = rsqrtf(wave_sum(ss) * (1.f / 512.f) + RMS_EPS);
                        const f32x4 n0 = *(const f32x4*)(norm_w + grp * 512 + lane * 8), n1 = *(const f32x4*)(norm_w + grp * 512 + lane * 8 + 4);
                        v4u o; o.x = pk2(v[0] * r * n0[0], v[1] * r * n0[1]); o.y = pk2(v[2] * r * n0[2], v[3] * r * n0[3]); o.z = pk2(v[4] * r * n1[0], v[5] * r * n1[1]); o.w = pk2(v[6] * r * n1[2], v[7] * r * n1[3]);
                        *(v4u*)(Y + off0 + grp * 512) = o;
                    }
                }
            }
            SEAM(pb + 3, pb + 4);
            if (IN(pb + 4)) {
                SITE_VARS();
                pg8::Gemm g{Y, (const bf16*)(ws + WS_WSSD_OUT) + (size_t)j * DM * SSD_INNER, SSD_INNER, SSD_INNER, -1};
                pg8::SplitTailOrder S; S.init(M_P / 256, DM / 256, M_S / 256, G, bx, WGM_OUT);
                EpiResid E{XB, VPRE, DN_ALPHA, SLAB};
                pg8::gemm_phase<EpiResid, pg8::SplitTailOrder, PG8_ALIGN, PG8_SP2, true>(lds, g, S, E, tid);
            }
            SEAM(pb + 4, pb + 5);
            if (IN(pb + 5)) {
                SITE_VARS();
                const float* lg = args.in[27] + (size_t)li * DM; const float* lb = args.in[28] + (size_t)li * DM;
                for (int row = gw; row < M; row += NGW) {
                    const v4u* vr = (const v4u*)(VPRE + (size_t)row * DM) + lane;
                    const v4u* XBV = (const v4u*)XB;
                    float v[32]; float sm = 0.f;
#pragma unroll
                    for (int q = 0; q < 4; ++q) { v4u w = vr[64 * q]; if (row >= M_P) w = (XBV + (size_t)row * (DM / 8) + lane)[64 * q]; v[8 * q + 0] = bflo(w.x); v[8 * q + 1] = bfhi(w.x); v[8 * q + 2] = bflo(w.y); v[8 * q + 3] = bfhi(w.y); v[8 * q + 4] = bflo(w.z); v[8 * q + 5] = bfhi(w.z); v[8 * q + 6] = bflo(w.w); v[8 * q + 7] = bfhi(w.w); }
                    if (row >= M_P) {
#pragma unroll
                        for (int i = 0; i < 32; ++i) v[i] *= DN_ALPHA;
#pragma unroll
                        for (int kq = 0; kq < 4; ++kq)
#pragma unroll
                            for (int q = 0; q < 4; ++q) { const float* sp = SLAB + ((size_t)kq * M_S + (row - M_P)) * DM + 8 * (lane + 64 * q); const f32x4 s0 = *(const f32x4*)sp, s1 = *(const f32x4*)(sp + 4);
                                v[8 * q + 0] += s0[0]; v[8 * q + 1] += s0[1]; v[8 * q + 2] += s0[2]; v[8 * q + 3] += s0[3]; v[8 * q + 4] += s1[0]; v[8 * q + 5] += s1[1]; v[8 * q + 6] += s1[2]; v[8 * q + 7] += s1[3]; }
                    }
#pragma unroll
                    for (int i = 0; i < 32; ++i) sm += v[i];
                    const float mean = wave_sum(sm) * (1.f / DM); float s2 = 0.f;
#pragma unroll
                    for (int i = 0; i < 32; ++i) { v[i] -= mean; s2 += v[i] * v[i]; }
                    const float rstd = rsqrtf(wave_sum(s2) * (1.f / DM) + LN_EPS);
#pragma unroll
                    for (int q = 0; q < 4; ++q) { const int c = 8 * (lane + 64 * q); const f32x4 g0 = *(const f32x4*)(lg + c), g1 = *(const f32x4*)(lg + c + 4), b0 = *(const f32x4*)(lb + c), b1 = *(const f32x4*)(lb + c + 4);
                        f32x4 o0, o1;
#pragma unroll
                        for (int e = 0; e < 4; ++e) { o0[e] = v[8 * q + e] * rstd * g0[e] + b0[e]; o1[e] = v[8 * q + 4 + e] * rstd * g1[e] + b1[e]; }
                        v4u w; w.x = pk2(o0[0], o0[1]); w.y = pk2(o0[2], o0[3]); w.z = pk2(o1[0], o1[1]); w.w = pk2(o1[2], o1[3]); *(v4u*)(XB + (size_t)row * DM + c) = w; }
                }
            }
            SEAM(pb + 5, pb + 8);
        }
        {
            const int li = 2 * jp + 1, pb = 1 + 8 * li, j = jp;
            size_t lo_ = 0; asm volatile("" : "+s"(lo_)); unsigned char* ws = ws0 + lo_; float* out = out0 + lo_;
            bf16* XM = (bf16*)(ws + WS_M_XM); bf16* Q = (bf16*)(ws + WS_M_Q); bf16* YG = (bf16*)(ws + WS_M_YG); bf16* Z = (bf16*)(ws + WS_M_Z); bf16* O = (bf16*)(ws + WS_M_O);
            bf16* XC = (bf16*)(ws + WS_M_XC); bf16* Kb = (bf16*)(ws + WS_M_K); bf16* Vb = (bf16*)(ws + WS_M_V); bf16* H = (bf16*)(ws + WS_M_H);
            float* GATES = (float*)(ws + WS_M_GATES); bf16* VPRE = (bf16*)(ws + WS_M_VPRE); float* SLAB = (float*)(ws + WS_M_VPRE + 136 * MiB);
            bf16* Sg = (bf16*)(ws + WS_M_S); float* TOK = (float*)(ws + WS_M_TOK); float* CHK = (float*)(ws + WS_M_CHK); float* CHP = (float*)(ws + WS_M_CHP); float* MPREV = (float*)(ws + WS_M_CHK + 768 * 1024);
            if (IN(pb + 0)) {
                SITE_VARS();
                pg8::Gemm g{XB, (const bf16*)(ws + WS_WML_IN) + (size_t)j * ML_NPAD * DM, DM, DM, -1};
                pg8::StaticOrder S; S.init(NPANEL, ML_NPAD / 256, G, bx);
                static_assert(WS_M_Z - WS_M_XM == ACT_U && WS_M_O - WS_M_Z == ACT_U, "XM | Z | O equally spaced");
                EpiMlIn E{XM, ACT_U / 2, GATES};
                pg8::gemm_phase<EpiMlIn, pg8::StaticOrder, PG8_ALIGN, PG8_SP2>(lds, g, S, E, tid);
            }
            SEAM(pb + 0, pb + 1);
            if (IN(pb + 1)) {
                SITE_VARS();
                const float* conv_w = args.in[17] + (size_t)j * 4 * ML_INNER; const float* conv_b = args.in[18] + (size_t)j * ML_INNER;
                conv_pass<ML_INNER>(XM, XC, conv_w, conv_b, st_mconv + (size_t)j * NB_S * 3 * ML_INNER, out + O_P_MCONV + (size_t)j * NB_P * 3 * ML_INNER, out + O_S_MCONV + (size_t)j * NB_S * 3 * ML_INNER, gtid, NGT);
                { const float* b_i = args.in[22] + j * 8; const float* b_f = args.in[23] + j * 8;
                  for (int it = gw; it < ML_NCHUNK * ML_NH; it += NGW) { const int ci = it >> 3, hd = it & 7; const int r0 = ci < 512 ? ci * 64 : M_P + (ci - 512) * 16, Lv = ci < 512 ? 64 : 16;
                      float b, a, pm; ml_gate_scalars(GATES, r0, Lv, hd, b_i[hd], b_f[hd], lane, b, a, pm);
                      if (lane == 63) { CHP[(ci * 8 + hd) * 2] = b; CHP[(ci * 8 + hd) * 2 + 1] = pm; } } }
                __syncthreads();
                pg8::Gemm g{XM, (const bf16*)(ws + WS_WML_V) + (size_t)j * 4096 * 512, ML_INNER, 512, 1};
                pg8::StaticOrder S; S.init(NPANEL, 16, G, bx, WGM_HEAD);
                EpiHead<0> E{Vb, nullptr, 1.f};
                pg8::gemm_phase<EpiHead<0>, pg8::StaticOrder, PG8_ALIGN, PG8_SP2>(lds, g, S, E, tid);
            }
            SEAM(pb + 1, pb + 2);
            if (IN(pb + 2)) {
                SITE_VARS();
                if (gw < NB_P * ML_NH) {
                    const int s = gw >> 3, hd = gw & 7;
                    const float blo = CHP[((s * 128 + lane) * 8 + hd) * 2], plo = CHP[((s * 128 + lane) * 8 + hd) * 2 + 1], bhi = CHP[((s * 128 + 64 + lane) * 8 + hd) * 2], phi = CHP[((s * 128 + 64 + lane) * 8 + hd) * 2 + 1];
                    float m = 0.f, mlo = 0.f, mhi = 0.f;
                    for (int cc = 0; cc < 128; ++cc) { if (cc < 64) { if (lane == cc) mlo = m; } else { if (lane == cc - 64) mhi = m; }
                        const float bb = RDLANE(cc < 64 ? blo : bhi, cc & 63), pp = RDLANE(cc < 64 ? plo : phi, cc & 63); m = bb + fmaxf(m, pp); }
                    MPREV[(s * 128 + lane) * 8 + hd] = mlo; MPREV[(s * 128 + 64 + lane) * 8 + hd] = mhi;
                }
                pg8::Gemm g{XC, (const bf16*)(ws + WS_WML_QK) + (size_t)j * 8192 * 512, ML_INNER, 512, 2};
                pg8::StaticOrder S; S.init(NPANEL, 32, G, bx, WGM_HEAD);
                EpiHead<1> E{Q, Kb, ML_QSCALE};
                pg8::gemm_phase<EpiHead<1>, pg8::StaticOrder, PG8_ALIGN, PG8_SP2>(lds, g, S, E, tid);
            }
            SEAM(pb + 2, pb + 3);
            if (IN(pb + 3)) {
                SITE_VARS();
                const int g4 = lane >> 4, l15 = lane & 15;
                const float* b_i = args.in[22] + j * 8; const float* b_f = args.in[23] + j * 8;
                LAS unsigned char* Qi = lds; LAS unsigned char* Ki = lds + 66560;
                LAS float* eS = (LAS float*)(lds + 133120); LAS float* aS = eS + 64; LAS float* denP = eS + 128;
                for (int u = bx; u < ML_NCHUNK * ML_NH; u += G) {
                    const int ci = u >> 3, hd = u & 7;
                    const int r0 = ci < 512 ? ci * 64 : M_P + (ci - 512) * 16, Lv = ci < 512 ? 64 : 16;
#pragma unroll
                    for (int i = 0; i < 8; ++i) { const int e = tid + 512 * i, t = e >> 6, c8 = (e & 63) * 8; v4u qv = (v4u){0u, 0u, 0u, 0u}, kv = (v4u){0u, 0u, 0u, 0u};
                        if (t < Lv) { qv = *(const v4u*)(Q + (size_t)(r0 + t) * ML_INNER + hd * 512 + c8); kv = *(const v4u*)(Kb + (size_t)(r0 + t) * ML_INNER + hd * 512 + c8); }
                        *(LAS v4u*)(Qi + t * 1040 + c8 * 2) = qv; *(LAS v4u*)(Ki + t * 1040 + c8 * 2) = kv; }
                    float gT = 0.f, emT = 1.f, tailT = 0.f;
                    if (wave == 0) {
                        float b, a, pm; ml_gate_scalars(GATES, r0, Lv, hd, b_i[hd], b_f[hd], lane, b, a, pm);
                        float mprev;
                        if (ci < 512) { mprev = MPREV[ci * 8 + hd];
                        } else mprev = st_mm[(size_t)(j * NB_S + (ci - 512)) * ML_NH + hd];
                        const float mt = b + fmaxf(mprev, pm);
                        const float b63 = RDLANE(b, 63), mnew = RDLANE(mt, 63);
                        eS[lane] = b - mt; aS[lane] = a;
                        gT = __expf(b + mprev - mt); emT = __expf(-mt); tailT = __expf(fminf(a + b63 - mnew, 0.f));
                        if (lane == 0) { CHK[(ci * 8 + hd) * 2] = __expf(b63 + mprev - mnew); CHK[(ci * 8 + hd) * 2 + 1] = mnew; }
                    }
                    __syncthreads();
                    {
                        const int ti = wave >> 1, t = ti * 16 + l15; const float et = eS[t]; float dsum = 0.f;
#pragma unroll
                        for (int sjj = 0; sjj < 2; ++sjj) {
                            const int sj = 2 * (wave & 1) + sjj; v2u w; w.x = 0u; w.y = 0u;
                            if (sj <= ti) {
                                f32x4 d = (f32x4){0.f, 0.f, 0.f, 0.f};
#pragma unroll
                                for (int kk = 0; kk < 16; ++kk) { const bf16x8 af = *(const LAS bf16x8*)(Ki + (sj * 16 + l15) * 1040 + (kk * 32 + 8 * g4) * 2), bfr = *(const LAS bf16x8*)(Qi + t * 1040 + (kk * 32 + 8 * g4) * 2);
                                    d = __builtin_amdgcn_mfma_f32_16x16x32_bf16(af, bfr, d, 0, 0, 0); }
                                const f32x4 as4 = *(const LAS f32x4*)(aS + sj * 16 + 4 * g4); float sv[4];
#pragma unroll
                                for (int r = 0; r < 4; ++r) { const int sidx = sj * 16 + 4 * g4 + r; sv[r] = sidx <= t ? d[r] * __expf(fminf(et + as4[r], 0.f)) : 0.f; dsum += sv[r]; }
                                w.x = pk2(sv[0], sv[1]); w.y = pk2(sv[2], sv[3]);
                            }
                            *(v2u*)(Sg + ((size_t)(ci * 8 + hd) * 64 + t) * 64 + sj * 16 + 4 * g4) = w;
                        }
                        dsum += BPERM(dsum, lane ^ 16); dsum += BPERM(dsum, lane ^ 32);
                        if (g4 == 0) denP[(wave & 1) * 64 + t] = dsum;
                    }
                    __syncthreads();
                    if (wave == 0 && lane < Lv) *(f32x4*)(TOK + ((size_t)(r0 + lane) * 8 + hd) * 4) = (f32x4){gT, emT, denP[lane] + denP[64 + lane], tailT};
                    __syncthreads();
                }
            }
            SEAM(pb + 3, pb + 4);
            if (IN(pb + 4)) {
                SITE_VARS();
                const int v16 = wave & 3, lw = wave & 3, ltid = tid & 255;
#define FRESHI(x) ({ int x__ = (x); asm volatile("" : "+v"(x__)); x__; })
#define LDSV(T, off) (*(LAS T*)(lds + (off)))
#define TRFRAG(off, stride) ({ const v4s lo_ = __builtin_amdgcn_ds_read_tr16_b64_v4i16((LAS v4s*)(lds + (off))); const v4s hi_ = __builtin_amdgcn_ds_read_tr16_b64_v4i16((LAS v4s*)(lds + (off) + 16 * (stride))); \
    (bf16x8){lo_[0], lo_[1], lo_[2], lo_[3], hi_[0], hi_[1], hi_[2], hi_[3]}; })
#define SB() __builtin_amdgcn_sched_barrier(0)
                LAS f32x4* Ib = (LAS f32x4*)(lds + MI_OFF);
                LAS float* scal = (LAS float*)(lds + MSC_OFF);
                LAS float* nS = (LAS float*)(lds + MN_OFF); LAS float* nPart = (LAS float*)(lds + MNP_OFF); LAS float* qnP = (LAS float*)(lds + MQN_OFF); LAS float* decS = (LAS float*)(lds + MDEC_OFF);
                LAS unsigned short* nB = (LAS unsigned short*)(lds + MNB_OFF); LAS unsigned short* tailB = (LAS unsigned short*)(lds + MTB_OFF);
                if (wave < 4) {
                for (int u = bx; u < 2304; u += G) {
                    int s, hd, vs;
                    if (u < 256) { const int pr = (u & 7) + 8 * (u >> 6); vs = (u >> 3) & 7; s = pr >> 3; hd = pr & 7; }
                    else { const int up = u - 256, pr = (up & 7) + 8 * (up >> 6); vs = (up >> 3) & 7; s = NB_P + (pr >> 3); hd = pr & 7; }
                    const int T = stream_T(s), row0 = stream_row0(s), Lv = T < 64 ? T : 64, nch = T < 64 ? 1 : T / 64;
                    const int ci0 = s < NB_P ? s * 128 : 512 + (s - NB_P);
                    const size_t sbi = s < NB_P ? 0 : (size_t)(j * NB_S + (s - NB_P)) * ML_NH + hd;
                    f32x4 R[32];
                    if (s < NB_P) {
                        if (true) {
#pragma unroll
                            for (int i = 0; i < 32; ++i) R[i] = (f32x4){0.f, 0.f, 0.f, 0.f};
                        }
                        nS[tid] = 0.f; nB[tid] = 0;
                    } else {
                        int t2_ = tid; asm volatile("" : "+v"(t2_));
                        const unsigned stio = (unsigned)((t2_ >> 4) * 256 + (t2_ & 15) * 16);
                        const unsigned stld = (unsigned)((4 * ((t2_ >> 4) & 3)) * 256 + (((t2_ >> 6) & 3) * 16 + (t2_ & 15)) * 4);
#pragma unroll
                        for (int h = 0; h < 2; ++h) {
                            const float* gp = st_mC + sbi * ML_HD * ML_HD + (size_t)(h * 256 + (t2_ >> 4)) * ML_HD + vs * 64 + (t2_ & 15) * 4;
#pragma unroll
                            for (int pp = 0; pp < 2; ++pp) { f32x4 tmp[4];
#pragma unroll
                                for (int p = 0; p < 4; ++p) tmp[p] = *(const f32x4*)(gp + (size_t)(pp * 4 + p) * 32 * ML_HD);
#pragma unroll
                                for (int p = 0; p < 4; ++p) LDSV(f32x4, (pp * 4 + p) * 8192 + stio) = tmp[p]; SB(); }
                            __syncthreads();
                            if (true) {
#pragma unroll
                                for (int i2 = 0; i2 < 2; ++i2)
#pragma unroll
                                    for (int kt = 0; kt < 8; ++kt)
#pragma unroll
                                        for (int r = 0; r < 4; ++r) R[(2 * h + i2) * 8 + kt][r] = LDSV(float, (i2 * 128 + kt * 16 + r) * 256 + stld);
                            }
                            __syncthreads();
                        }
                        { const float n0_ = st_mn[sbi * ML_HD + tid]; nS[tid] = n0_; nB[tid] = (unsigned short)f2bf(n0_); }
                    }
                    const int ltid_u = FRESHI(ltid), lane_u = FRESHI(lane);
                    const int lnu = FRESHI(lane); const int ug4 = lnu >> 4, ul15 = lnu & 15;
                    const unsigned m_rowQ = (unsigned)(ul15 * ST128 + 8 * ug4); unsigned m_rowQh = m_rowQ + 32; asm volatile("" : "+v"(m_rowQh));
                    const unsigned m_trK0 = (unsigned)((4 * ug4 + (ul15 >> 2)) * STK + 8 * (lnu & 3) + MQ_K);
                    const unsigned m_trVT0 = (unsigned)((4 * ug4 + (ul15 >> 2)) * STV + 8 * (lnu & 3) + v16 * 32 + MVT_OFF);
                    v4u sa[2], va[2]; float tlv[2]; f32x4 tk; float dcv;
                    const char* Qu = (const char*)(Q + (size_t)row0 * ML_INNER + hd * 512); const char* Ku = (const char*)(Kb + (size_t)row0 * ML_INNER + hd * 512);
#define ML_LOADX(set, cn, qi, x_, rowq_, colq_) do { const size_t go_ = ((size_t)(cn) * 64 * ML_INNER + (qi) * 128) * 2; const int rr_ = (rowq_) + 16 * (x_), rc_ = rr_ < Lv ? rr_ : Lv - 1; const unsigned qk_ = (unsigned)(rc_ * (ML_INNER * 2)) + (colq_); \
    R[(set) * 8 + (x_)] = *(const f32x4*)(Qu + go_ + qk_); R[(set) * 8 + 4 + (x_)] = *(const f32x4*)(Ku + go_ + qk_); } while (0)
#define ML_LOADS(set, cn, qi) do { const int tl_ = FRESHI(ltid); const int rq_ = tl_ >> 4; const unsigned cq_ = (unsigned)(tl_ & 15) * 16u; \
    ML_LOADX(set, cn, qi, 0, rq_, cq_); ML_LOADX(set, cn, qi, 1, rq_, cq_); ML_LOADX(set, cn, qi, 2, rq_, cq_); ML_LOADX(set, cn, qi, 3, rq_, cq_); } while (0)
#define ML_LOADS_S(cn) do { const int rn0_ = row0 + (cn) * 64; const int tl_ = FRESHI(ltid); \
    _Pragma("unroll") for (int x_ = 0; x_ < 2; ++x_) { const int tq_ = (tl_ >> 3) + 32 * x_, tc_ = tq_ < Lv ? tq_ : Lv - 1; \
        sa[x_] = *(const v4u*)(Sg + (size_t)((ci0 + (cn)) * 8 + hd) * 4096 + (tl_ + 256 * x_) * 8); \
        va[x_] = *(const v4u*)(Vb + (size_t)(rn0_ + tc_) * ML_INNER + hd * 512 + vs * 64 + (tl_ & 7) * 8); tlv[x_] = TOK[((size_t)(rn0_ + tc_) * 8 + hd) * 4 + 3]; } \
    { const int t6_ = tl_ & 63, t6c_ = t6_ < Lv ? t6_ : Lv - 1; tk = *(const f32x4*)(TOK + ((size_t)(rn0_ + t6c_) * 8 + hd) * 4); } \
    dcv = CHK[((ci0 + (cn)) * 8 + hd) * 2]; } while (0)
#define ML_WRITES(bufi, set) do { const int tw_ = ltid_u; const unsigned stq_ = (unsigned)((tw_ >> 4) * ST128 + (tw_ & 15) * 16), stk_ = (unsigned)((tw_ >> 4) * STK + (tw_ & 15) * 16 + MQ_K); \
    _Pragma("unroll") for (int x_ = 0; x_ < 4; ++x_) { LDSV(f32x4, (bufi) * MQ_BUF + x_ * 16 * ST128 + stq_) = R[(set) * 8 + x_]; LDSV(f32x4, (bufi) * MQ_BUF + x_ * 16 * STK + stk_) = R[(set) * 8 + 4 + x_]; } } while (0)
#define ML_WRITES_S(cn) do { const int tw_ = FRESHI(ltid); const unsigned sts_ = (unsigned)((tw_ >> 3) * ST64 + (tw_ & 7) * 16 + MS_OFF), stv_ = (unsigned)((tw_ >> 3) * STV + (tw_ & 7) * 16 + MV_OFF); \
    _Pragma("unroll") for (int x_ = 0; x_ < 2; ++x_) { if ((tw_ >> 3) + 32 * x_ >= Lv) { va[x_] = (v4u){0u, 0u, 0u, 0u}; tlv[x_] = 0.f; } \
        LDSV(v4u, x_ * 32 * ST64 + sts_) = sa[x_]; LDSV(v4u, x_ * 32 * STV + stv_) = va[x_]; const float tl2_ = tlv[x_]; \
        v4u o_; o_.x = pk2(bflo(va[x_].x) * tl2_, bfhi(va[x_].x) * tl2_); o_.y = pk2(bflo(va[x_].y) * tl2_, bfhi(va[x_].y) * tl2_); o_.z = pk2(bflo(va[x_].z) * tl2_, bfhi(va[x_].z) * tl2_); o_.w = pk2(bflo(va[x_].w) * tl2_, bfhi(va[x_].w) * tl2_); \
        LDSV(v4u, (MVT_OFF - MV_OFF) + ((cn) & 1) * MV_IMG + x_ * 32 * STV + stv_) = o_; } \
    if ((tw_ & 63) >= Lv) tk = (f32x4){0.f, 1.f, 1.f, 0.f}; \
    if (tw_ < 64) { LAS float* sc_ = scal + ((cn) & 1) * 256; sc_[tw_] = tk[0]; sc_[64 + tw_] = tk[1]; sc_[128 + tw_] = tk[2]; sc_[192 + tw_] = tk[3]; tailB[((cn) & 1) * 64 + tw_] = (unsigned short)f2bf(tk[3]); } \
    if (tw_ == 64) decS[(cn) & 1] = dcv; } while (0)
                    if (!true) {
                        ML_LOADS(0, 0, 0); ML_LOADS_S(0); ML_LOADS(1, 0, 1); ML_LOADS(2, 0, 2); ML_LOADS(3, 0, 3);
                        ML_WRITES(0, 0); ML_WRITES_S(0);
                    }
                    __syncthreads();
                    f32x4 qn_acc = (f32x4){0.f, 0.f, 0.f, 0.f};
                    for (int c = 0; c < nch; ++c) {
                        const int r0 = row0 + c * 64;
                        const int cnx = c + 1 < nch ? c + 1 : nch - 1;
                        f32x4 accQ[4];
#pragma unroll
                        for (int tt = 0; tt < 4; ++tt) accQ[tt] = (f32x4){0.f, 0.f, 0.f, 0.f};
                        const LAS float* scc = scal + (c & 1) * 256;
                        const float dec = decS[c & 1];
#pragma unroll
                        for (int i = 0; i < 4; ++i) {
                            const int b = i & 1;
                            if (true) {
                                const unsigned rowQ = m_rowQ + b * MQ_BUF, rowQh = m_rowQh + b * MQ_BUF;
                                const unsigned trK = m_trK0 + b * MQ_BUF;
                                const unsigned trVT = m_trVT0 + (c & 1) * MV_IMG;
                                if (i == 0) {
                                    const unsigned trV = m_trVT0 - (MVT_OFF - MV_OFF), rowS = (unsigned)(ul15 * ST64 + 8 * ug4 + MS_OFF);
                                    f32x4 accI[4];
#pragma unroll
                                    for (int tt = 0; tt < 4; ++tt) accI[tt] = (f32x4){0.f, 0.f, 0.f, 0.f};
                                    bf16x8 vf2[2]; v2u sl2[2][4], sh2[2][4];
#pragma unroll
                                    for (int ks = 0; ks < 2; ++ks) { vf2[ks] = TRFRAG(ks * 32 * STV + trV, STV);
#pragma unroll
                                        for (int tt = 0; tt < 4; ++tt) { sl2[ks][tt] = LDSV(v2u, tt * 16 * ST64 + ks * 64 + rowS); sh2[ks][tt] = LDSV(v2u, tt * 16 * ST64 + ks * 64 + 32 + rowS); } }
                                    SB();
#pragma unroll
                                    for (int ks = 0; ks < 2; ++ks) {
#pragma unroll
                                        for (int tt = 0; tt < 4; ++tt) { pg8::u32x4 sw; sw.x = sl2[ks][tt].x; sw.y = sl2[ks][tt].y; sw.z = sh2[ks][tt].x; sw.w = sh2[ks][tt].y;
                                            accI[tt] = __builtin_amdgcn_mfma_f32_16x16x32_bf16(vf2[ks], __builtin_bit_cast(bf16x8, sw), accI[tt], 0, 0, 0); } }
#pragma unroll
                                    for (int tt = 0; tt < 4; ++tt) Ib[(v16 * 4 + tt) * 64 + lnu] = accI[tt];
                                    SB();
                                }
                                v2u ql[8], qh[8]; bf16x8 k0w[4], k1w[4], afr[2];
#define QRD(n) do { ql[(n) & 7] = LDSV(v2u, ((n) & 3) * 16 * ST128 + ((n) >> 2) * 64 + rowQ); qh[(n) & 7] = LDSV(v2u, ((n) & 3) * 16 * ST128 + ((n) >> 2) * 64 + rowQh); asm volatile("" ::: "memory"); } while (0)
#define AFQ(kk) do { const f32x4 sa0 = R[i * 8 + 2 * (kk)], sb0 = R[i * 8 + 2 * (kk) + 1]; pg8::u32x4 aw; aw.x = cvt_pk_bf16(sa0[0], sa0[1]); aw.y = cvt_pk_bf16(sa0[2], sa0[3]); aw.z = cvt_pk_bf16(sb0[0], sb0[1]); aw.w = cvt_pk_bf16(sb0[2], sb0[3]); afr[(kk) & 1] = __builtin_bit_cast(bf16x8, aw); } while (0)
#define QMF(n) do { pg8::u32x4 bw; bw.x = ql[(n) & 7].x; bw.y = ql[(n) & 7].y; bw.z = qh[(n) & 7].x; bw.w = qh[(n) & 7].y; accQ[(n) & 3] = __builtin_amdgcn_mfma_f32_16x16x32_bf16(afr[((n) >> 2) & 1], __builtin_bit_cast(bf16x8, bw), accQ[(n) & 3], 0, 0, 0); } while (0)
#define KRD(t) do { k0w[(t) & 3] = TRFRAG((t) * 32 + trK, STK); k1w[(t) & 3] = TRFRAG(32 * STK + (t) * 32 + trK, STK); } while (0)
#define KDEC(dst, t) do { const f32x4 r_ = R[i * 8 + (t)]; _Pragma("unroll") for (int e_ = 0; e_ < 4; ++e_) { float t_; asm("v_mul_f32 %0, %1, %2" : "=v"(t_) : "v"(r_[e_]), "v"(dec)); dst[e_] = t_; } } while (0)
#define KMF(sv, t) do { sv = __builtin_amdgcn_mfma_f32_16x16x32_bf16(k0w[(t) & 3], vt0, sv, 0, 0, 0); sv = __builtin_amdgcn_mfma_f32_16x16x32_bf16(k1w[(t) & 3], vt1, sv, 0, 0, 0); R[i * 8 + (t)] = sv; } while (0)
                                QRD(0); QRD(1); QRD(2); QRD(3); QRD(4); QRD(5); QRD(6); QRD(7); AFQ(0); SB();
                                const bf16x8 vt0 = TRFRAG(trVT, STV), vt1 = TRFRAG(trVT + 32 * STV, STV);
                                QMF(0); QRD(8); SB();
                                AFQ(1); QMF(1); QRD(9); SB();
                                QMF(2); QRD(10); SB();
                                QMF(3); QRD(11); SB();
                                QMF(4); QRD(12); SB();
                                AFQ(2); QMF(5); QRD(13); SB();
                                QMF(6); QRD(14); SB();
                                QMF(7); QRD(15); SB();
                                QMF(8); KRD(0); SB();
                                AFQ(3); QMF(9); SB();
                                QMF(10); KRD(1); SB();
                                QMF(11); SB();
                                QMF(12); KRD(2); SB();
                                QMF(13); SB();
                                QMF(14); KRD(3); SB();
                                QMF(15); SB();
                                f32x4 svA, svB; KDEC(svA, 0); SB();
                                KDEC(svB, 1); KMF(svA, 0); KRD(4); SB();
                                KDEC(svA, 2); KMF(svB, 1); KRD(5); SB();
                                KDEC(svB, 3); KMF(svA, 2); KRD(6); SB();
                                KDEC(svA, 4); KMF(svB, 3); KRD(7); SB();
                                KDEC(svB, 5); KMF(svA, 4); SB();
                                KDEC(svA, 6); KMF(svB, 5); SB();
                                KDEC(svB, 7); KMF(svA, 6); SB();
                                KMF(svB, 7); SB();
#undef QRD
#undef AFQ
#undef QMF
#undef KRD
#undef KDEC
#undef KMF
                            } else {
                                const int tlq = ltid_u; const int rowq = tlq >> 4; const unsigned colq = (unsigned)(tlq & 15) * 16u;
                                ML_LOADX(i, cnx, i, 0, rowq, colq);
                                SB();
                                const int lnd = FRESHI(lane); const int g4 = lnd >> 4, l15 = lnd & 15;
                                const bool dofold = (ltid < 128) && !(i == 0 && c == 0);
                                const int kr = ((i + 3) & 3) * 128 + (ltid & 127);
                                const float fo_n = nS[kr], fo_p = nPart[((i + 1) & 1) * 128 + (ltid & 127)];
                                const unsigned tbo = MTB_OFF + (c & 1) * 128 + 8 * g4;
                                const v2u t0l = LDSV(v2u, tbo), t0h = LDSV(v2u, tbo + 32), t1l = LDSV(v2u, tbo + 64), t1h = LDSV(v2u, tbo + 96);
                                const unsigned trK = (unsigned)((4 * g4 + (l15 >> 2)) * STK + 8 * (lnd & 3) + MQ_K + b * MQ_BUF + lw * 64);
                                const bf16x8 kfa0 = TRFRAG(trK, STK), kfa1 = TRFRAG(32 * STK + trK, STK);
                                SB();
                                ML_LOADX(i, cnx, i, 1, rowq, colq);
                                SB();
                                if (dofold) { const float dc = i == 0 ? decS[(c + 1) & 1] : dec; const float nn = dc * fo_n + fo_p; nS[kr] = nn; nB[kr] = (unsigned short)f2bf(nn); }
                                { pg8::u32x4 w0, w1; w0.x = t0l.x; w0.y = t0l.y; w0.z = t0h.x; w0.w = t0h.y; w1.x = t1l.x; w1.y = t1l.y; w1.z = t1h.x; w1.w = t1h.y;
                                  const bf16x8 tf0 = __builtin_bit_cast(bf16x8, w0), tf1 = __builtin_bit_cast(bf16x8, w1);
                                  const bf16x8 kfb0 = TRFRAG(32 + trK, STK), kfb1 = TRFRAG(32 * STK + 32 + trK, STK);
                                  f32x4 pn = (f32x4){0.f, 0.f, 0.f, 0.f}; pn = __builtin_amdgcn_mfma_f32_16x16x32_bf16(kfa0, tf0, pn, 0, 0, 0); pn = __builtin_amdgcn_mfma_f32_16x16x32_bf16(kfa1, tf1, pn, 0, 0, 0);
                                  if (l15 == 0) *(LAS f32x4*)(nPart + (i & 1) * 128 + (2 * lw) * 16 + 4 * g4) = pn;
                                  SB(); ML_LOADX(i, cnx, i, 2, rowq, colq); SB();
                                  f32x4 pm = (f32x4){0.f, 0.f, 0.f, 0.f}; pm = __builtin_amdgcn_mfma_f32_16x16x32_bf16(kfb0, tf0, pm, 0, 0, 0); pm = __builtin_amdgcn_mfma_f32_16x16x32_bf16(kfb1, tf1, pm, 0, 0, 0);
                                  if (l15 == 0) *(LAS f32x4*)(nPart + (i & 1) * 128 + (2 * lw + 1) * 16 + 4 * g4) = pm; }
                                SB();
                                ML_LOADX(i, cnx, i, 3, rowq, colq);
                                if (i == 0) ML_LOADS_S(cnx);
                                SB();
                                { const unsigned qro = (unsigned)(b * MQ_BUF + (lw * 16 + l15) * ST128 + 16 * g4), nbo = (unsigned)(MNB_OFF + (i * 128 + 8 * g4) * 2);
                                  bf16x8 qf[4], nf[4];
#pragma unroll
                                  for (int kk = 0; kk < 4; ++kk) { qf[kk] = LDSV(bf16x8, qro + kk * 64); nf[kk] = LDSV(bf16x8, nbo + kk * 64); }
                                  SB();
#pragma unroll
                                  for (int kk = 0; kk < 4; ++kk) qn_acc = __builtin_amdgcn_mfma_f32_16x16x32_bf16(qf[kk], nf[kk], qn_acc, 0, 0, 0); }
                                SB();
                                ML_WRITES(b ^ 1, (i + 1) & 3);
                                if (i == 3) { ML_WRITES_S(cnx); if (l15 == 0) *(LAS f32x4*)(qnP + lw * 16 + 4 * g4) = qn_acc; qn_acc = (f32x4){0.f, 0.f, 0.f, 0.f}; }
                            }
                            __syncthreads();
                        }
                        if (true) {
                            const int lnf = lnu; const int l15 = ul15, g4 = ug4;
                            float qn4[4], gt4[4], em4[4], dn4[4]; f32x4 ib4[4];
#pragma unroll
                            for (int tt = 0; tt < 4; ++tt) { const int t = tt * 16 + l15; qn4[tt] = qnP[t]; gt4[tt] = scc[t]; em4[tt] = scc[64 + t]; dn4[tt] = scc[128 + t]; ib4[tt] = Ib[(v16 * 4 + tt) * 64 + lnf]; }
                            SB();
#pragma unroll
                            for (int tt = 0; tt < 4; ++tt) { const int t = tt * 16 + l15;
                                const float den = dn4[tt] + gt4[tt] * qn4[tt];
                                const float rd = __builtin_amdgcn_rcpf(fmaxf(fabsf(den), em4[tt]));
                                const f32x4 hv = (ib4[tt] + accQ[tt] * gt4[tt]) * rd;
                                if (t < Lv) { v2u o; o.x = pk2(hv[0], hv[1]); o.y = pk2(hv[2], hv[3]); *(v2u*)(H + (size_t)(r0 + t) * ML_INNER + hd * 512 + vs * 64 + v16 * 16 + 4 * g4) = o; } }
                        }
                    }
                    if (!true && ltid < 128) { const int kr = 3 * 128 + ltid; nS[kr] = decS[(nch - 1) & 1] * nS[kr] + nPart[128 + ltid]; }
                    __syncthreads();
                    {
                        const size_t sbo = s < NB_P ? (size_t)(j * NB_P + s) * ML_NH + hd : sbi;
                        int t2_ = tid; asm volatile("" : "+v"(t2_));
                        const unsigned stio = (unsigned)((t2_ >> 4) * 256 + (t2_ & 15) * 16);
                        const unsigned stld = (unsigned)((4 * ((t2_ >> 4) & 3)) * 256 + (((t2_ >> 6) & 3) * 16 + (t2_ & 15)) * 4);
                        if (vs == 0) { out[(s < NB_P ? O_P_MN : O_S_MN) + sbo * ML_HD + tid] = nS[tid]; if (tid == 0) out[(s < NB_P ? O_P_MM : O_S_MM) + sbo] = CHK[((ci0 + nch - 1) * 8 + hd) * 2 + 1]; }
                        __syncthreads();
#pragma unroll
                        for (int h = 0; h < 2; ++h) {
                            if (true) {
#pragma unroll
                                for (int i2 = 0; i2 < 2; ++i2)
#pragma unroll
                                    for (int kt = 0; kt < 8; ++kt)
#pragma unroll
                                        for (int r = 0; r < 4; ++r) LDSV(float, (i2 * 128 + kt * 16 + r) * 256 + stld) = R[(2 * h + i2) * 8 + kt][r];
                            }
                            __syncthreads();
                            float* gp = out + (s < NB_P ? O_P_MC : O_S_MC) + sbo * ML_HD * ML_HD + (size_t)(h * 256 + (t2_ >> 4)) * ML_HD + vs * 64 + (t2_ & 15) * 4;
#pragma unroll 1
                            for (int p = 0; p < 8; ++p) *(f32x4*)(gp + (size_t)p * 32 * ML_HD) = LDSV(f32x4, p * 8192 + stio);
                            __syncthreads();
                        }
                    }
                    __syncthreads();
#undef ML_LOADS
#undef ML_LOADS_S
#undef ML_WRITES
#undef ML_WRITES_S
                }
                } else {
                for (int u = bx; u < 2304; u += G) {
                    int s, hd, vs;
                    if (u < 256) { const int pr = (u & 7) + 8 * (u >> 6); vs = (u >> 3) & 7; s = pr >> 3; hd = pr & 7; }
                    else { const int up = u - 256, pr = (up & 7) + 8 * (up >> 6); vs = (up >> 3) & 7; s = NB_P + (pr >> 3); hd = pr & 7; }
                    const int T = stream_T(s), row0 = stream_row0(s), Lv = T < 64 ? T : 64, nch = T < 64 ? 1 : T / 64;
                    const int ci0 = s < NB_P ? s * 128 : 512 + (s - NB_P);
                    const size_t sbi = s < NB_P ? 0 : (size_t)(j * NB_S + (s - NB_P)) * ML_NH + hd;
                    f32x4 R[32];
                    if (s < NB_P) {
                        if (false) {
#pragma unroll
                            for (int i = 0; i < 32; ++i) R[i] = (f32x4){0.f, 0.f, 0.f, 0.f};
                        }
                        nS[tid] = 0.f; nB[tid] = 0;
                    } else {
                        int t2_ = tid; asm volatile("" : "+v"(t2_));
                        const unsigned stio = (unsigned)((t2_ >> 4) * 256 + (t2_ & 15) * 16);
                        const unsigned stld = (unsigned)((4 * ((t2_ >> 4) & 3)) * 256 + (((t2_ >> 6) & 3) * 16 + (t2_ & 15)) * 4);
#pragma unroll
                        for (int h = 0; h < 2; ++h) {
                            const float* gp = st_mC + sbi * ML_HD * ML_HD + (size_t)(h * 256 + (t2_ >> 4)) * ML_HD + vs * 64 + (t2_ & 15) * 4;
#pragma unroll
                            for (int pp = 0; pp < 2; ++pp) { f32x4 tmp[4];
#pragma unroll
                                for (int p = 0; p < 4; ++p) tmp[p] = *(const f32x4*)(gp + (size_t)(pp * 4 + p) * 32 * ML_HD);
#pragma unroll
                                for (int p = 0; p < 4; ++p) LDSV(f32x4, (pp * 4 + p) * 8192 + stio) = tmp[p]; SB(); }
                            __syncthreads();
                            if (false) {
#pragma unroll
                                for (int i2 = 0; i2 < 2; ++i2)
#pragma unroll
                                    for (int kt = 0; kt < 8; ++kt)
#pragma unroll
                                        for (int r = 0; r < 4; ++r) R[(2 * h + i2) * 8 + kt][r] = LDSV(float, (i2 * 128 + kt * 16 + r) * 256 + stld);
                            }
                            __syncthreads();
                        }
                        { const float n0_ = st_mn[sbi * ML_HD + tid]; nS[tid] = n0_; nB[tid] = (unsigned short)f2bf(n0_); }
                    }
                    const int ltid_u = FRESHI(ltid), lane_u = FRESHI(lane);
                    const int lnu = FRESHI(lane); const int ug4 = lnu >> 4, ul15 = lnu & 15;
                    const unsigned m_rowQ = (unsigned)(ul15 * ST128 + 8 * ug4); unsigned m_rowQh = m_rowQ + 32; asm volatile("" : "+v"(m_rowQh));
                    const unsigned m_trK0 = (unsigned)((4 * ug4 + (ul15 >> 2)) * STK + 8 * (lnu & 3) + MQ_K);
                    const unsigned m_trVT0 = (unsigned)((4 * ug4 + (ul15 >> 2)) * STV + 8 * (lnu & 3) + v16 * 32 + MVT_OFF);
                    v4u sa[2], va[2]; float tlv[2]; f32x4 tk; float dcv;
                    const char* Qu = (const char*)(Q + (size_t)row0 * ML_INNER + hd * 512); const char* Ku = (const char*)(Kb + (size_t)row0 * ML_INNER + hd * 512);
#define ML_LOADX(set, cn, qi, x_, rowq_, colq_) do { const size_t go_ = ((size_t)(cn) * 64 * ML_INNER + (qi) * 128) * 2; const int rr_ = (rowq_) + 16 * (x_), rc_ = rr_ < Lv ? rr_ : Lv - 1; const unsigned qk_ = (unsigned)(rc_ * (ML_INNER * 2)) + (colq_); \
    R[(set) * 8 + (x_)] = *(const f32x4*)(Qu + go_ + qk_); R[(set) * 8 + 4 + (x_)] = *(const f32x4*)(Ku + go_ + qk_); } while (0)
#define ML_LOADS(set, cn, qi) do { const int tl_ = FRESHI(ltid); const int rq_ = tl_ >> 4; const unsigned cq_ = (unsigned)(tl_ & 15) * 16u; \
    ML_LOADX(set, cn, qi, 0, rq_, cq_); ML_LOADX(set, cn, qi, 1, rq_, cq_); ML_LOADX(set, cn, qi, 2, rq_, cq_); ML_LOADX(set, cn, qi, 3, rq_, cq_); } while (0)
#define ML_LOADS_S(cn) do { const int rn0_ = row0 + (cn) * 64; const int tl_ = FRESHI(ltid); \
    _Pragma("unroll") for (int x_ = 0; x_ < 2; ++x_) { const int tq_ = (tl_ >> 3) + 32 * x_, tc_ = tq_ < Lv ? tq_ : Lv - 1; \
        sa[x_] = *(const v4u*)(Sg + (size_t)((ci0 + (cn)) * 8 + hd) * 4096 + (tl_ + 256 * x_) * 8); \
        va[x_] = *(const v4u*)(Vb + (size_t)(rn0_ + tc_) * ML_INNER + hd * 512 + vs * 64 + (tl_ & 7) * 8); tlv[x_] = TOK[((size_t)(rn0_ + tc_) * 8 + hd) * 4 + 3]; } \
    { const int t6_ = tl_ & 63, t6c_ = t6_ < Lv ? t6_ : Lv - 1; tk = *(const f32x4*)(TOK + ((size_t)(rn0_ + t6c_) * 8 + hd) * 4); } \
    dcv = CHK[((ci0 + (cn)) * 8 + hd) * 2]; } while (0)
#define ML_WRITES(bufi, set) do { const int tw_ = ltid_u; const unsigned stq_ = (unsigned)((tw_ >> 4) * ST128 + (tw_ & 15) * 16), stk_ = (unsigned)((tw_ >> 4) * STK + (tw_ & 15) * 16 + MQ_K); \
    _Pragma("unroll") for (int x_ = 0; x_ < 4; ++x_) { LDSV(f32x4, (bufi) * MQ_BUF + x_ * 16 * ST128 + stq_) = R[(set) * 8 + x_]; LDSV(f32x4, (bufi) * MQ_BUF + x_ * 16 * STK + stk_) = R[(set) * 8 + 4 + x_]; } } while (0)
#define ML_WRITES_S(cn) do { const int tw_ = FRESHI(ltid); const unsigned sts_ = (unsigned)((tw_ >> 3) * ST64 + (tw_ & 7) * 16 + MS_OFF), stv_ = (unsigned)((tw_ >> 3) * STV + (tw_ & 7) * 16 + MV_OFF); \
    _Pragma("unroll") for (int x_ = 0; x_ < 2; ++x_) { if ((tw_ >> 3) + 32 * x_ >= Lv) { va[x_] = (v4u){0u, 0u, 0u, 0u}; tlv[x_] = 0.f; } \
        LDSV(v4u, x_ * 32 * ST64 + sts_) = sa[x_]; LDSV(v4u, x_ * 32 * STV + stv_) = va[x_]; const float tl2_ = tlv[x_]; \
        v4u o_; o_.x = pk2(bflo(va[x_].x) * tl2_, bfhi(va[x_].x) * tl2_); o_.y = pk2(bflo(va[x_].y) * tl2_, bfhi(va[x_].y) * tl2_); o_.z = pk2(bflo(va[x_].z) * tl2_, bfhi(va[x_].z) * tl2_); o_.w = pk2(bflo(va[x_].w) * tl2_, bfhi(va[x_].w) * tl2_); \
        LDSV(v4u, (MVT_OFF - MV_OFF) + ((cn) & 1) * MV_IMG + x_ * 32 * STV + stv_) = o_; } \
    if ((tw_ & 63) >= Lv) tk = (f32x4){0.f, 1.f, 1.f, 0.f}; \
    if (tw_ < 64) { LAS float* sc_ = scal + ((cn) & 1) * 256; sc_[tw_] = tk[0]; sc_[64 + tw_] = tk[1]; sc_[128 + tw_] = tk[2]; sc_[192 + tw_] = tk[3]; tailB[((cn) & 1) * 64 + tw_] = (unsigned short)f2bf(tk[3]); } \
    if (tw_ == 64) decS[(cn) & 1] = dcv; } while (0)
                    if (!false) {
                        ML_LOADS(0, 0, 0); ML_LOADS_S(0); ML_LOADS(1, 0, 1); ML_LOADS(2, 0, 2); ML_LOADS(3, 0, 3);
                        ML_WRITES(0, 0); ML_WRITES_S(0);
                    }
                    __syncthreads();
                    f32x4 qn_acc = (f32x4){0.f, 0.f, 0.f, 0.f};
                    for (int c = 0; c < nch; ++c) {
                        const int r0 = row0 + c * 64;
                        const int cnx = c + 1 < nch ? c + 1 : nch - 1;
                        f32x4 accQ[4];
#pragma unroll
                        for (int tt = 0; tt < 4; ++tt) accQ[tt] = (f32x4){0.f, 0.f, 0.f, 0.f};
                        const LAS float* scc = scal + (c & 1) * 256;
                        const float dec = decS[c & 1];
#pragma unroll
                        for (int i = 0; i < 4; ++i) {
                            const int b = i & 1;
                            if (false) {
                                const unsigned rowQ = m_rowQ + b * MQ_BUF, rowQh = m_rowQh + b * MQ_BUF;
                                const unsigned trK = m_trK0 + b * MQ_BUF;
                                const unsigned trVT = m_trVT0 + (c & 1) * MV_IMG;
                                if (i == 0) {
                                    const unsigned trV = m_trVT0 - (MVT_OFF - MV_OFF), rowS = (unsigned)(ul15 * ST64 + 8 * ug4 + MS_OFF);
                                    f32x4 accI[4];
#pragma unroll
                                    for (int tt = 0; tt < 4; ++tt) accI[tt] = (f32x4){0.f, 0.f, 0.f, 0.f};
                                    bf16x8 vf2[2]; v2u sl2[2][4], sh2[2][4];
#pragma unroll
                                    for (int ks = 0; ks < 2; ++ks) { vf2[ks] = TRFRAG(ks * 32 * STV + trV, STV);
#pragma unroll
                                        for (int tt = 0; tt < 4; ++tt) { sl2[ks][tt] = LDSV(v2u, tt * 16 * ST64 + ks * 64 + rowS); sh2[ks][tt] = LDSV(v2u, tt * 16 * ST64 + ks * 64 + 32 + rowS); } }
                                    SB();
#pragma unroll
                                    for (int ks = 0; ks < 2; ++ks) {
#pragma unroll
                                        for (int tt = 0; tt < 4; ++tt) { pg8::u32x4 sw; sw.x = sl2[ks][tt].x; sw.y = sl2[ks][tt].y; sw.z = sh2[ks][tt].x; sw.w = sh2[ks][tt].y;
                                            accI[tt] = __builtin_amdgcn_mfma_f32_16x16x32_bf16(vf2[ks], __builtin_bit_cast(bf16x8, sw), accI[tt], 0, 0, 0); } }
#pragma unroll
                                    for (int tt = 0; tt < 4; ++tt) Ib[(v16 * 4 + tt) * 64 + lnu] = accI[tt];
                                    SB();
                                }
                                v2u ql[8], qh[8]; bf16x8 k0w[4], k1w[4], afr[2];
#define QRD(n) do { ql[(n) & 7] = LDSV(v2u, ((n) & 3) * 16 * ST128 + ((n) >> 2) * 64 + rowQ); qh[(n) & 7] = LDSV(v2u, ((n) & 3) * 16 * ST128 + ((n) >> 2) * 64 + rowQh); asm volatile("" ::: "memory"); } while (0)
#define AFQ(kk) do { const f32x4 sa0 = R[i * 8 + 2 * (kk)], sb0 = R[i * 8 + 2 * (kk) + 1]; pg8::u32x4 aw; aw.x = cvt_pk_bf16(sa0[0], sa0[1]); aw.y = cvt_pk_bf16(sa0[2], sa0[3]); aw.z = cvt_pk_bf16(sb0[0], sb0[1]); aw.w = cvt_pk_bf16(sb0[2], sb0[3]); afr[(kk) & 1] = __builtin_bit_cast(bf16x8, aw); } while (0)
#define QMF(n) do { pg8::u32x4 bw; bw.x = ql[(n) & 7].x; bw.y = ql[(n) & 7].y; bw.z = qh[(n) & 7].x; bw.w = qh[(n) & 7].y; accQ[(n) & 3] = __builtin_amdgcn_mfma_f32_16x16x32_bf16(afr[((n) >> 2) & 1], __builtin_bit_cast(bf16x8, bw), accQ[(n) & 3], 0, 0, 0); } while (0)
#define KRD(t) do { k0w[(t) & 3] = TRFRAG((t) * 32 + trK, STK); k1w[(t) & 3] = TRFRAG(32 * STK + (t) * 32 + trK, STK); } while (0)
#define KDEC(dst, t) do { const f32x4 r_ = R[i * 8 + (t)]; _Pragma("unroll") for (int e_ = 0; e_ < 4; ++e_) { float t_; asm("v_mul_f32 %0, %1, %2" : "=v"(t_) : "v"(r_[e_]), "v"(dec)); dst[e_] = t_; } } while (0)
#define KMF(sv, t) do { sv = __builtin_amdgcn_mfma_f32_16x16x32_bf16(k0w[(t) & 3], vt0, sv, 0, 0, 0); sv = __builtin_amdgcn_mfma_f32_16x16x32_bf16(k1w[(t) & 3], vt1, sv, 0, 0, 0); R[i * 8 + (t)] = sv; } while (0)
                                QRD(0); QRD(1); QRD(2); QRD(3); QRD(4); QRD(5); QRD(6); QRD(7); AFQ(0); SB();
                                const bf16x8 vt0 = TRFRAG(trVT, STV), vt1 = TRFRAG(trVT + 32 * STV, STV);
                                QMF(0); QRD(8); SB();
                                AFQ(1); QMF(1); QRD(9); SB();
                                QMF(2); QRD(10); SB();
                                QMF(3); QRD(11); SB();
                                QMF(4); QRD(12); SB();
                                AFQ(2); QMF(5); QRD(13); SB();
                                QMF(6); QRD(14); SB();
                                QMF(7); QRD(15); SB();
                                QMF(8); KRD(0); SB();
                                AFQ(3); QMF(9); SB();
                                QMF(10); KRD(1); SB();
                                QMF(11); SB();
                                QMF(12); KRD(2); SB();
                                QMF(13); SB();
                                QMF(14); KRD(3); SB();
                                QMF(15); SB();
                                f32x4 svA, svB; KDEC(svA, 0); SB();
                                KDEC(svB, 1); KMF(svA, 0); KRD(4); SB();
                                KDEC(svA, 2); KMF(svB, 1); KRD(5); SB();
                                KDEC(svB, 3); KMF(svA, 2); KRD(6); SB();
                                KDEC(svA, 4); KMF(svB, 3); KRD(7); SB();
                                KDEC(svB, 5); KMF(svA, 4); SB();
                                KDEC(svA, 6); KMF(svB, 5); SB();
                                KDEC(svB, 7); KMF(svA, 6); SB();
                                KMF(svB, 7); SB();
#undef QRD
#undef AFQ
#undef QMF
#undef KRD
#undef KDEC
#undef KMF
                            } else {
                                const int tlq = ltid_u; const int rowq = tlq >> 4; const unsigned colq = (unsigned)(tlq & 15) * 16u;
                                ML_LOADX(i, cnx, i, 0, rowq, colq);
                                SB();
                                const int lnd = FRESHI(lane); const int g4 = lnd >> 4, l15 = lnd & 15;
                                const bool dofold = (ltid < 128) && !(i == 0 && c == 0);
                                const int kr = ((i + 3) & 3) * 128 + (ltid & 127);
                                const float fo_n = nS[kr], fo_p = nPart[((i + 1) & 1) * 128 + (ltid & 127)];
                                const unsigned tbo = MTB_OFF + (c & 1) * 128 + 8 * g4;
                                const v2u t0l = LDSV(v2u, tbo), t0h = LDSV(v2u, tbo + 32), t1l = LDSV(v2u, tbo + 64), t1h = LDSV(v2u, tbo + 96);
                                const unsigned trK = (unsigned)((4 * g4 + (l15 >> 2)) * STK + 8 * (lnd & 3) + MQ_K + b * MQ_BUF + lw * 64);
                                const bf16x8 kfa0 = TRFRAG(trK, STK), kfa1 = TRFRAG(32 * STK + trK, STK);
                                SB();
                                ML_LOADX(i, cnx, i, 1, rowq, colq);
                                SB();
                                if (dofold) { const float dc = i == 0 ? decS[(c + 1) & 1] : dec; const float nn = dc * fo_n + fo_p; nS[kr] = nn; nB[kr] = (unsigned short)f2bf(nn); }
                                { pg8::u32x4 w0, w1; w0.x = t0l.x; w0.y = t0l.y; w0.z = t0h.x; w0.w = t0h.y; w1.x = t1l.x; w1.y = t1l.y; w1.z = t1h.x; w1.w = t1h.y;
                                  const bf16x8 tf0 = __builtin_bit_cast(bf16x8, w0), tf1 = __builtin_bit_cast(bf16x8, w1);
                                  const bf16x8 kfb0 = TRFRAG(32 + trK, STK), kfb1 = TRFRAG(32 * STK + 32 + trK, STK);
                                  f32x4 pn = (f32x4){0.f, 0.f, 0.f, 0.f}; pn = __builtin_amdgcn_mfma_f32_16x16x32_bf16(kfa0, tf0, pn, 0, 0, 0); pn = __builtin_amdgcn_mfma_f32_16x16x32_bf16(kfa1, tf1, pn, 0, 0, 0);
                                  if (l15 == 0) *(LAS f32x4*)(nPart + (i & 1) * 128 + (2 * lw) * 16 + 4 * g4) = pn;
                                  SB(); ML_LOADX(i, cnx, i, 2, rowq, colq); SB();
                                  f32x4 pm = (f32x4){0.f, 0.f, 0.f, 0.f}; pm = __builtin_amdgcn_mfma_f32_16x16x32_bf16(kfb0, tf0, pm, 0, 0, 0); pm = __builtin_amdgcn_mfma_f32_16x16x32_bf16(kfb1, tf1, pm, 0, 0, 0);
                                  if (l15 == 0) *(LAS f32x4*)(nPart + (i & 1) * 128 + (2 * lw + 1) * 16 + 4 * g4) = pm; }
                                SB();
                                ML_LOADX(i, cnx, i, 3, rowq, colq);
                                if (i == 0) ML_LOADS_S(cnx);
                                SB();
                                { const unsigned qro = (unsigned)(b * MQ_BUF + (lw * 16 + l15) * ST128 + 16 * g4), nbo = (unsigned)(MNB_OFF + (i * 128 + 8 * g4) * 2);
                                  bf16x8 qf[4], nf[4];
#pragma unroll
                                  for (int kk = 0; kk < 4; ++kk) { qf[kk] = LDSV(bf16x8, qro + kk * 64); nf[kk] = LDSV(bf16x8, nbo + kk * 64); }
                                  SB();
#pragma unroll
                                  for (int kk = 0; kk < 4; ++kk) qn_acc = __builtin_amdgcn_mfma_f32_16x16x32_bf16(qf[kk], nf[kk], qn_acc, 0, 0, 0); }
                                SB();
                                ML_WRITES(b ^ 1, (i + 1) & 3);
                                if (i == 3) { ML_WRITES_S(cnx); if (l15 == 0) *(LAS f32x4*)(qnP + lw * 16 + 4 * g4) = qn_acc; qn_acc = (f32x4){0.f, 0.f, 0.f, 0.f}; }
                            }
                            __syncthreads();
                        }
                        if (false) {
                            const int lnf = lnu; const int l15 = ul15, g4 = ug4;
                            float qn4[4], gt4[4], em4[4], dn4[4]; f32x4 ib4[4];
#pragma unroll
                            for (int tt = 0; tt < 4; ++tt) { const int t = tt * 16 + l15; qn4[tt] = qnP[t]; gt4[tt] = scc[t]; em4[tt] = scc[64 + t]; dn4[tt] = scc[128 + t]; ib4[tt] = Ib[(v16 * 4 + tt) * 64 + lnf]; }
                            SB();
#pragma unroll
                            for (int tt = 0; tt < 4; ++tt) { const int t = tt * 16 + l15;
                                const float den = dn4[tt] + gt4[tt] * qn4[tt];
                                const float rd = __builtin_amdgcn_rcpf(fmaxf(fabsf(den), em4[tt]));
                                const f32x4 hv = (ib4[tt] + accQ[tt] * gt4[tt]) * rd;
                                if (t < Lv) { v2u o; o.x = pk2(hv[0], hv[1]); o.y = pk2(hv[2], hv[3]); *(v2u*)(H + (size_t)(r0 + t) * ML_INNER + hd * 512 + vs * 64 + v16 * 16 + 4 * g4) = o; } }
                        }
                    }
                    if (!false && ltid < 128) { const int kr = 3 * 128 + ltid; nS[kr] = decS[(nch - 1) & 1] * nS[kr] + nPart[128 + ltid]; }
                    __syncthreads();
                    {
                        const size_t sbo = s < NB_P ? (size_t)(j * NB_P + s) * ML_NH + hd : sbi;
                        int t2_ = tid; asm volatile("" : "+v"(t2_));
                        const unsigned stio = (unsigned)((t2_ >> 4) * 256 + (t2_ & 15) * 16);
                        const unsigned stld = (unsigned)((4 * ((t2_ >> 4) & 3)) * 256 + (((t2_ >> 6) & 3) * 16 + (t2_ & 15)) * 4);
                        if (vs == 0) { out[(s < NB_P ? O_P_MN : O_S_MN) + sbo * ML_HD + tid] = nS[tid]; if (tid == 0) out[(s < NB_P ? O_P_MM : O_S_MM) + sbo] = CHK[((ci0 + nch - 1) * 8 + hd) * 2 + 1]; }
                        __syncthreads();
#pragma unroll
                        for (int h = 0; h < 2; ++h) {
                            if (false) {
#pragma unroll
                                for (int i2 = 0; i2 < 2; ++i2)
#pragma unroll
                                    for (int kt = 0; kt < 8; ++kt)
#pragma unroll
                                        for (int r = 0; r < 4; ++r) LDSV(float, (i2 * 128 + kt * 16 + r) * 256 + stld) = R[(2 * h + i2) * 8 + kt][r];
                            }
                            __syncthreads();
                            float* gp = out + (s < NB_P ? O_P_MC : O_S_MC) + sbo * ML_HD * ML_HD + (size_t)(h * 256 + (t2_ >> 4)) * ML_HD + vs * 64 + (t2_ & 15) * 4;
#pragma unroll 1
                            for (int p = 0; p < 8; ++p) *(f32x4*)(gp + (size_t)p * 32 * ML_HD) = LDSV(f32x4, p * 8192 + stio);
                            __syncthreads();
                        }
                    }
                    __syncthreads();
#undef ML_LOADS
#undef ML_LOADS_S
#undef ML_WRITES
#undef ML_WRITES_S
                }
                }
#undef LDSV
#undef TRFRAG
#undef FRESHI
#undef SB
            }
            SEAM(pb + 4, pb + 5);
            if (IN(pb + 5)) {
                SITE_VARS();
                const float* norm_w = args.in[24] + (size_t)j * ML_INNER; const float* skip = args.in[25] + (size_t)j * ML_INNER;
                for (int it = gw; it < M * 2; it += NGW) {
                    const int row = it >> 1, hh = (it & 1) * 4; const size_t off0 = (size_t)row * ML_INNER + hh * 512 + lane * 8;
                    v4u hw4[4], ow4[4], xw4[4], zw4[4];
#pragma unroll
                    for (int q = 0; q < 4; ++q) { hw4[q] = *(const v4u*)(H + off0 + q * 512); ow4[q] = *(const v4u*)(O + off0 + q * 512); xw4[q] = *(const v4u*)(XC + off0 + q * 512); zw4[q] = *(const v4u*)(Z + off0 + q * 512); }
#pragma unroll
                    for (int q = 0; q < 4; ++q) {
                        const int hd = hh + q; const v4u hw = hw4[q], ow = ow4[q], xw = xw4[q], zw = zw4[q];
                        float h[8] = {bflo(hw.x), bfhi(hw.x), bflo(hw.y), bfhi(hw.y), bflo(hw.z), bfhi(hw.z), bflo(hw.w), bfhi(hw.w)};
                        const float og[8] = {bflo(ow.x), bfhi(ow.x), bflo(ow.y), bfhi(ow.y), bflo(ow.z), bfhi(ow.z), bflo(ow.w), bfhi(ow.w)};
                        const float xc[8] = {bflo(xw.x), bfhi(xw.x), bflo(xw.y), bfhi(xw.y), bflo(xw.z), bfhi(xw.z), bflo(xw.w), bfhi(xw.w)};
                        const float zz[8] = {bflo(zw.x), bfhi(zw.x), bflo(zw.y), bfhi(zw.y), bflo(zw.z), bfhi(zw.z), bflo(zw.w), bfhi(zw.w)};
                        float sm = 0.f;
#pragma unroll
                        for (int i = 0; i < 8; ++i) sm += h[i];
                        const float mu = wave_sum(sm) * (1.f / 512.f); float s2 = 0.f;
#pragma unroll
                        for (int i = 0; i < 8; ++i) { h[i] -= mu; s2 += h[i] * h[i]; }
                        const float rstd = rsqrtf(wave_sum(s2) * (1.f / 512.f) + LN_EPS);
                        const float* nw = norm_w + hd * 512 + lane * 8; const float* sk = skip + hd * 512 + lane * 8;
                        const f32x4 n0 = *(const f32x4*)nw, n1 = *(const f32x4*)(nw + 4), k0 = *(const f32x4*)sk, k1 = *(const f32x4*)(sk + 4);
                        const float nwv[8] = {n0[0], n0[1], n0[2], n0[3], n1[0], n1[1], n1[2], n1[3]}, skv[8] = {k0[0], k0[1], k0[2], k0[3], k1[0], k1[1], k1[2], k1[3]};
                        float y[8];
#pragma unroll
                        for (int i = 0; i < 8; ++i) y[i] = (sigmoid_f(og[i]) * (h[i] * rstd * nwv[i]) + skv[i] * xc[i]) * silu_f(zz[i]);
                        v4u o; o.x = pk2(y[0], y[1]); o.y = pk2(y[2], y[3]); o.z = pk2(y[4], y[5]); o.w = pk2(y[6], y[7]);
                        *(v4u*)(YG + off0 + q * 512) = o;
                    }
                }
            }
            SEAM(pb + 5, pb + 6);
            if (IN(pb + 6)) {
                SITE_VARS();
                pg8::Gemm g{YG, (const bf16*)(ws + WS_WML_OUT) + (size_t)j * DM * ML_INNER, ML_INNER, ML_INNER, -1};
                pg8::SplitTailOrder S; S.init(M_P / 256, DM / 256, M_S / 256, G, bx, WGM_OUT);
                EpiResid E{XB, VPRE, DN_ALPHA, SLAB};
                pg8::gemm_phase<EpiResid, pg8::SplitTailOrder, PG8_ALIGN, PG8_SP2, true>(lds, g, S, E, tid);
            }
            SEAM(pb + 6, pb + 7);
            if (IN(pb + 7)) {
                SITE_VARS();
                const float* lg = args.in[27] + (size_t)li * DM; const float* lb = args.in[28] + (size_t)li * DM;
                const bool lastl = (li == 3);
                for (int row = gw; row < M; row += NGW) {
                    const v4u* vr = (const v4u*)(VPRE + (size_t)row * DM) + lane;
                    const v4u* XBV = (const v4u*)XB;
                    float v[32]; float sm = 0.f;
#pragma unroll
                    for (int q = 0; q < 4; ++q) { v4u w = vr[64 * q]; if (row >= M_P) w = (XBV + (size_t)row * (DM / 8) + lane)[64 * q]; v[8 * q + 0] = bflo(w.x); v[8 * q + 1] = bfhi(w.x); v[8 * q + 2] = bflo(w.y); v[8 * q + 3] = bfhi(w.y); v[8 * q + 4] = bflo(w.z); v[8 * q + 5] = bfhi(w.z); v[8 * q + 6] = bflo(w.w); v[8 * q + 7] = bfhi(w.w); }
                    if (row >= M_P) {
#pragma unroll
                        for (int i = 0; i < 32; ++i) v[i] *= DN_ALPHA;
#pragma unroll
                        for (int kq = 0; kq < 4; ++kq)
#pragma unroll
                            for (int q = 0; q < 4; ++q) { const float* sp = SLAB + ((size_t)kq * M_S + (row - M_P)) * DM + 8 * (lane + 64 * q); const f32x4 s0 = *(const f32x4*)sp, s1 = *(const f32x4*)(sp + 4);
                                v[8 * q + 0] += s0[0]; v[8 * q + 1] += s0[1]; v[8 * q + 2] += s0[2]; v[8 * q + 3] += s0[3]; v[8 * q + 4] += s1[0]; v[8 * q + 5] += s1[1]; v[8 * q + 6] += s1[2]; v[8 * q + 7] += s1[3]; }
                    }
#pragma unroll
                    for (int i = 0; i < 32; ++i) sm += v[i];
                    const float mean = wave_sum(sm) * (1.f / DM); float s2 = 0.f;
#pragma unroll
                    for (int i = 0; i < 32; ++i) { v[i] -= mean; s2 += v[i] * v[i]; }
                    const float rstd = rsqrtf(wave_sum(s2) * (1.f / DM) + LN_EPS);
#pragma unroll
                    for (int q = 0; q < 4; ++q) { const int c = 8 * (lane + 64 * q); const f32x4 g0 = *(const f32x4*)(lg + c), g1 = *(const f32x4*)(lg + c + 4), b0 = *(const f32x4*)(lb + c), b1 = *(const f32x4*)(lb + c + 4);
                        f32x4 o0, o1;
#pragma unroll
                        for (int e = 0; e < 4; ++e) { o0[e] = v[8 * q + e] * rstd * g0[e] + b0[e]; o1[e] = v[8 * q + 4 + e] * rstd * g1[e] + b1[e]; }
                        if (lastl) { float* orow = out + (size_t)row * DM + c; *(f32x4*)orow = o0; *(f32x4*)(orow + 4) = o1; } else { v4u w; w.x = pk2(o0[0], o0[1]); w.y = pk2(o0[2], o0[3]); w.z = pk2(o1[0], o1[1]); w.w = pk2(o1[2], o1[3]); *(v4u*)(XB + (size_t)row * DM + c) = w; } }
                }
            }
            SEAM(pb + 7, pb + 8);
        }
    }
#undef IN
#undef SEAM
}

static bool phase_used(int ph) { if (ph == 0) return true; const int i = (ph - 1) / 8, k = (ph - 1) % 8; return (i & 1) ? (k < 8) : (k < 6); }
constexpr int N_PHASE_IDS = 33;

extern "C" void kernel_launch(void* const* d_in, const int* in_sizes, int n_in, void* d_out, int out_size, void* d_ws, size_t ws_size, hipStream_t stream) {
    static int grid = 0;
    if (grid == 0) {
        if (n_in != 29 || (size_t)out_size != O_END || ws_size < WS_END) { fprintf(stderr, "kernel_launch: shape mismatch: n_in %d out %d (want %zu) ws %zu (want %zu)\n", n_in, out_size, (size_t)O_END, ws_size, (size_t)WS_END); grid = -1; return; }
        int dev = 0, cus = 0;
        if (hipGetDevice(&dev) != hipSuccess || hipDeviceGetAttribute(&cus, hipDeviceAttributeMultiprocessorCount, dev) != hipSuccess) { grid = -1; return; }
        if (hipFuncSetAttribute((const void*)mk_fwd, hipFuncAttributeMaxDynamicSharedMemorySize, LDS_BYTES) != hipSuccess) { fprintf(stderr, "kernel_launch: hipFuncSetAttribute failed\n"); grid = -1; return; }
        int per_cu = 0;
        (void)hipOccupancyMaxActiveBlocksPerMultiprocessor(&per_cu, (const void*)mk_fwd, NWAVES * 64, LDS_BYTES);
        (void)hipGetLastError();
        grid = cus;
    }
    if (grid < 0) return;
    if (hipMemsetAsync((char*)d_ws + WS_CTL, 0, CTL_ZERO_BYTES, stream) != hipSuccess) return;
    Args a{};
    for (int i = 0; i < 29; ++i) a.in[i] = (const float*)d_in[i];
    a.out = (float*)d_out; a.ws = (unsigned char*)d_ws;
#if MK_ONE_LAUNCH
    a.ph_lo = 0; a.ph_hi = N_PHASE_IDS;
    hipLaunchKernelGGL(mk_fwd, dim3(grid), dim3(NWAVES * 64), LDS_BYTES, stream, a);
#else
    for (int ph = 0; ph < N_PHASE_IDS; ++ph) {
        if (!phase_used(ph)) continue;
        a.ph_lo = ph; a.ph_hi = ph + 1;
        hipLaunchKernelGGL(mk_fwd, dim3(grid), dim3(NWAVES * 64), LDS_BYTES, stream, a);
    }
#endif
}
```
